# Optimizing an MI355X kernel written in HIP

```python
import jax, jax.numpy as jnp
from jax import lax
import numpy as np

D_MODEL = 1024
BATCH = 8
SEQ = 4096
DEPTH = 1

CHUNK = 64
SB_BLOCK = 128
PLE_DIM = 256
MIX_WIDTH = D_MODEL
SB_WIDTH = MIX_WIDTH // 2
ML_WIDTH = MIX_WIDTH - SB_WIDTH
SB_HEADS = 8
SB_HEAD_DIM = SB_WIDTH // SB_HEADS
ML_HEADS = 4
ML_HEAD_DIM = ML_WIDTH // ML_HEADS
CONV_K = 4
EPS = 1e-6
SPLIT_SIZES = (SB_WIDTH, SB_WIDTH, SB_WIDTH, SB_WIDTH, ML_WIDTH, ML_WIDTH, ML_WIDTH, ML_WIDTH, ML_WIDTH, ML_HEADS, ML_HEADS)
N_IN = 4 * SB_WIDTH + 5 * ML_WIDTH + 2 * ML_HEADS

kernel_name = 'hybrid_stickbreaking_mlstm_block'


def _rmsnorm(x, w):
    xf = x.astype(jnp.float32)
    y = xf * lax.rsqrt(jnp.mean(xf * xf, axis=-1, keepdims=True) + EPS)
    return (y * w.astype(jnp.float32)).astype(x.dtype)


def _head_rmsnorm(y, w, n_heads):
    b, s, width = y.shape
    yf = y.astype(jnp.float32).reshape(b, s, n_heads, width // n_heads)
    yf = yf * lax.rsqrt(jnp.mean(yf * yf, axis=-1, keepdims=True) + EPS)
    return (yf.reshape(b, s, width) * w.astype(jnp.float32)).astype(y.dtype)


def _split_cols(u):
    bounds = []
    acc = 0
    for size in SPLIT_SIZES[:-1]:
        acc += size
        bounds.append(acc)
    return jnp.split(u, bounds, axis=-1)


def _split_heads(u, n_heads):
    b, s, width = u.shape
    return u.reshape(b, s, n_heads, width // n_heads).transpose(0, 2, 1, 3)


def _merge_heads(u):
    b, h, s, d = u.shape
    return u.transpose(0, 2, 1, 3).reshape(b, s, h * d)


def _causal_conv(u, w, bias):
    s = u.shape[1]
    k = w.shape[0]
    up = jnp.pad(u, ((0, 0), (k - 1, 0), (0, 0)))
    out = bias
    for j in range(k):
        out = out + w[j] * up[:, j:j + s]
    return out


def _stick_breaking_attention(q, k, v):
    s = q.shape[2]
    d = q.shape[3]
    scale = d ** -0.5
    outs = []
    for blk in range(s // SB_BLOCK):
        q0 = blk * SB_BLOCK
        k_end = q0 + SB_BLOCK
        qb = q[:, :, q0:k_end]
        kb = k[:, :, :k_end]
        vb = v[:, :, :k_end]
        z = jnp.einsum('bhqd,bhkd->bhqk', qb, kb).astype(jnp.float32) * scale
        t_pos = q0 + jnp.arange(SB_BLOCK)[:, None]
        s_pos = jnp.arange(k_end)[None, :]
        strict = s_pos < t_pos
        log_beta = jax.nn.log_sigmoid(z)
        log_keep = jnp.where(strict, log_beta - z, 0.0)
        after = lax.cumsum(log_keep, axis=3, reverse=True) - log_keep
        a = jnp.where(strict, jnp.exp(log_beta + after), 0.0)
        outs.append(jnp.einsum('bhqk,bhkd->bhqd', a, vb.astype(jnp.float32)))
    return jnp.concatenate(outs, axis=2).astype(q.dtype)


def _mlstm_chunkwise(q, k, v, i_pre, f_pre):
    out_dtype = q.dtype
    f32 = jnp.float32
    bsz, nh, s, d = q.shape
    nc = s // CHUNK

    def chunks(t):
        return t.astype(f32).reshape(bsz, nh, nc, CHUNK, d)

    q = chunks(q)
    k = chunks(k) * (d ** -0.5)
    v = chunks(v)
    ig = i_pre.astype(f32).transpose(0, 2, 1).reshape(bsz, nh, nc, CHUNK)
    lf = jax.nn.log_sigmoid(f_pre.astype(f32)).transpose(0, 2, 1).reshape(bsz, nh, nc, CHUNK)
    b = jnp.cumsum(lf, axis=-1)
    b_last = b[..., -1]

    g = b_last[..., None] - b + ig
    m_loc = jnp.max(g, axis=-1)
    w_loc = jnp.exp(g - m_loc[..., None])
    c_loc = jnp.einsum('bhcs,bhcsv,bhcsd->bhcvd', w_loc, v, k)
    n_loc = jnp.einsum('bhcs,bhcsd->bhcd', w_loc, k)

    def step(carry, xs):
        c_st, n_st, m_st = carry
        bl, ml, cl, nl = xs
        m_new = jnp.maximum(bl + m_st, ml)
        a = jnp.exp(bl + m_st - m_new)
        gg = jnp.exp(ml - m_new)
        c_new = a[..., None, None] * c_st + gg[..., None, None] * cl
        n_new = a[..., None] * n_st + gg[..., None] * nl
        return (c_new, n_new, m_new), (c_st, n_st, m_st)

    init = (jnp.zeros((bsz, nh, d, d), f32), jnp.zeros((bsz, nh, d), f32), jnp.zeros((bsz, nh), f32))
    xs = (jnp.moveaxis(b_last, 2, 0), jnp.moveaxis(m_loc, 2, 0), jnp.moveaxis(c_loc, 2, 0), jnp.moveaxis(n_loc, 2, 0))
    _, (c_prev, n_prev, m_prev) = lax.scan(step, init, xs)
    c_prev = jnp.moveaxis(c_prev, 0, 2)
    n_prev = jnp.moveaxis(n_prev, 0, 2)
    m_prev = jnp.moveaxis(m_prev, 0, 2)

    causal = jnp.tril(jnp.ones((CHUNK, CHUNK), dtype=bool))
    d_log = jnp.where(causal, b[..., :, None] - b[..., None, :] + ig[..., None, :], -jnp.inf)
    m_t = jnp.maximum(b + m_prev[..., None], jnp.max(d_log, axis=-1))
    w_intra = jnp.exp(d_log - m_t[..., None])
    scores = jnp.einsum('bhcld,bhcsd->bhcls', q, k) * w_intra
    carry_scale = jnp.exp(b + m_prev[..., None] - m_t)
    num = jnp.einsum('bhcls,bhcsv->bhclv', scores, v) + carry_scale[..., None] * jnp.einsum('bhcld,bhcvd->bhclv', q, c_prev)
    den = jnp.sum(scores, axis=-1) + carry_scale * jnp.einsum('bhcld,bhcd->bhcl', q, n_prev)
    h = num / jnp.maximum(jnp.abs(den), jnp.exp(-m_t))[..., None]
    return h.reshape(bsz, nh, s, d).astype(out_dtype)


def setup_inputs(seed: int = 0) -> dict:
    key = jax.random.key(seed)
    ks = jax.random.split(key, 15)
    nrm = jax.random.normal
    f32 = jnp.float32
    return {
        'x': nrm(ks[0], (BATCH, SEQ, D_MODEL), f32),
        'p': nrm(ks[1], (DEPTH, BATCH, SEQ, PLE_DIM), f32),
        'pre_norm_w': 1.0 + 0.05 * nrm(ks[2], (DEPTH, D_MODEL), f32),
        'w_in': nrm(ks[3], (DEPTH, D_MODEL, N_IN), f32) * D_MODEL ** -0.5,
        'ml_conv_w': nrm(ks[4], (DEPTH, CONV_K, 2 * ML_WIDTH), f32) * CONV_K ** -0.5,
        'ml_conv_b': 0.02 * nrm(ks[5], (DEPTH, 2 * ML_WIDTH), f32),
        'ml_i_bias': 0.1 * nrm(ks[6], (DEPTH, ML_HEADS), f32),
        'ml_f_bias': jnp.linspace(3.0, 6.0, ML_HEADS, dtype=f32)[None, :] + 0.01 * nrm(ks[7], (DEPTH, ML_HEADS), f32),
        'sb_norm_w': 1.0 + 0.05 * nrm(ks[8], (DEPTH, SB_WIDTH), f32),
        'ml_norm_w': 1.0 + 0.05 * nrm(ks[9], (DEPTH, ML_WIDTH), f32),
        'w_out': nrm(ks[10], (DEPTH, MIX_WIDTH, D_MODEL), f32) * MIX_WIDTH ** -0.5,
        'post_norm_w': 1.0 + 0.05 * nrm(ks[11], (DEPTH, D_MODEL), f32),
        'ple_w_up': nrm(ks[12], (DEPTH, PLE_DIM, D_MODEL), f32) * PLE_DIM ** -0.5,
        'ple_w_gate': nrm(ks[13], (DEPTH, D_MODEL, D_MODEL), f32) * D_MODEL ** -0.5,
        'ple_b_gate': 0.02 * nrm(ks[14], (DEPTH, D_MODEL), f32),
    }


def reference(x, p, pre_norm_w, w_in, ml_conv_w, ml_conv_b, ml_i_bias, ml_f_bias, sb_norm_w, ml_norm_w, w_out, post_norm_w, ple_w_up, ple_w_gate, ple_b_gate):
    h = x
    for i in range(DEPTH):
        u = _rmsnorm(h, pre_norm_w[i])
        proj = u @ w_in[i]
        sb_q, sb_k, sb_v, sb_z, ml_q, ml_k, ml_v, ml_o, ml_z, ml_i, ml_f = _split_cols(proj)

        y_sb = _stick_breaking_attention(_split_heads(sb_q, SB_HEADS), _split_heads(sb_k, SB_HEADS), _split_heads(sb_v, SB_HEADS))
        y_sb = _head_rmsnorm(_merge_heads(y_sb), sb_norm_w[i], SB_HEADS) * jax.nn.silu(sb_z)

        qk = jax.nn.silu(_causal_conv(jnp.concatenate([ml_q, ml_k], axis=-1), ml_conv_w[i], ml_conv_b[i]))
        ml_q, ml_k = jnp.split(qk, 2, axis=-1)
        y_ml = _mlstm_chunkwise(_split_heads(ml_q, ML_HEADS), _split_heads(ml_k, ML_HEADS), _split_heads(ml_v, ML_HEADS), ml_i + ml_i_bias[i], ml_f + ml_f_bias[i])
        y_ml = jax.nn.sigmoid(ml_o) * _merge_heads(y_ml)
        y_ml = _head_rmsnorm(y_ml, ml_norm_w[i], ML_HEADS) * jax.nn.silu(ml_z)

        y = jnp.concatenate([y_sb, y_ml], axis=-1) @ w_out[i]
        h = h + _rmsnorm(y, post_norm_w[i])

        gate = jax.nn.sigmoid(h @ ple_w_gate[i] + ple_b_gate[i])
        h = h + gate * (p[i] @ ple_w_up[i])
    return h
```

```cpp
#include <hip/hip_runtime.h>
#include <hip/hip_cooperative_groups.h>
#include <cstdio>
#include <cstdint>
namespace cg = cooperative_groups;
namespace pg8 {
#define PG8_LAS __attribute__((address_space(3)))
typedef unsigned short bf16_t;
typedef short bf16x8 __attribute__((ext_vector_type(8)));
typedef float f32x4 __attribute__((ext_vector_type(4)));
typedef unsigned u32x4 __attribute__((ext_vector_type(4)));
constexpr int BM = 256, BK = 64, HALF = 128, HTB = HALF * BK * 2  , STAGE_BYTES = 8 * HTB, NXCD = 8, WGM = 8;

__host__ __device__ __forceinline__ int lds_byte(int r, int c) { const int st = (r >> 4) * 2 + (c >> 5), rr = r & 15, cc = c & 31, ob = rr * 64 + cc * 2; return st * 1024 + (ob ^ (((ob >> 9) & 1) << 5)); }
__host__ __device__ __forceinline__ void stage_rc(int b, int& R, int& C) { const int st = b / 1024, sb = b % 1024, swz = sb ^ (((sb >> 9) & 1) << 5); R = (st >> 1) * 16 + swz / 64; C = (st & 1) * 32 + (swz % 64) / 2; }
__host__ __device__ __forceinline__ int perm32(int rho) { const int n = rho >> 4, i = rho & 15; return 8 * (i >> 2) + 4 * n + (i & 3); }

struct Unit { int pm, pn; };
struct Gemm { const bf16_t* A; const bf16_t* Bt; int M, N, K; };

struct StaticOrder {
    int nM, nN, nwg, G, c;
    __host__ __device__ void init(int M, int N, int G_, int c_) { nM = M / BM; nN = N / BM; nwg = nM * nN; G = G_; c = c_; }
    __host__ __device__ bool next(int i, Unit& u) const {
        const long L = (long)i * G + c; if (L >= nwg) return false;
        int wgid = (int)L; { const int q = nwg / NXCD, r = nwg % NXCD, xcd = wgid % NXCD, off = wgid / NXCD; wgid = (xcd < r ? xcd * (q + 1) : r * (q + 1) + (xcd - r) * q) + off; }
        const int nig = WGM * nN, gid = wgid / nig, fm = gid * WGM, gsz = (nM - fm) < WGM ? (nM - fm) : WGM;
        u.pm = fm + ((wgid % nig) % gsz); u.pn = (wgid % nig) / gsz; return true;
    }
    __device__ __forceinline__ void a_ready(const Unit&) const {}
    __device__ __forceinline__ void done(const Unit&) const {}
};

__device__ __forceinline__ unsigned cvt_pk_bf16(float lo, float hi) { unsigned r; asm volatile("v_cvt_pk_bf16_f32 %0, %1, %2" : "=v"(r) : "v"(lo), "v"(hi)); return r; }
typedef float f32x2 __attribute__((ext_vector_type(2)));
__device__ __forceinline__ f32x2 gelu_pk(f32x2 v) {
    const f32x2 av = __builtin_elementwise_abs(v), d = av * 0.2316418882f + 1.0f;
    f32x2 t; t.x = __builtin_amdgcn_rcpf(d.x); t.y = __builtin_amdgcn_rcpf(d.y);
    f32x2 q = t * 0.5307027145f + (-0.7265760135f); q = q * t + 0.7107068705f; q = q * t + (-0.142248368f); q = q * t + 0.127414796f; q = q * t;
    const f32x2 s = (v * v) * (-0.72134752044f);
    f32x2 e; e.x = __builtin_amdgcn_exp2f(s.x); e.y = __builtin_amdgcn_exp2f(s.y);
    const f32x2 m = v * (q * e), r = v - m;
    f32x2 o; o.x = v.x < 0.f ? m.x : r.x; o.y = v.y < 0.f ? m.y : r.y; return o;
}

template <int ACT  > struct EpiBf16 {
    static constexpr bool PERM = true, AFTER_DRAIN = false; static_assert(ACT == 0 || ACT == 1, "EpiBf16: ACT is 0 (none) or 1 (gelu_pk)");
    bf16_t* O; int ldc; const float* bias; int split_cols; size_t split_stride; float scale0;
    __device__ __forceinline__ void operator()(const f32x4 (&acc)[2][2][4][2], const Unit& u, int wr, int wc, int fr, int fq) const {
        const int row0 = u.pm * BM + wr * 64 + fr; int colt = u.pn * BM; bf16_t* base = O;
        float sc = 1.f; if (split_cols) { const int t = colt / split_cols; base += (size_t)t * split_stride; colt -= t * split_cols; if (t == 0) sc = scale0; }
        const int col0 = colt + wc * 32 + 8 * fq, bcol0 = u.pn * BM + wc * 32 + 8 * fq;
        f32x4 bv[2][2];
#pragma unroll
        for (int bj = 0; bj < 2; ++bj)
#pragma unroll
            for (int n = 0; n < 2; ++n) bv[bj][n] = bias ? *(const f32x4*)(bias + bcol0 + bj * HALF + 4 * n) : (f32x4){0.f, 0.f, 0.f, 0.f};
#pragma unroll
        for (int ai = 0; ai < 2; ++ai)
#pragma unroll
            for (int m = 0; m < 4; ++m) { bf16_t* rowp = base + (size_t)(row0 + ai * HALF + m * 16) * ldc + col0;
#pragma unroll
                for (int bj = 0; bj < 2; ++bj) { f32x4 v0 = acc[ai][bj][m][0] + bv[bj][0], v1 = acc[ai][bj][m][1] + bv[bj][1];
                    if (ACT == 1) { f32x2 a = gelu_pk((f32x2){v0[0], v0[1]}), b = gelu_pk((f32x2){v0[2], v0[3]}), c = gelu_pk((f32x2){v1[0], v1[1]}), d = gelu_pk((f32x2){v1[2], v1[3]});
                        v0 = (f32x4){a.x, a.y, b.x, b.y}; v1 = (f32x4){c.x, c.y, d.x, d.y}; }
                    v0 = v0 * sc; v1 = v1 * sc; u32x4 w; w.x = cvt_pk_bf16(v0[0], v0[1]); w.y = cvt_pk_bf16(v0[2], v0[3]); w.z = cvt_pk_bf16(v1[0], v1[1]); w.w = cvt_pk_bf16(v1[2], v1[3]);
                    *(u32x4*)(rowp + bj * HALF) = w; } }
    }
};

template <class Epi, class Sched, bool ALIGN_EPI = false, bool SP2 = false>
__device__ __forceinline__ void gemm_phase(PG8_LAS unsigned char* lds, const Gemm g, const Sched& S, const Epi& E) {
    const int tid = threadIdx.x, wid = __builtin_amdgcn_readfirstlane(tid >> 6), lane = tid & 63, wr = wid >> 2, wc = wid & 3, fr = lane & 15, fq = lane >> 4;
    const int K = g.K, nt = K / BK;
    unsigned voffA[2], voffB[2];
#pragma unroll
    for (int i = 0; i < 2; ++i) { int R, C; stage_rc(tid * 16 + i * 8192, R, C); const int Rb = Epi::PERM ? ((R & ~31) + perm32(R & 31)) : R;
        voffA[i] = (unsigned)(R * K + C) * 2u; voffB[i] = (unsigned)(Rb * K + C) * 2u; }
    const size_t kstep = (size_t)(BK * 2);
    const size_t hstep = (size_t)HALF * K * 2;
    const size_t tstep = 2 * hstep;
    const unsigned ldsw = (unsigned)wid * 1024u;
    const int aoff = lds_byte(wr * 64 + fr, fq * 8), boff = lds_byte(wc * 32 + fr, fq * 8);
#define PG8_SA(b, h) (((b) * 2 + (h)) * HTB)
#define PG8_SB(b, h) ((4 + (b) * 2 + (h)) * HTB)
#define PG8_STAGE(bufoff, gbase, voff) do { _Pragma("unroll") for (int _i = 0; _i < 2; ++_i) \
        __builtin_amdgcn_global_load_lds((const unsigned*)((const char*)(gbase) + (voff)[_i]), (PG8_LAS unsigned*)(lds + (bufoff) + ldsw + _i * 8192), 16, 0, 0); } while (0)
#define PG8_LDA(dst, b, h) do { _Pragma("unroll") for (int m = 0; m < 4; ++m) _Pragma("unroll") for (int k = 0; k < 2; ++k) dst[m][k] = *(const PG8_LAS bf16x8*)(lds + PG8_SA(b, h) + aoff + m * 2048 + k * 1024); } while (0)
#define PG8_LDB(dst, b, h) do { _Pragma("unroll") for (int n = 0; n < 2; ++n) _Pragma("unroll") for (int k = 0; k < 2; ++k) dst[n][k] = *(const PG8_LAS bf16x8*)(lds + PG8_SB(b, h) + boff + n * 2048 + k * 1024); } while (0)
#define PG8_MMA(ai, bj, At, Bt) do { __builtin_amdgcn_s_setprio(1); _Pragma("unroll") for (int m = 0; m < 4; ++m) _Pragma("unroll") for (int n = 0; n < 2; ++n) _Pragma("unroll") for (int k = 0; k < 2; ++k) \
        acc[ai][bj][m][n] = __builtin_amdgcn_mfma_f32_16x16x32_bf16(Bt[n][k], At[m][k], acc[ai][bj][m][n], 0, 0, 0); __builtin_amdgcn_s_setprio(0); } while (0)
#define PG8_WAIT_V(n) asm volatile("s_waitcnt vmcnt(" #n ")" ::: "memory")
#define PG8_WAIT_L(n) asm volatile("s_waitcnt lgkmcnt(" #n ")" ::: "memory")
#define PG8_BAR __builtin_amdgcn_s_barrier()
#define PG8_SCHED __builtin_amdgcn_sched_barrier(0)
    Unit cur, nxt; int ui = 0;
    if (!S.next(0, cur)) return;
    f32x4 acc[2][2][4][2];
#pragma unroll
    for (int a = 0; a < 2; ++a)
#pragma unroll
        for (int b = 0; b < 2; ++b)
#pragma unroll
            for (int m = 0; m < 4; ++m)
#pragma unroll
                for (int n = 0; n < 2; ++n) acc[a][b][m][n] = (f32x4){0.f, 0.f, 0.f, 0.f};
    bf16x8 At[4][2], B0[2][2], B1[2][2];
    const char* cA = (const char*)g.A + (size_t)cur.pm * tstep; const char* cB = (const char*)g.Bt + (size_t)cur.pn * tstep;
    S.a_ready(cur);
    if constexpr (SP2) {
        PG8_STAGE(PG8_SB(0, 0), cB, voffB); PG8_STAGE(PG8_SB(0, 1), cB + hstep, voffB); PG8_STAGE(PG8_SA(0, 0), cA, voffA); PG8_STAGE(PG8_SA(0, 1), cA + hstep, voffA);
        if (wr == 1) PG8_BAR;
        PG8_WAIT_V(2); PG8_BAR;
        PG8_STAGE(PG8_SB(1, 0), cB + kstep, voffB); PG8_STAGE(PG8_SA(1, 0), cA + kstep, voffA); PG8_STAGE(PG8_SB(1, 1), cB + hstep + kstep, voffB);
        PG8_WAIT_V(6); PG8_BAR;
    } else {
        PG8_STAGE(PG8_SB(0, 0), cB, voffB); PG8_STAGE(PG8_SA(0, 0), cA, voffA); PG8_STAGE(PG8_SB(0, 1), cB + hstep, voffB); PG8_STAGE(PG8_SA(0, 1), cA + hstep, voffA);
        if (wr == 1) PG8_BAR;
        PG8_WAIT_V(4); PG8_BAR;
        PG8_STAGE(PG8_SB(1, 0), cB + kstep, voffB); PG8_STAGE(PG8_SA(1, 0), cA + kstep, voffA); PG8_STAGE(PG8_SB(1, 1), cB + hstep + kstep, voffB);
        PG8_WAIT_V(6); PG8_BAR;
    }
    for (;;) {
        const bool has_next = S.next(ui + 1, nxt);
        const char* nA = has_next ? (const char*)g.A + (size_t)nxt.pm * tstep : cA; const char* nB = has_next ? (const char*)g.Bt + (size_t)nxt.pn * tstep : cB;
        for (int t = 0; t < nt; t += 2) {
            const bool last = (t == nt - 2);
            const char* a1 = cA + (size_t)(t + 1) * kstep;
            const char* a2 = last ? nA : cA + (size_t)(t + 2) * kstep; const char* b2 = last ? nB : cB + (size_t)(t + 2) * kstep;
            const char* a3 = a2 + kstep; const char* b3 = b2 + kstep;
            if (last && has_next) S.a_ready(nxt);
            if constexpr (SP2) {
            PG8_LDB(B0, 0, 0); PG8_LDB(B1, 0, 1); PG8_SCHED; PG8_LDA(At, 0, 0); PG8_STAGE(PG8_SA(1, 1), a1 + hstep, voffA);
            PG8_WAIT_V(8); PG8_WAIT_L(0); PG8_BAR; PG8_MMA(0, 0, At, B0); PG8_MMA(0, 1, At, B1); PG8_BAR; PG8_SCHED;
            PG8_LDA(At, 0, 1); PG8_STAGE(PG8_SB(0, 0), b2, voffB); PG8_STAGE(PG8_SB(0, 1), b2 + hstep, voffB); PG8_STAGE(PG8_SA(0, 0), a2, voffA);
            PG8_WAIT_V(8); PG8_WAIT_L(0); PG8_BAR; PG8_MMA(1, 0, At, B0); PG8_MMA(1, 1, At, B1); PG8_BAR; PG8_SCHED;
            PG8_LDB(B0, 1, 0); PG8_LDB(B1, 1, 1); PG8_SCHED; PG8_LDA(At, 1, 0); PG8_STAGE(PG8_SA(0, 1), a2 + hstep, voffA);
            PG8_WAIT_V(8); PG8_WAIT_L(0); PG8_BAR; PG8_MMA(0, 0, At, B0); PG8_MMA(0, 1, At, B1); PG8_BAR; PG8_SCHED;
            PG8_LDA(At, 1, 1); PG8_STAGE(PG8_SB(1, 0), b3, voffB); PG8_STAGE(PG8_SB(1, 1), b3 + hstep, voffB); PG8_STAGE(PG8_SA(1, 0), a3, voffA);
            PG8_WAIT_V(8); PG8_WAIT_L(0); PG8_BAR; PG8_MMA(1, 0, At, B0); PG8_MMA(1, 1, At, B1); PG8_BAR; PG8_SCHED;
            } else {
            PG8_LDB(B0, 0, 0); PG8_SCHED; PG8_LDA(At, 0, 0); PG8_STAGE(PG8_SA(1, 1), a1 + hstep, voffA);
            PG8_WAIT_L(8); PG8_BAR; PG8_WAIT_L(0); PG8_MMA(0, 0, At, B0); PG8_BAR; PG8_SCHED;
            PG8_LDB(B1, 0, 1); PG8_STAGE(PG8_SB(0, 0), b2, voffB);
            PG8_BAR; PG8_WAIT_L(0); PG8_MMA(0, 1, At, B1); PG8_BAR;
            PG8_LDA(At, 0, 1); PG8_STAGE(PG8_SA(0, 0), a2, voffA);
            PG8_BAR; PG8_WAIT_L(0); PG8_MMA(1, 0, At, B0); PG8_BAR; PG8_SCHED;
            PG8_STAGE(PG8_SB(0, 1), b2 + hstep, voffB);
            PG8_WAIT_V(6); PG8_BAR; PG8_MMA(1, 1, At, B1); PG8_BAR;
            PG8_LDB(B0, 1, 0); PG8_SCHED; PG8_LDA(At, 1, 0); PG8_STAGE(PG8_SA(0, 1), a2 + hstep, voffA);
            PG8_WAIT_L(8); PG8_BAR; PG8_WAIT_L(0); PG8_MMA(0, 0, At, B0); PG8_BAR; PG8_SCHED;
            PG8_LDB(B1, 1, 1); PG8_STAGE(PG8_SB(1, 0), b3, voffB);
            PG8_BAR; PG8_WAIT_L(0); PG8_MMA(0, 1, At, B1); PG8_BAR;
            PG8_LDA(At, 1, 1); PG8_STAGE(PG8_SA(1, 0), a3, voffA);
            PG8_BAR; PG8_WAIT_L(0); PG8_MMA(1, 0, At, B0); PG8_BAR; PG8_SCHED;
            PG8_STAGE(PG8_SB(1, 1), b3 + hstep, voffB);
            PG8_WAIT_V(6); PG8_BAR; PG8_MMA(1, 1, At, B1); PG8_BAR;
            }
        }
        if constexpr (ALIGN_EPI) { if (wr == 0) PG8_BAR; }
        if constexpr (!Epi::AFTER_DRAIN) { E(acc, cur, wr, wc, fr, fq); S.done(cur); }
        if (!has_next) break;
#pragma unroll
        for (int a = 0; a < 2; ++a)
#pragma unroll
            for (int b = 0; b < 2; ++b)
#pragma unroll
                for (int m = 0; m < 4; ++m)
#pragma unroll
                    for (int n = 0; n < 2; ++n) acc[a][b][m][n] = (f32x4){0.f, 0.f, 0.f, 0.f};
        cur = nxt; cA = nA; cB = nB; ++ui;
        if constexpr (ALIGN_EPI) { if (wr == 1) PG8_BAR; }
    }
    PG8_WAIT_V(0);
    if constexpr (!ALIGN_EPI) { if (wr == 0) PG8_BAR; }
    PG8_BAR;
    if constexpr (Epi::AFTER_DRAIN) { E.fused(acc, cur, wr, wc, fr, fq, lds, wid, lane); S.done(cur); }
#undef PG8_SA
#undef PG8_SB
#undef PG8_STAGE
#undef PG8_LDA
#undef PG8_LDB
#undef PG8_MMA
#undef PG8_WAIT_V
#undef PG8_WAIT_L
#undef PG8_BAR
#undef PG8_SCHED
}
}
#define LAS __attribute__((address_space(3)))
typedef unsigned short bf16;
typedef unsigned v4u __attribute__((ext_vector_type(4)));
typedef unsigned v2u __attribute__((ext_vector_type(2)));
typedef float f32x4 __attribute__((ext_vector_type(4)));
typedef short bf16x8 __attribute__((ext_vector_type(8)));
typedef short s16x4 __attribute__((ext_vector_type(4)));
typedef float f32x16 __attribute__((ext_vector_type(16)));
constexpr int DM = 1024, NB = 8, SEQ = 4096, MTOK = NB * SEQ, NIN = 4616, NPROJ = 4608, PLE = 256;
constexpr int C_SBQ = 0, C_SBK = 512, C_SBV = 1024, C_SBZ = 1536, C_MLQ = 2048, C_MLK = 2560, C_MLV = 3072, C_MLO = 3584, C_MLZ = 4096;
constexpr float EPS = 1e-6f;
constexpr size_t MiB = 1u << 20;
constexpr size_t WS_WIN = 1 * MiB, WS_WOUT = 10 * MiB, WS_WGATE = 12 * MiB, WS_WUP = 14 * MiB, WS_GATES = 15 * MiB;
constexpr size_t WS_U = 16 * MiB;
constexpr size_t WS_PROJ = 80 * MiB;
constexpr size_t WS_PU = 368 * MiB, WS_PB = 432 * MiB, WS_QKC = 448 * MiB, WS_END = 512 * MiB;
constexpr int LDS_BYTES = 147456;

__device__ __forceinline__ unsigned f2bf(float f) { unsigned u = __builtin_bit_cast(unsigned, f); return (u + 0x7fffu + ((u >> 16) & 1u)) >> 16; }
__device__ __forceinline__ unsigned pk2(float lo, float hi) { return f2bf(lo) | (f2bf(hi) << 16); }
__device__ __forceinline__ float bflo(unsigned w) { return __builtin_bit_cast(float, w << 16); }
__device__ __forceinline__ float bfhi(unsigned w) { return __builtin_bit_cast(float, w & 0xffff0000u); }
__device__ __forceinline__ float bf1(bf16 v) { return __builtin_bit_cast(float, ((unsigned)v) << 16); }
__device__ __forceinline__ float wave_sum(float v) {
#pragma unroll
    for (int o = 1; o < 64; o <<= 1) v += __shfl_xor(v, o);
    return v;
}
__device__ __forceinline__ float sigmoidf_(float x) { return 1.f / (1.f + __expf(-x)); }
__device__ __forceinline__ float siluf_(float x) { return x / (1.f + __expf(-x)); }
#define LDS_WAIT() asm volatile("s_waitcnt lgkmcnt(0)" ::: "memory")

__device__ __forceinline__ void p0_transpose_item(const float* W, int K, int pitch, int nblk, bf16* WT, LAS float* scr, int item, int lane) {
    const int kb = item / nblk, nb = item % nblk, k0 = 64 * kb, n0 = 32 * nb;
#pragma unroll 8
    for (int i = 0; i < 32; ++i) { const int kk = 2 * i + (lane >> 5); scr[kk * 33 + (lane & 31)] = W[(size_t)(k0 + kk) * pitch + n0 + (lane & 31)]; }
    LDS_WAIT(); asm volatile("" ::: "memory");
    const int c = lane & 7;
#pragma unroll
    for (int j = 0; j < 4; ++j) { const int n = (lane >> 3) + 8 * j; const LAS float* s = scr + (8 * c) * 33 + n;
        v4u o; o.x = pk2(s[0 * 33], s[1 * 33]); o.y = pk2(s[2 * 33], s[3 * 33]); o.z = pk2(s[4 * 33], s[5 * 33]); o.w = pk2(s[6 * 33], s[7 * 33]);
        *(v4u*)(WT + (size_t)(n0 + n) * K + k0 + 8 * c) = o; }
    LDS_WAIT(); asm volatile("" ::: "memory");
}

struct EpiGate {
    static constexpr bool PERM = true, AFTER_DRAIN = false;
    float* out; const bf16* pu; const float* bias;
    __device__ __forceinline__ void operator()(const pg8::f32x4 (&acc)[2][2][4][2], const pg8::Unit& u, int wr, int wc, int fr, int fq) const {
        const int row0 = u.pm * 256 + wr * 64 + fr, col0 = u.pn * 256 + wc * 32 + 8 * fq;
#pragma unroll
        for (int ai = 0; ai < 2; ++ai)
#pragma unroll
            for (int m = 0; m < 4; ++m) { const size_t ro = (size_t)(row0 + ai * 128 + m * 16) * DM;
#pragma unroll
                for (int bj = 0; bj < 2; ++bj) { const int c = col0 + bj * 128;
                    const f32x4 b0 = *(const f32x4*)(bias + c), b1 = *(const f32x4*)(bias + c + 4);
                    const f32x4 h0 = *(const f32x4*)(out + ro + c), h1 = *(const f32x4*)(out + ro + c + 4);
                    const v4u pw = *(const v4u*)(pu + ro + c);
                    const f32x4 v0 = acc[ai][bj][m][0] + b0, v1 = acc[ai][bj][m][1] + b1;
                    f32x4 o0, o1;
                    o0[0] = h0[0] + sigmoidf_(v0[0]) * bflo(pw.x); o0[1] = h0[1] + sigmoidf_(v0[1]) * bfhi(pw.x);
                    o0[2] = h0[2] + sigmoidf_(v0[2]) * bflo(pw.y); o0[3] = h0[3] + sigmoidf_(v0[3]) * bfhi(pw.y);
                    o1[0] = h1[0] + sigmoidf_(v1[0]) * bflo(pw.z); o1[1] = h1[1] + sigmoidf_(v1[1]) * bfhi(pw.z);
                    o1[2] = h1[2] + sigmoidf_(v1[2]) * bflo(pw.w); o1[3] = h1[3] + sigmoidf_(v1[3]) * bfhi(pw.w);
                    *(f32x4*)(out + ro + c) = o0; *(f32x4*)(out + ro + c + 4) = o1; } }
    }
};

struct Args { const float* in[15]; float* out; unsigned char* ws; };
struct Ctx {
    LAS unsigned char* lds; int tid, lane, wave, gw, NGW;
    const float *x, *p, *pre_w, *w_in, *conv_w, *conv_b, *i_bias, *f_bias, *sb_w, *ml_w, *w_out, *post_w, *w_up, *w_gate, *b_gate;
    float* out; bf16 *WT_IN, *WT_OUT, *WT_GATE, *WT_UP, *U, *Y, *HB, *PROJ, *Y2, *PU, *PB, *QKC; float* GATES;
};

__device__ __forceinline__ void phase0(Ctx& F) {
    {
        LAS float* scr = (LAS float*)(F.lds + F.wave * 16384);
        constexpr int I_IN = 16 * 144, I_O = 16 * 32, I_G = 16 * 32, I_U = 4 * 32, NIT = I_IN + I_O + I_G + I_U;
        for (int it = F.gw; it < NIT; it += F.NGW) {
            int r = it;
            if (r < I_IN) { p0_transpose_item(F.w_in, DM, NIN, 144, F.WT_IN, scr, r, F.lane); continue; } r -= I_IN;
            if (r < I_O) { p0_transpose_item(F.w_out, DM, DM, 32, F.WT_OUT, scr, r, F.lane); continue; } r -= I_O;
            if (r < I_G) { p0_transpose_item(F.w_gate, DM, DM, 32, F.WT_GATE, scr, r, F.lane); continue; } r -= I_G;
            p0_transpose_item(F.w_up, PLE, DM, 32, F.WT_UP, scr, r, F.lane);
        }
    }
    __syncthreads();
    LAS float* Wg = (LAS float*)F.lds;
    for (int e = F.tid; e < 1024 * 8; e += 512) Wg[e] = F.w_in[(size_t)(e >> 3) * NIN + NPROJ + (e & 7)];
    __syncthreads();
    for (int m = F.gw; m < MTOK; m += F.NGW) {
        const f32x4* xr = (const f32x4*)(F.x + (size_t)m * DM) + F.lane;
        f32x4 v[4]; float s = 0.f;
#pragma unroll
        for (int j = 0; j < 4; ++j) { v[j] = xr[64 * j]; s += (v[j].x * v[j].x + v[j].y * v[j].y) + (v[j].z * v[j].z + v[j].w * v[j].w); }
        const float rstd = 1.0f / sqrtf(wave_sum(s) * (1.f / DM) + EPS);
        float g[8];
#pragma unroll
        for (int i = 0; i < 8; ++i) g[i] = 0.f;
        unsigned long long* o8 = (unsigned long long*)(F.U + (size_t)m * DM) + F.lane;
#pragma unroll
        for (int j = 0; j < 4; ++j) {
            const f32x4 w = *((const f32x4*)F.pre_w + F.lane + 64 * j);
            const f32x4 u = v[j] * rstd * w;
            o8[64 * j] = (unsigned long long)pk2(u.x, u.y) | ((unsigned long long)pk2(u.z, u.w) << 32);
#pragma unroll
            for (int e = 0; e < 4; ++e) { const LAS f32x4* wg = (const LAS f32x4*)(Wg + (256 * j + 4 * F.lane + e) * 8); const f32x4 a = wg[0], b = wg[1]; const float ue = u[e];
                g[0] += ue * a.x; g[1] += ue * a.y; g[2] += ue * a.z; g[3] += ue * a.w; g[4] += ue * b.x; g[5] += ue * b.y; g[6] += ue * b.z; g[7] += ue * b.w; }
        }
#pragma unroll
        for (int i = 0; i < 8; ++i) g[i] = wave_sum(g[i]);
        if (F.lane == 0) {
            f32x4 gi, gf;
#pragma unroll
            for (int i = 0; i < 4; ++i) { gi[i] = g[i] + F.i_bias[i]; const float fp = g[4 + i] + F.f_bias[i];
                gf[i] = fp >= 0.f ? -log1pf(expf(-fp)) : fp - log1pf(expf(fp)); }
            *(f32x4*)(F.GATES + (size_t)m * 8) = gi; *(f32x4*)(F.GATES + (size_t)m * 8 + 4) = gf;
        }
    }
    for (size_t e = (size_t)(blockIdx.x * 512 + F.tid) * 8; e < (size_t)MTOK * PLE; e += (size_t)gridDim.x * 512 * 8) {
        const f32x4 a = *(const f32x4*)(F.p + e), b = *(const f32x4*)(F.p + e + 4);
        v4u o; o.x = pk2(a.x, a.y); o.y = pk2(a.z, a.w); o.z = pk2(b.x, b.y); o.w = pk2(b.z, b.w);
        *(v4u*)(F.PB + e) = o;
    }
}

__device__ __forceinline__ void phase_conv(Ctx& F) {
    const size_t NITEM = (size_t)MTOK * 128;
    for (size_t it = (size_t)blockIdx.x * 512 + F.tid; it < NITEM; it += (size_t)gridDim.x * 512) {
        const int row = (int)(it >> 7), c0 = (int)(it & 127) * 8, t = row & (SEQ - 1);
        float acc[8];
#pragma unroll
        for (int e = 0; e < 8; ++e) acc[e] = F.conv_b[c0 + e];
#pragma unroll
        for (int j = 0; j < 4; ++j) {
            if (t - 3 + j < 0) continue;
            const v4u r = *(const v4u*)(F.PROJ + (size_t)(row - 3 + j) * NPROJ + C_MLQ + c0);
            const f32x4 w0 = *(const f32x4*)(F.conv_w + j * 1024 + c0), w1 = *(const f32x4*)(F.conv_w + j * 1024 + c0 + 4);
            acc[0] += w0.x * bflo(r.x); acc[1] += w0.y * bfhi(r.x); acc[2] += w0.z * bflo(r.y); acc[3] += w0.w * bfhi(r.y);
            acc[4] += w1.x * bflo(r.z); acc[5] += w1.y * bfhi(r.z); acc[6] += w1.z * bflo(r.w); acc[7] += w1.w * bfhi(r.w);
        }
        const float sc = c0 >= 512 ? 0.08838834764831845f : 1.0f;
#pragma unroll
        for (int e = 0; e < 8; ++e) acc[e] = siluf_(acc[e]) * sc;
        v4u o; o.x = pk2(acc[0], acc[1]); o.y = pk2(acc[2], acc[3]); o.z = pk2(acc[4], acc[5]); o.w = pk2(acc[6], acc[7]);
        *(v4u*)(F.QKC + (size_t)row * 1024 + c0) = o;
    }
}

__device__ __forceinline__ void phase_norm(Ctx& F) {
    for (int m = F.gw; m < MTOK; m += F.NGW) {
        const v4u* yr = (const v4u*)(F.Y2 + (size_t)m * DM) + F.lane;
        float y[16]; float s = 0.f;
#pragma unroll
        for (int j = 0; j < 2; ++j) { const v4u r = yr[64 * j];
            y[8 * j + 0] = bflo(r.x); y[8 * j + 1] = bfhi(r.x); y[8 * j + 2] = bflo(r.y); y[8 * j + 3] = bfhi(r.y);
            y[8 * j + 4] = bflo(r.z); y[8 * j + 5] = bfhi(r.z); y[8 * j + 6] = bflo(r.w); y[8 * j + 7] = bfhi(r.w); }
#pragma unroll
        for (int e = 0; e < 16; ++e) s += y[e] * y[e];
        const float rstd = 1.0f / sqrtf(wave_sum(s) * (1.f / DM) + EPS);
#pragma unroll
        for (int j = 0; j < 2; ++j) {
            const int c = 512 * j + 8 * F.lane; const size_t o = (size_t)m * DM + c;
            const f32x4 x0 = *(const f32x4*)(F.x + o), x1 = *(const f32x4*)(F.x + o + 4);
            const f32x4 w0 = *(const f32x4*)(F.post_w + c), w1 = *(const f32x4*)(F.post_w + c + 4);
            f32x4 h0, h1;
#pragma unroll
            for (int e = 0; e < 4; ++e) { h0[e] = x0[e] + y[8 * j + e] * rstd * w0[e]; h1[e] = x1[e] + y[8 * j + 4 + e] * rstd * w1[e]; }
            *(f32x4*)(F.out + o) = h0; *(f32x4*)(F.out + o + 4) = h1;
            v4u hb; hb.x = pk2(h0[0], h0[1]); hb.y = pk2(h0[2], h0[3]); hb.z = pk2(h1[0], h1[1]); hb.w = pk2(h1[2], h1[3]);
            *(v4u*)(F.HB + o) = hb;
        }
    }
}
__device__ __forceinline__ void attn_naive(Ctx& F) {
    constexpr float QS = 0.125f * 1.4426950408889634f;
    for (int unit = F.gw; unit < NB * 8 * (SEQ / 64); unit += F.NGW) {
        const int bh = unit >> 6, qb = unit & 63, b = bh >> 3, h = bh & 7, t = qb * 64 + F.lane;
        const size_t row = (size_t)b * SEQ + t;
        float q[64], o[64];
#pragma unroll
        for (int c = 0; c < 8; ++c) { const v4u r = *(const v4u*)(F.PROJ + row * NPROJ + C_SBQ + h * 64 + 8 * c);
            q[8 * c + 0] = bflo(r.x) * QS; q[8 * c + 1] = bfhi(r.x) * QS; q[8 * c + 2] = bflo(r.y) * QS; q[8 * c + 3] = bfhi(r.y) * QS;
            q[8 * c + 4] = bflo(r.z) * QS; q[8 * c + 5] = bfhi(r.z) * QS; q[8 * c + 6] = bflo(r.w) * QS; q[8 * c + 7] = bfhi(r.w) * QS; }
#pragma unroll
        for (int d = 0; d < 64; ++d) o[d] = 0.f;
        float R = 0.f;
        for (int s = qb * 64 + 62; s >= 0; --s) {
            const bf16* kr = F.PROJ + ((size_t)b * SEQ + s) * NPROJ + C_SBK + h * 64;
            const bf16* vr = F.PROJ + ((size_t)b * SEQ + s) * NPROJ + C_SBV + h * 64;
            float z = 0.f;
#pragma unroll
            for (int c = 0; c < 8; ++c) { const v4u r = *(const v4u*)(kr + 8 * c);
                z += q[8 * c + 0] * bflo(r.x) + q[8 * c + 1] * bfhi(r.x) + q[8 * c + 2] * bflo(r.y) + q[8 * c + 3] * bfhi(r.y)
                   + q[8 * c + 4] * bflo(r.z) + q[8 * c + 5] * bfhi(r.z) + q[8 * c + 6] * bflo(r.w) + q[8 * c + 7] * bfhi(r.w); }
            const bool valid = s < t;
            const float lk = -(fmaxf(z, 0.f) + __log2f(1.f + exp2f(-fabsf(z))));
            R += valid ? lk : 0.f;
            const float a = valid ? exp2f(z + R) : 0.f;
#pragma unroll
            for (int c = 0; c < 8; ++c) { const v4u r = *(const v4u*)(vr + 8 * c);
                o[8 * c + 0] += a * bflo(r.x); o[8 * c + 1] += a * bfhi(r.x); o[8 * c + 2] += a * bflo(r.y); o[8 * c + 3] += a * bfhi(r.y);
                o[8 * c + 4] += a * bflo(r.z); o[8 * c + 5] += a * bfhi(r.z); o[8 * c + 6] += a * bflo(r.w); o[8 * c + 7] += a * bfhi(r.w); }
        }
        float ss = 0.f;
#pragma unroll
        for (int d = 0; d < 64; ++d) ss += o[d] * o[d];
        const float rstd = 1.0f / sqrtf(ss * (1.f / 64.f) + EPS);
#pragma unroll
        for (int c = 0; c < 8; ++c) { const v4u zr = *(const v4u*)(F.PROJ + row * NPROJ + C_SBZ + h * 64 + 8 * c);
            const f32x4 w0 = *(const f32x4*)(F.sb_w + h * 64 + 8 * c), w1 = *(const f32x4*)(F.sb_w + h * 64 + 8 * c + 4);
            v4u ov;
            ov.x = pk2(o[8 * c + 0] * rstd * w0.x * siluf_(bflo(zr.x)), o[8 * c + 1] * rstd * w0.y * siluf_(bfhi(zr.x)));
            ov.y = pk2(o[8 * c + 2] * rstd * w0.z * siluf_(bflo(zr.y)), o[8 * c + 3] * rstd * w0.w * siluf_(bfhi(zr.y)));
            ov.z = pk2(o[8 * c + 4] * rstd * w1.x * siluf_(bflo(zr.z)), o[8 * c + 5] * rstd * w1.y * siluf_(bfhi(zr.z)));
            ov.w = pk2(o[8 * c + 6] * rstd * w1.z * siluf_(bflo(zr.w)), o[8 * c + 7] * rstd * w1.w * siluf_(bfhi(zr.w)));
            *(v4u*)(F.Y + row * DM + h * 64 + 8 * c) = ov; }
    }
}
__device__ __forceinline__ void mlstm_naive(Ctx& F) {
    LAS float* red = (LAS float*)F.lds;
    for (int unit = blockIdx.x; unit < NB * 4; unit += gridDim.x) {
        const int b = unit >> 2, h = unit & 3, v = F.tid >> 2, dq = F.tid & 3, d0 = dq * 32;
        float C[32], n[32]; float m = 0.f;
#pragma unroll
        for (int j = 0; j < 32; ++j) { C[j] = 0.f; n[j] = 0.f; }
        const float nw = F.ml_w[h * 128 + v];
        __syncthreads();
        for (int t = 0; t < SEQ; ++t) {
            const size_t row = (size_t)b * SEQ + t;
            const float ig = F.GATES[row * 8 + h], lf = F.GATES[row * 8 + 4 + h];
            const float m_new = fmaxf(lf + m, ig), fa = expf(lf + m - m_new), ia = expf(ig - m_new);
            const float vv = bf1(F.PROJ[row * NPROJ + C_MLV + h * 128 + v]) * ia;
            float num = 0.f, den = 0.f;
#pragma unroll
            for (int c = 0; c < 4; ++c) {
                const v4u kr = *(const v4u*)(F.QKC + row * 1024 + 512 + h * 128 + d0 + 8 * c);
                const v4u qr = *(const v4u*)(F.QKC + row * 1024 + h * 128 + d0 + 8 * c);
                const float kk[8] = {bflo(kr.x), bfhi(kr.x), bflo(kr.y), bfhi(kr.y), bflo(kr.z), bfhi(kr.z), bflo(kr.w), bfhi(kr.w)};
                const float qq[8] = {bflo(qr.x), bfhi(qr.x), bflo(qr.y), bfhi(qr.y), bflo(qr.z), bfhi(qr.z), bflo(qr.w), bfhi(qr.w)};
#pragma unroll
                for (int e = 0; e < 8; ++e) { const int j = 8 * c + e;
                    C[j] = fa * C[j] + vv * kk[e]; n[j] = fa * n[j] + ia * kk[e]; num += C[j] * qq[e]; den += n[j] * qq[e]; }
            }
            num += __shfl_xor(num, 1); num += __shfl_xor(num, 2); den += __shfl_xor(den, 1); den += __shfl_xor(den, 2);
            const float hv = num / fmaxf(fabsf(den), expf(-m_new));
            m = m_new;
            const float yv = sigmoidf_(bf1(F.PROJ[row * NPROJ + C_MLO + h * 128 + v])) * hv;
            const float sq = wave_sum(dq == 0 ? yv * yv : 0.f);
            if (F.lane == 0) red[(t & 1) * 8 + F.wave] = sq;
            __syncthreads();
            float tot = 0.f;
#pragma unroll
            for (int w = 0; w < 8; ++w) tot += red[(t & 1) * 8 + w];
            const float rstd = 1.0f / sqrtf(tot * (1.f / 128.f) + EPS);
            if (dq == 0) F.Y[row * DM + 512 + h * 128 + v] = (bf16)f2bf(yv * rstd * nw * siluf_(bf1(F.PROJ[row * NPROJ + C_MLZ + h * 128 + v])));
        }
    }
}
#define MIXERS(F) do { attn_naive(F); mlstm_naive(F); } while (0)
__global__ void __launch_bounds__(512, 2) fwd_kernel(Args args) {
    extern __shared__ __attribute__((aligned(16))) unsigned char lds_raw[];
    cg::grid_group grid = cg::this_grid();
    Ctx F;
    F.lds = (LAS unsigned char*)lds_raw;
    F.tid = threadIdx.x; F.lane = F.tid & 63; F.wave = __builtin_amdgcn_readfirstlane(F.tid >> 6);
    F.gw = blockIdx.x * 8 + F.wave; F.NGW = gridDim.x * 8;
    F.x = args.in[0]; F.p = args.in[1]; F.pre_w = args.in[2]; F.w_in = args.in[3]; F.conv_w = args.in[4]; F.conv_b = args.in[5]; F.i_bias = args.in[6]; F.f_bias = args.in[7];
    F.sb_w = args.in[8]; F.ml_w = args.in[9]; F.w_out = args.in[10]; F.post_w = args.in[11]; F.w_up = args.in[12]; F.w_gate = args.in[13]; F.b_gate = args.in[14];
    F.out = args.out; unsigned char* ws = args.ws;
    F.WT_IN = (bf16*)(ws + WS_WIN); F.WT_OUT = (bf16*)(ws + WS_WOUT); F.WT_GATE = (bf16*)(ws + WS_WGATE); F.WT_UP = (bf16*)(ws + WS_WUP); F.GATES = (float*)(ws + WS_GATES);
    F.U = (bf16*)(ws + WS_U); F.Y = F.U; F.HB = F.U; F.PROJ = (bf16*)(ws + WS_PROJ); F.Y2 = F.PROJ; F.PU = (bf16*)(ws + WS_PU); F.PB = (bf16*)(ws + WS_PB); F.QKC = (bf16*)(ws + WS_QKC);

    phase0(F);
    grid.sync();
    {
        pg8::Gemm g{F.U, F.WT_IN, MTOK, NPROJ, DM}; pg8::StaticOrder S; S.init(MTOK, NPROJ, gridDim.x, blockIdx.x);
        pg8::EpiBf16<0> E{F.PROJ, NPROJ, nullptr, 0, 0, 1.f};
        pg8::gemm_phase<pg8::EpiBf16<0>, pg8::StaticOrder, true, true>(F.lds, g, S, E);
        pg8::Gemm g2{F.PB, F.WT_UP, MTOK, DM, PLE}; pg8::StaticOrder S2; S2.init(MTOK, DM, gridDim.x, blockIdx.x);
        pg8::EpiBf16<0> E2{F.PU, DM, nullptr, 0, 0, 1.f};
        pg8::gemm_phase<pg8::EpiBf16<0>, pg8::StaticOrder, true, true>(F.lds, g2, S2, E2);
    }
    grid.sync();
    phase_conv(F);
    grid.sync();
    MIXERS(F);
    grid.sync();
    {
        pg8::Gemm g{F.Y, F.WT_OUT, MTOK, DM, DM}; pg8::StaticOrder S; S.init(MTOK, DM, gridDim.x, blockIdx.x);
        pg8::EpiBf16<0> E{F.Y2, DM, nullptr, 0, 0, 1.f};
        pg8::gemm_phase<pg8::EpiBf16<0>, pg8::StaticOrder, true, true>(F.lds, g, S, E);
    }
    grid.sync();
    phase_norm(F);
    grid.sync();
    {
        pg8::Gemm g{F.HB, F.WT_GATE, MTOK, DM, DM}; pg8::StaticOrder S; S.init(MTOK, DM, gridDim.x, blockIdx.x);
        EpiGate E{F.out, F.PU, F.b_gate};
        pg8::gemm_phase<EpiGate, pg8::StaticOrder, true, true>(F.lds, g, S, E);
    }
}

extern "C" void kernel_launch(void* const* d_in, const int* in_sizes, int n_in, void* d_out, int out_size, void* d_ws, size_t ws_size, hipStream_t stream) {
    static int grid = 0;
    if (grid == 0) {
        if (n_in != 15 || out_size != MTOK * DM || ws_size < WS_END) { fprintf(stderr, "kernel_launch: unexpected shapes (n_in %d out %d ws %zu)\n", n_in, out_size, ws_size); grid = -1; return; }
        int dev = 0, cus = 0, per_cu = 0;
        (void)hipGetDevice(&dev); (void)hipDeviceGetAttribute(&cus, hipDeviceAttributeMultiprocessorCount, dev);
        if (hipFuncSetAttribute((const void*)fwd_kernel, hipFuncAttributeMaxDynamicSharedMemorySize, LDS_BYTES) != hipSuccess) { fprintf(stderr, "kernel_launch: hipFuncSetAttribute failed\n"); grid = -1; return; }
        if (hipOccupancyMaxActiveBlocksPerMultiprocessor(&per_cu, (const void*)fwd_kernel, 512, LDS_BYTES) != hipSuccess || per_cu < 1) { fprintf(stderr, "kernel_launch: occupancy query says %d\n", per_cu); per_cu = 1; }
        (void)hipGetLastError();
        grid = cus * 1;
        if (grid <= 0) grid = 256;
    }
    if (grid < 0) return;
    Args a{};
    for (int i = 0; i < 15; ++i) a.in[i] = (const float*)d_in[i];
    a.out = (float*)d_out; a.ws = (unsigned char*)d_ws;
    void* kargs[] = {&a};
    hipError_t e = hipLaunchCooperativeKernel((const void*)fwd_kernel, dim3(grid), dim3(512), kargs, LDS_BYTES, stream);
    if (e != hipSuccess) fprintf(stderr, "kernel_launch: cooperative launch failed: %s (grid %d)\n", hipGetErrorString(e), grid);
}
```

```cpp
#include <hip/hip_runtime.h>
#include <hip/hip_cooperative_groups.h>
#include <cstdio>
#include <cstdint>
namespace cg = cooperative_groups;
namespace pg8 {
#define PG8_LAS __attribute__((address_space(3)))
typedef unsigned short bf16_t;
typedef short bf16x8 __attribute__((ext_vector_type(8)));
typedef float f32x4 __attribute__((ext_vector_type(4)));
typedef unsigned u32x4 __attribute__((ext_vector_type(4)));
constexpr int BM = 256, BK = 64, HALF = 128, HTB = HALF * BK * 2  , STAGE_BYTES = 8 * HTB, NXCD = 8, WGM = 8;

__host__ __device__ __forceinline__ int lds_byte(int r, int c) { const int st = (r >> 4) * 2 + (c >> 5), rr = r & 15, cc = c & 31, ob = rr * 64 + cc * 2; return st * 1024 + (ob ^ (((ob >> 9) & 1) << 5)); }
__host__ __device__ __forceinline__ void stage_rc(int b, int& R, int& C) { const int st = b / 1024, sb = b % 1024, swz = sb ^ (((sb >> 9) & 1) << 5); R = (st >> 1) * 16 + swz / 64; C = (st & 1) * 32 + (swz % 64) / 2; }
__host__ __device__ __forceinline__ int perm32(int rho) { const int n = rho >> 4, i = rho & 15; return 8 * (i >> 2) + 4 * n + (i & 3); }

struct Unit { int pm, pn; };
struct Gemm { const bf16_t* A; const bf16_t* Bt; int M, N, K; };

struct StaticOrder {
    int nM, nN, nwg, G, c;
    __host__ __device__ void init(int M, int N, int G_, int c_) { nM = M / BM; nN = N / BM; nwg = nM * nN; G = G_; c = c_; }
    __host__ __device__ bool next(int i, Unit& u) const {
        const long L = (long)i * G + c; if (L >= nwg) return false;
        int wgid = (int)L; { const int q = nwg / NXCD, r = nwg % NXCD, xcd = wgid % NXCD, off = wgid / NXCD; wgid = (xcd < r ? xcd * (q + 1) : r * (q + 1) + (xcd - r) * q) + off; }
        const int nig = WGM * nN, gid = wgid / nig, fm = gid * WGM, gsz = (nM - fm) < WGM ? (nM - fm) : WGM;
        u.pm = fm + ((wgid % nig) % gsz); u.pn = (wgid % nig) / gsz; return true;
    }
    __device__ __forceinline__ void a_ready(const Unit&) const {}
    __device__ __forceinline__ void done(const Unit&) const {}
};

__device__ __forceinline__ unsigned cvt_pk_bf16(float lo, float hi) { unsigned r; asm volatile("v_cvt_pk_bf16_f32 %0, %1, %2" : "=v"(r) : "v"(lo), "v"(hi)); return r; }
typedef float f32x2 __attribute__((ext_vector_type(2)));
__device__ __forceinline__ f32x2 gelu_pk(f32x2 v) {
    const f32x2 av = __builtin_elementwise_abs(v), d = av * 0.2316418882f + 1.0f;
    f32x2 t; t.x = __builtin_amdgcn_rcpf(d.x); t.y = __builtin_amdgcn_rcpf(d.y);
    f32x2 q = t * 0.5307027145f + (-0.7265760135f); q = q * t + 0.7107068705f; q = q * t + (-0.142248368f); q = q * t + 0.127414796f; q = q * t;
    const f32x2 s = (v * v) * (-0.72134752044f);
    f32x2 e; e.x = __builtin_amdgcn_exp2f(s.x); e.y = __builtin_amdgcn_exp2f(s.y);
    const f32x2 m = v * (q * e), r = v - m;
    f32x2 o; o.x = v.x < 0.f ? m.x : r.x; o.y = v.y < 0.f ? m.y : r.y; return o;
}

template <int ACT  > struct EpiBf16 {
    static constexpr bool PERM = true, AFTER_DRAIN = false; static_assert(ACT == 0 || ACT == 1, "EpiBf16: ACT is 0 (none) or 1 (gelu_pk)");
    bf16_t* O; int ldc; const float* bias; int split_cols; size_t split_stride; float scale0;
    __device__ __forceinline__ void operator()(const f32x4 (&acc)[2][2][4][2], const Unit& u, int wr, int wc, int fr, int fq) const {
        const int row0 = u.pm * BM + wr * 64 + fr; int colt = u.pn * BM; bf16_t* base = O;
        float sc = 1.f; if (split_cols) { const int t = colt / split_cols; base += (size_t)t * split_stride; colt -= t * split_cols; if (t == 0) sc = scale0; }
        const int col0 = colt + wc * 32 + 8 * fq, bcol0 = u.pn * BM + wc * 32 + 8 * fq;
        f32x4 bv[2][2];
#pragma unroll
        for (int bj = 0; bj < 2; ++bj)
#pragma unroll
            for (int n = 0; n < 2; ++n) bv[bj][n] = bias ? *(const f32x4*)(bias + bcol0 + bj * HALF + 4 * n) : (f32x4){0.f, 0.f, 0.f, 0.f};
#pragma unroll
        for (int ai = 0; ai < 2; ++ai)
#pragma unroll
            for (int m = 0; m < 4; ++m) { bf16_t* rowp = base + (size_t)(row0 + ai * HALF + m * 16) * ldc + col0;
#pragma unroll
                for (int bj = 0; bj < 2; ++bj) { f32x4 v0 = acc[ai][bj][m][0] + bv[bj][0], v1 = acc[ai][bj][m][1] + bv[bj][1];
                    if (ACT == 1) { f32x2 a = gelu_pk((f32x2){v0[0], v0[1]}), b = gelu_pk((f32x2){v0[2], v0[3]}), c = gelu_pk((f32x2){v1[0], v1[1]}), d = gelu_pk((f32x2){v1[2], v1[3]});
                        v0 = (f32x4){a.x, a.y, b.x, b.y}; v1 = (f32x4){c.x, c.y, d.x, d.y}; }
                    v0 = v0 * sc; v1 = v1 * sc; u32x4 w; w.x = cvt_pk_bf16(v0[0], v0[1]); w.y = cvt_pk_bf16(v0[2], v0[3]); w.z = cvt_pk_bf16(v1[0], v1[1]); w.w = cvt_pk_bf16(v1[2], v1[3]);
                    *(u32x4*)(rowp + bj * HALF) = w; } }
    }
};

template <class Epi, class Sched, bool ALIGN_EPI = false, bool SP2 = false>
__device__ __forceinline__ void gemm_phase(PG8_LAS unsigned char* lds, const Gemm g, const Sched& S, const Epi& E) {
    int tid_ = threadIdx.x; asm volatile("" : "+v"(tid_));
    const int tid = tid_, wid = __builtin_amdgcn_readfirstlane(tid >> 6), lane = tid & 63, wr = wid >> 2, wc = wid & 3, fr = lane & 15, fq = lane >> 4;
    const int K = g.K, nt = K / BK;
    unsigned voffA[2], voffB[2];
#pragma unroll
    for (int i = 0; i < 2; ++i) { int R, C; stage_rc(tid * 16 + i * 8192, R, C); const int Rb = Epi::PERM ? ((R & ~31) + perm32(R & 31)) : R;
        voffA[i] = (unsigned)(R * K + C) * 2u; voffB[i] = (unsigned)(Rb * K + C) * 2u; }
    const size_t kstep = (size_t)(BK * 2);
    const size_t hstep = (size_t)HALF * K * 2;
    const size_t tstep = 2 * hstep;
    const unsigned ldsw = (unsigned)wid * 1024u;
    const int aoff = lds_byte(wr * 64 + fr, fq * 8), boff = lds_byte(wc * 32 + fr, fq * 8);
#define PG8_SA(b, h) (((b) * 2 + (h)) * HTB)
#define PG8_SB(b, h) ((4 + (b) * 2 + (h)) * HTB)
#define PG8_STAGE(bufoff, gbase, voff) do { _Pragma("unroll") for (int _i = 0; _i < 2; ++_i) \
        __builtin_amdgcn_global_load_lds((const unsigned*)((const char*)(gbase) + (voff)[_i]), (PG8_LAS unsigned*)(lds + (bufoff) + ldsw + _i * 8192), 16, 0, 0); } while (0)
#define PG8_LDA(dst, b, h) do { _Pragma("unroll") for (int m = 0; m < 4; ++m) _Pragma("unroll") for (int k = 0; k < 2; ++k) dst[m][k] = *(const PG8_LAS bf16x8*)(lds + PG8_SA(b, h) + aoff + m * 2048 + k * 1024); } while (0)
#define PG8_LDB(dst, b, h) do { _Pragma("unroll") for (int n = 0; n < 2; ++n) _Pragma("unroll") for (int k = 0; k < 2; ++k) dst[n][k] = *(const PG8_LAS bf16x8*)(lds + PG8_SB(b, h) + boff + n * 2048 + k * 1024); } while (0)
#define PG8_MMA(ai, bj, At, Bt) do { __builtin_amdgcn_s_setprio(1); _Pragma("unroll") for (int m = 0; m < 4; ++m) _Pragma("unroll") for (int n = 0; n < 2; ++n) _Pragma("unroll") for (int k = 0; k < 2; ++k) \
        acc[ai][bj][m][n] = __builtin_amdgcn_mfma_f32_16x16x32_bf16(Bt[n][k], At[m][k], acc[ai][bj][m][n], 0, 0, 0); __builtin_amdgcn_s_setprio(0); } while (0)
#define PG8_WAIT_V(n) asm volatile("s_waitcnt vmcnt(" #n ")" ::: "memory")
#define PG8_WAIT_L(n) asm volatile("s_waitcnt lgkmcnt(" #n ")" ::: "memory")
#define PG8_BAR __builtin_amdgcn_s_barrier()
#define PG8_SCHED __builtin_amdgcn_sched_barrier(0)
    Unit cur, nxt; int ui = 0;
    if (!S.next(0, cur)) return;
    f32x4 acc[2][2][4][2];
#pragma unroll
    for (int a = 0; a < 2; ++a)
#pragma unroll
        for (int b = 0; b < 2; ++b)
#pragma unroll
            for (int m = 0; m < 4; ++m)
#pragma unroll
                for (int n = 0; n < 2; ++n) acc[a][b][m][n] = (f32x4){0.f, 0.f, 0.f, 0.f};
    bf16x8 At[4][2], B0[2][2], B1[2][2];
    const char* cA = (const char*)g.A + (size_t)cur.pm * tstep; const char* cB = (const char*)g.Bt + (size_t)cur.pn * tstep;
    S.a_ready(cur);
    if constexpr (SP2) {
        PG8_STAGE(PG8_SB(0, 0), cB, voffB); PG8_STAGE(PG8_SB(0, 1), cB + hstep, voffB); PG8_STAGE(PG8_SA(0, 0), cA, voffA); PG8_STAGE(PG8_SA(0, 1), cA + hstep, voffA);
        if (wr == 1) PG8_BAR;
        PG8_WAIT_V(2); PG8_BAR;
        PG8_STAGE(PG8_SB(1, 0), cB + kstep, voffB); PG8_STAGE(PG8_SA(1, 0), cA + kstep, voffA); PG8_STAGE(PG8_SB(1, 1), cB + hstep + kstep, voffB);
        PG8_WAIT_V(6); PG8_BAR;
    } else {
        PG8_STAGE(PG8_SB(0, 0), cB, voffB); PG8_STAGE(PG8_SA(0, 0), cA, voffA); PG8_STAGE(PG8_SB(0, 1), cB + hstep, voffB); PG8_STAGE(PG8_SA(0, 1), cA + hstep, voffA);
        if (wr == 1) PG8_BAR;
        PG8_WAIT_V(4); PG8_BAR;
        PG8_STAGE(PG8_SB(1, 0), cB + kstep, voffB); PG8_STAGE(PG8_SA(1, 0), cA + kstep, voffA); PG8_STAGE(PG8_SB(1, 1), cB + hstep + kstep, voffB);
        PG8_WAIT_V(6); PG8_BAR;
    }
    for (;;) {
        const bool has_next = S.next(ui + 1, nxt);
        const char* nA = has_next ? (const char*)g.A + (size_t)nxt.pm * tstep : cA; const char* nB = has_next ? (const char*)g.Bt + (size_t)nxt.pn * tstep : cB;
        for (int t = 0; t < nt; t += 2) {
            const bool last = (t == nt - 2);
            const char* a1 = cA + (size_t)(t + 1) * kstep;
            const char* a2 = last ? nA : cA + (size_t)(t + 2) * kstep; const char* b2 = last ? nB : cB + (size_t)(t + 2) * kstep;
            const char* a3 = a2 + kstep; const char* b3 = b2 + kstep;
            if (last && has_next) S.a_ready(nxt);
            if constexpr (SP2) {
            PG8_LDB(B0, 0, 0); PG8_LDB(B1, 0, 1); PG8_SCHED; PG8_LDA(At, 0, 0); PG8_STAGE(PG8_SA(1, 1), a1 + hstep, voffA);
            PG8_WAIT_V(8); PG8_WAIT_L(0); PG8_BAR; PG8_MMA(0, 0, At, B0); PG8_MMA(0, 1, At, B1); PG8_BAR; PG8_SCHED;
            PG8_LDA(At, 0, 1); PG8_STAGE(PG8_SB(0, 0), b2, voffB); PG8_STAGE(PG8_SB(0, 1), b2 + hstep, voffB); PG8_STAGE(PG8_SA(0, 0), a2, voffA);
            PG8_WAIT_V(8); PG8_WAIT_L(0); PG8_BAR; PG8_MMA(1, 0, At, B0); PG8_MMA(1, 1, At, B1); PG8_BAR; PG8_SCHED;
            PG8_LDB(B0, 1, 0); PG8_LDB(B1, 1, 1); PG8_SCHED; PG8_LDA(At, 1, 0); PG8_STAGE(PG8_SA(0, 1), a2 + hstep, voffA);
            PG8_WAIT_V(8); PG8_WAIT_L(0); PG8_BAR; PG8_MMA(0, 0, At, B0); PG8_MMA(0, 1, At, B1); PG8_BAR; PG8_SCHED;
            PG8_LDA(At, 1, 1); PG8_STAGE(PG8_SB(1, 0), b3, voffB); PG8_STAGE(PG8_SB(1, 1), b3 + hstep, voffB); PG8_STAGE(PG8_SA(1, 0), a3, voffA);
            PG8_WAIT_V(8); PG8_WAIT_L(0); PG8_BAR; PG8_MMA(1, 0, At, B0); PG8_MMA(1, 1, At, B1); PG8_BAR; PG8_SCHED;
            } else {
            PG8_LDB(B0, 0, 0); PG8_SCHED; PG8_LDA(At, 0, 0); PG8_STAGE(PG8_SA(1, 1), a1 + hstep, voffA);
            PG8_WAIT_L(8); PG8_BAR; PG8_WAIT_L(0); PG8_MMA(0, 0, At, B0); PG8_BAR; PG8_SCHED;
            PG8_LDB(B1, 0, 1); PG8_STAGE(PG8_SB(0, 0), b2, voffB);
            PG8_BAR; PG8_WAIT_L(0); PG8_MMA(0, 1, At, B1); PG8_BAR;
            PG8_LDA(At, 0, 1); PG8_STAGE(PG8_SA(0, 0), a2, voffA);
            PG8_BAR; PG8_WAIT_L(0); PG8_MMA(1, 0, At, B0); PG8_BAR; PG8_SCHED;
            PG8_STAGE(PG8_SB(0, 1), b2 + hstep, voffB);
            PG8_WAIT_V(6); PG8_BAR; PG8_MMA(1, 1, At, B1); PG8_BAR;
            PG8_LDB(B0, 1, 0); PG8_SCHED; PG8_LDA(At, 1, 0); PG8_STAGE(PG8_SA(0, 1), a2 + hstep, voffA);
            PG8_WAIT_L(8); PG8_BAR; PG8_WAIT_L(0); PG8_MMA(0, 0, At, B0); PG8_BAR; PG8_SCHED;
            PG8_LDB(B1, 1, 1); PG8_STAGE(PG8_SB(1, 0), b3, voffB);
            PG8_BAR; PG8_WAIT_L(0); PG8_MMA(0, 1, At, B1); PG8_BAR;
            PG8_LDA(At, 1, 1); PG8_STAGE(PG8_SA(1, 0), a3, voffA);
            PG8_BAR; PG8_WAIT_L(0); PG8_MMA(1, 0, At, B0); PG8_BAR; PG8_SCHED;
            PG8_STAGE(PG8_SB(1, 1), b3 + hstep, voffB);
            PG8_WAIT_V(6); PG8_BAR; PG8_MMA(1, 1, At, B1); PG8_BAR;
            }
        }
        if constexpr (ALIGN_EPI) { if (wr == 0) PG8_BAR; }
        if constexpr (!Epi::AFTER_DRAIN) { E(acc, cur, wr, wc, fr, fq); S.done(cur); }
        if (!has_next) break;
#pragma unroll
        for (int a = 0; a < 2; ++a)
#pragma unroll
            for (int b = 0; b < 2; ++b)
#pragma unroll
                for (int m = 0; m < 4; ++m)
#pragma unroll
                    for (int n = 0; n < 2; ++n) acc[a][b][m][n] = (f32x4){0.f, 0.f, 0.f, 0.f};
        cur = nxt; cA = nA; cB = nB; ++ui;
        if constexpr (ALIGN_EPI) { if (wr == 1) PG8_BAR; }
    }
    PG8_WAIT_V(0);
    if constexpr (!ALIGN_EPI) { if (wr == 0) PG8_BAR; }
    PG8_BAR;
    if constexpr (Epi::AFTER_DRAIN) { E.fused(acc, cur, wr, wc, fr, fq, lds, wid, lane); S.done(cur); }
#undef PG8_SA
#undef PG8_SB
#undef PG8_STAGE
#undef PG8_LDA
#undef PG8_LDB
#undef PG8_MMA
#undef PG8_WAIT_V
#undef PG8_WAIT_L
#undef PG8_BAR
#undef PG8_SCHED
}
}
#define LAS __attribute__((address_space(3)))
typedef unsigned short bf16;
typedef unsigned v4u __attribute__((ext_vector_type(4)));
typedef unsigned v2u __attribute__((ext_vector_type(2)));
typedef float f32x4 __attribute__((ext_vector_type(4)));
typedef short bf16x8 __attribute__((ext_vector_type(8)));
typedef short s16x4 __attribute__((ext_vector_type(4)));
typedef float f32x16 __attribute__((ext_vector_type(16)));
constexpr int DM = 1024, NB = 8, SEQ = 4096, MTOK = NB * SEQ, NIN = 4616, NPROJ = 4608, PLE = 256;
constexpr int C_SBQ = 0, C_SBK = 512, C_SBV = 1024, C_SBZ = 1536, C_MLQ = 2048, C_MLK = 2560, C_MLV = 3072, C_MLO = 3584, C_MLZ = 4096;
constexpr float EPS = 1e-6f;
constexpr size_t MiB = 1u << 20;
constexpr size_t WS_WIN = 1 * MiB, WS_WOUT = 10 * MiB, WS_WGATE = 12 * MiB, WS_WUP = 14 * MiB, WS_GATES = 15 * MiB;
constexpr size_t WS_U = 16 * MiB;
constexpr size_t WS_PROJ = 80 * MiB;
constexpr size_t WS_PU = 368 * MiB, WS_PB = 432 * MiB, WS_QKC = 448 * MiB, WS_END = 512 * MiB;
constexpr int LDS_BYTES = 147456;

__device__ __forceinline__ unsigned f2bf(float f) { unsigned u = __builtin_bit_cast(unsigned, f); return (u + 0x7fffu + ((u >> 16) & 1u)) >> 16; }
__device__ __forceinline__ unsigned pk2(float lo, float hi) { return f2bf(lo) | (f2bf(hi) << 16); }
__device__ __forceinline__ float bflo(unsigned w) { return __builtin_bit_cast(float, w << 16); }
__device__ __forceinline__ float bfhi(unsigned w) { return __builtin_bit_cast(float, w & 0xffff0000u); }
__device__ __forceinline__ float bf1(bf16 v) { return __builtin_bit_cast(float, ((unsigned)v) << 16); }
__device__ __forceinline__ float wave_sum(float v) {
#pragma unroll
    for (int o = 1; o < 64; o <<= 1) v += __shfl_xor(v, o);
    return v;
}
__device__ __forceinline__ float sigmoidf_(float x) { return 1.f / (1.f + __expf(-x)); }
__device__ __forceinline__ float siluf_(float x) { return x / (1.f + __expf(-x)); }
#define LDS_WAIT() asm volatile("s_waitcnt lgkmcnt(0)" ::: "memory")

__device__ __forceinline__ void p0_transpose_item(const float* W, int K, int pitch, int nblk, bf16* WT, LAS float* scr, int item, int lane) {
    const int kb = item / nblk, nb = item % nblk, k0 = 64 * kb, n0 = 32 * nb;
#pragma unroll 8
    for (int i = 0; i < 32; ++i) { const int kk = 2 * i + (lane >> 5); scr[kk * 33 + (lane & 31)] = W[(size_t)(k0 + kk) * pitch + n0 + (lane & 31)]; }
    LDS_WAIT(); asm volatile("" ::: "memory");
    const int c = lane & 7;
#pragma unroll
    for (int j = 0; j < 4; ++j) { const int n = (lane >> 3) + 8 * j; const LAS float* s = scr + (8 * c) * 33 + n;
        v4u o; o.x = pk2(s[0 * 33], s[1 * 33]); o.y = pk2(s[2 * 33], s[3 * 33]); o.z = pk2(s[4 * 33], s[5 * 33]); o.w = pk2(s[6 * 33], s[7 * 33]);
        *(v4u*)(WT + (size_t)(n0 + n) * K + k0 + 8 * c) = o; }
    LDS_WAIT(); asm volatile("" ::: "memory");
}

struct EpiGate {
    static constexpr bool PERM = true, AFTER_DRAIN = false;
    float* out; const bf16* pu; const float* bias;
    __device__ __forceinline__ void operator()(const pg8::f32x4 (&acc)[2][2][4][2], const pg8::Unit& u, int wr, int wc, int fr, int fq) const {
        const int row0 = u.pm * 256 + wr * 64 + fr, col0 = u.pn * 256 + wc * 32 + 8 * fq;
#pragma unroll
        for (int ai = 0; ai < 2; ++ai)
#pragma unroll
            for (int m = 0; m < 4; ++m) { const size_t ro = (size_t)(row0 + ai * 128 + m * 16) * DM;
#pragma unroll
                for (int bj = 0; bj < 2; ++bj) { const int c = col0 + bj * 128;
                    const f32x4 b0 = *(const f32x4*)(bias + c), b1 = *(const f32x4*)(bias + c + 4);
                    const f32x4 h0 = *(const f32x4*)(out + ro + c), h1 = *(const f32x4*)(out + ro + c + 4);
                    const v4u pw = *(const v4u*)(pu + ro + c);
                    const f32x4 v0 = acc[ai][bj][m][0] + b0, v1 = acc[ai][bj][m][1] + b1;
                    f32x4 o0, o1;
                    o0[0] = h0[0] + sigmoidf_(v0[0]) * bflo(pw.x); o0[1] = h0[1] + sigmoidf_(v0[1]) * bfhi(pw.x);
                    o0[2] = h0[2] + sigmoidf_(v0[2]) * bflo(pw.y); o0[3] = h0[3] + sigmoidf_(v0[3]) * bfhi(pw.y);
                    o1[0] = h1[0] + sigmoidf_(v1[0]) * bflo(pw.z); o1[1] = h1[1] + sigmoidf_(v1[1]) * bfhi(pw.z);
                    o1[2] = h1[2] + sigmoidf_(v1[2]) * bflo(pw.w); o1[3] = h1[3] + sigmoidf_(v1[3]) * bfhi(pw.w);
                    *(f32x4*)(out + ro + c) = o0; *(f32x4*)(out + ro + c + 4) = o1; } }
    }
};

struct Args { const float* in[15]; float* out; unsigned char* ws; };
struct Ctx {
    LAS unsigned char* lds; int tid, lane, wave, gw, NGW;
    const float *x, *p, *pre_w, *w_in, *conv_w, *conv_b, *i_bias, *f_bias, *sb_w, *ml_w, *w_out, *post_w, *w_up, *w_gate, *b_gate;
    float* out; bf16 *WT_IN, *WT_OUT, *WT_GATE, *WT_UP, *U, *Y, *HB, *PROJ, *Y2, *PU, *PB, *QKC; float* GATES;
};

__device__ __forceinline__ void phase0(Ctx& F) {
    {
        LAS float* scr = (LAS float*)(F.lds + F.wave * 16384);
        constexpr int I_IN = 16 * 144, I_O = 16 * 32, I_G = 16 * 32, I_U = 4 * 32, NIT = I_IN + I_O + I_G + I_U;
        for (int it = F.gw; it < NIT; it += F.NGW) {
            int r = it;
            if (r < I_IN) { p0_transpose_item(F.w_in, DM, NIN, 144, F.WT_IN, scr, r, F.lane); continue; } r -= I_IN;
            if (r < I_O) { p0_transpose_item(F.w_out, DM, DM, 32, F.WT_OUT, scr, r, F.lane); continue; } r -= I_O;
            if (r < I_G) { p0_transpose_item(F.w_gate, DM, DM, 32, F.WT_GATE, scr, r, F.lane); continue; } r -= I_G;
            p0_transpose_item(F.w_up, PLE, DM, 32, F.WT_UP, scr, r, F.lane);
        }
    }
    __syncthreads();
    LAS float* Wg = (LAS float*)F.lds;
    for (int e = F.tid; e < 1024 * 8; e += 512) Wg[e] = F.w_in[(size_t)(e >> 3) * NIN + NPROJ + (e & 7)];
    __syncthreads();
    for (int m = F.gw; m < MTOK; m += F.NGW) {
        const f32x4* xr = (const f32x4*)(F.x + (size_t)m * DM) + F.lane;
        f32x4 v[4]; float s = 0.f;
#pragma unroll
        for (int j = 0; j < 4; ++j) { v[j] = xr[64 * j]; s += (v[j].x * v[j].x + v[j].y * v[j].y) + (v[j].z * v[j].z + v[j].w * v[j].w); }
        const float rstd = 1.0f / sqrtf(wave_sum(s) * (1.f / DM) + EPS);
        float g[8];
#pragma unroll
        for (int i = 0; i < 8; ++i) g[i] = 0.f;
        unsigned long long* o8 = (unsigned long long*)(F.U + (size_t)m * DM) + F.lane;
#pragma unroll
        for (int j = 0; j < 4; ++j) {
            const f32x4 w = *((const f32x4*)F.pre_w + F.lane + 64 * j);
            const f32x4 u = v[j] * rstd * w;
            o8[64 * j] = (unsigned long long)pk2(u.x, u.y) | ((unsigned long long)pk2(u.z, u.w) << 32);
#pragma unroll
            for (int e = 0; e < 4; ++e) { const LAS f32x4* wg = (const LAS f32x4*)(Wg + (256 * j + 4 * F.lane + e) * 8); const f32x4 a = wg[0], b = wg[1]; const float ue = u[e];
                g[0] += ue * a.x; g[1] += ue * a.y; g[2] += ue * a.z; g[3] += ue * a.w; g[4] += ue * b.x; g[5] += ue * b.y; g[6] += ue * b.z; g[7] += ue * b.w; }
        }
#pragma unroll
        for (int i = 0; i < 8; ++i) g[i] = wave_sum(g[i]);
        if (F.lane == 0) {
            f32x4 gi, gf;
#pragma unroll
            for (int i = 0; i < 4; ++i) { gi[i] = g[i] + F.i_bias[i]; const float fp = g[4 + i] + F.f_bias[i];
                gf[i] = fp >= 0.f ? -log1pf(expf(-fp)) : fp - log1pf(expf(fp)); }
            *(f32x4*)(F.GATES + (size_t)m * 8) = gi; *(f32x4*)(F.GATES + (size_t)m * 8 + 4) = gf;
        }
    }
    for (size_t e = (size_t)(blockIdx.x * 512 + F.tid) * 8; e < (size_t)MTOK * PLE; e += (size_t)gridDim.x * 512 * 8) {
        const f32x4 a = *(const f32x4*)(F.p + e), b = *(const f32x4*)(F.p + e + 4);
        v4u o; o.x = pk2(a.x, a.y); o.y = pk2(a.z, a.w); o.z = pk2(b.x, b.y); o.w = pk2(b.z, b.w);
        *(v4u*)(F.PB + e) = o;
    }
}

__device__ __forceinline__ void phase_conv(Ctx& F) {
    const size_t NITEM = (size_t)MTOK * 128;
    for (size_t it = (size_t)blockIdx.x * 512 + F.tid; it < NITEM; it += (size_t)gridDim.x * 512) {
        const int row = (int)(it >> 7), c0 = (int)(it & 127) * 8, t = row & (SEQ - 1);
        float acc[8];
#pragma unroll
        for (int e = 0; e < 8; ++e) acc[e] = F.conv_b[c0 + e];
#pragma unroll
        for (int j = 0; j < 4; ++j) {
            if (t - 3 + j < 0) continue;
            const v4u r = *(const v4u*)(F.PROJ + (size_t)(row - 3 + j) * NPROJ + C_MLQ + c0);
            const f32x4 w0 = *(const f32x4*)(F.conv_w + j * 1024 + c0), w1 = *(const f32x4*)(F.conv_w + j * 1024 + c0 + 4);
            acc[0] += w0.x * bflo(r.x); acc[1] += w0.y * bfhi(r.x); acc[2] += w0.z * bflo(r.y); acc[3] += w0.w * bfhi(r.y);
            acc[4] += w1.x * bflo(r.z); acc[5] += w1.y * bfhi(r.z); acc[6] += w1.z * bflo(r.w); acc[7] += w1.w * bfhi(r.w);
        }
        const float sc = c0 >= 512 ? 0.08838834764831845f : 1.0f;
#pragma unroll
        for (int e = 0; e < 8; ++e) acc[e] = siluf_(acc[e]) * sc;
        v4u o; o.x = pk2(acc[0], acc[1]); o.y = pk2(acc[2], acc[3]); o.z = pk2(acc[4], acc[5]); o.w = pk2(acc[6], acc[7]);
        *(v4u*)(F.QKC + (size_t)row * 1024 + c0) = o;
    }
}

__device__ __forceinline__ void phase_norm(Ctx& F) {
    for (int m = F.gw; m < MTOK; m += F.NGW) {
        const v4u* yr = (const v4u*)(F.Y2 + (size_t)m * DM) + F.lane;
        float y[16]; float s = 0.f;
#pragma unroll
        for (int j = 0; j < 2; ++j) { const v4u r = yr[64 * j];
            y[8 * j + 0] = bflo(r.x); y[8 * j + 1] = bfhi(r.x); y[8 * j + 2] = bflo(r.y); y[8 * j + 3] = bfhi(r.y);
            y[8 * j + 4] = bflo(r.z); y[8 * j + 5] = bfhi(r.z); y[8 * j + 6] = bflo(r.w); y[8 * j + 7] = bfhi(r.w); }
#pragma unroll
        for (int e = 0; e < 16; ++e) s += y[e] * y[e];
        const float rstd = 1.0f / sqrtf(wave_sum(s) * (1.f / DM) + EPS);
#pragma unroll
        for (int j = 0; j < 2; ++j) {
            const int c = 512 * j + 8 * F.lane; const size_t o = (size_t)m * DM + c;
            const f32x4 x0 = *(const f32x4*)(F.x + o), x1 = *(const f32x4*)(F.x + o + 4);
            const f32x4 w0 = *(const f32x4*)(F.post_w + c), w1 = *(const f32x4*)(F.post_w + c + 4);
            f32x4 h0, h1;
#pragma unroll
            for (int e = 0; e < 4; ++e) { h0[e] = x0[e] + y[8 * j + e] * rstd * w0[e]; h1[e] = x1[e] + y[8 * j + 4 + e] * rstd * w1[e]; }
            *(f32x4*)(F.out + o) = h0; *(f32x4*)(F.out + o + 4) = h1;
            v4u hb; hb.x = pk2(h0[0], h0[1]); hb.y = pk2(h0[2], h0[3]); hb.z = pk2(h1[0], h1[1]); hb.w = pk2(h1[2], h1[3]);
            *(v4u*)(F.HB + o) = hb;
        }
    }
}
typedef short v4i16_t __attribute__((ext_vector_type(4)));
typedef float f32x2_t __attribute__((ext_vector_type(2)));
typedef __bf16 bf16x2_t __attribute__((ext_vector_type(2)));
__device__ __forceinline__ unsigned cvtpk(float lo, float hi) { f32x2_t v = {lo, hi}; bf16x2_t b = __builtin_convertvector(v, bf16x2_t); return __builtin_bit_cast(unsigned, b); }
__device__ __forceinline__ s16x4 vtr(const LAS unsigned char* p) { return __builtin_bit_cast(s16x4, __builtin_amdgcn_ds_read_tr16_b64_v4i16((LAS v4i16_t*)p)); }
__device__ __forceinline__ bf16x8 pack8(const f32x16& x, int s) {
    v4u p; p.x = cvtpk(x[8 * s + 0], x[8 * s + 1]); p.y = cvtpk(x[8 * s + 2], x[8 * s + 3]); p.z = cvtpk(x[8 * s + 4], x[8 * s + 5]); p.w = cvtpk(x[8 * s + 6], x[8 * s + 7]);
    return __builtin_bit_cast(bf16x8, p);
}
template <bool MASK> __device__ __forceinline__ void sb_half(f32x16& p, float& R, int kbase, int t, int hi) {
    float lk[16];
#pragma unroll
    for (int i = 0; i < 16; ++i) {
        const float z = p[i];
        float v = -(fmaxf(z, 0.f) + __builtin_amdgcn_logf(1.f + __builtin_amdgcn_exp2f(-fabsf(z))));
        if (MASK) { const int key = kbase + (i & 3) + 8 * (i >> 2); v = key < t ? v : 0.f; }
        lk[i] = v;
    }
#pragma unroll
    for (int g = 0; g < 4; ++g) { lk[4 * g + 2] += lk[4 * g + 3]; lk[4 * g + 1] += lk[4 * g + 2]; lk[4 * g] += lk[4 * g + 1]; }
    float Glo[4], Ghi[4];
#pragma unroll
    for (int g = 0; g < 4; ++g) { const float own = lk[4 * g], oth = __shfl_xor(own, 32); Glo[g] = hi ? oth : own; Ghi[g] = hi ? own : oth; }
    float acc = R;
#pragma unroll
    for (int g = 3; g >= 0; --g) {
        const float off1 = acc, off0 = acc + Ghi[g]; acc = off0 + Glo[g];
        const float off = hi ? off1 : off0;
#pragma unroll
        for (int e = 0; e < 4; ++e) { const int i = 4 * g + e;
            float a = __builtin_amdgcn_exp2f(p[i] + (lk[i] + off));
            if (MASK) { const int key = kbase + (i & 3) + 8 * (i >> 2); a = key < t ? a : 0.f; }
            p[i] = a; }
    }
    R = acc;
}
__device__ __forceinline__ void attn_fast(Ctx& F) {
    constexpr int VP = 144;
    LAS unsigned char* vt = F.lds + F.wave * 16384;
    int lane_ = F.lane; asm volatile("" : "+v"(lane_));
    const int lane = lane_, r32 = lane & 31, hi = lane >> 5;
    const int i16 = lane & 15, tq = i16 >> 2, tp = i16 & 3, blk = (lane >> 4) & 1;
    const int troff = (4 * hi + tq) * VP + (16 * blk + 4 * tp) * 2;
    for (int unit = F.gw; unit < NB * 8 * (SEQ / 32); unit += F.NGW) {
        const int bh = unit >> 7, qb = unit & 127, b = bh >> 3, h = bh & 7, q0 = 32 * qb, t = q0 + r32;
        const bf16* base = F.PROJ + (size_t)b * SEQ * NPROJ + h * 64;
        bf16x8 qr[4];
        { const bf16* qp = base + (size_t)t * NPROJ + C_SBQ + 8 * hi;
#pragma unroll
          for (int d0 = 0; d0 < 4; ++d0) qr[d0] = *(const bf16x8*)(qp + 16 * d0); }
        const int kt = (q0 + 31) >> 6;
        bf16x8 kf[2][4]; v4u vr[8];
#define LOAD_KV(KF, VR, k0_) do { const bf16* kp_ = base + (size_t)((k0_) + r32) * NPROJ + C_SBK + 8 * hi; \
            _Pragma("unroll") for (int hh = 0; hh < 2; ++hh) _Pragma("unroll") for (int d0 = 0; d0 < 4; ++d0) KF[hh][d0] = *(const bf16x8*)(kp_ + (size_t)hh * 32 * NPROJ + 16 * d0); \
            const bf16* vp_ = base + (size_t)((k0_) + (lane >> 3)) * NPROJ + C_SBV + 8 * (lane & 7); \
            _Pragma("unroll") for (int i = 0; i < 8; ++i) VR[i] = *(const v4u*)(vp_ + (size_t)(8 * i) * NPROJ); } while (0)
        LOAD_KV(kf, vr, 64 * kt);
        f32x16 o[2];
#pragma unroll
        for (int i = 0; i < 16; ++i) { o[0][i] = 0.f; o[1][i] = 0.f; }
        float R = 0.f;
        for (int it = kt; it >= 0; --it) {
            const int k0 = 64 * it;
            asm volatile("" ::: "memory");
#pragma unroll
            for (int i = 0; i < 8; ++i) *(LAS v4u*)(vt + (8 * i + (lane >> 3)) * VP + 16 * (lane & 7)) = vr[i];
            asm volatile("" ::: "memory");
            bf16x8 kc[2][4];
#pragma unroll
            for (int hh = 0; hh < 2; ++hh)
#pragma unroll
                for (int d0 = 0; d0 < 4; ++d0) kc[hh][d0] = kf[hh][d0];
            if (it > 0) LOAD_KV(kf, vr, k0 - 64);
            const bool first = (it == kt);
            const bool do_hi = !first || (k0 + 32 <= q0 + 30);
            f32x16 p0, p1;
#pragma unroll
            for (int i = 0; i < 16; ++i) { p0[i] = 0.f; p1[i] = 0.f; }
#pragma unroll
            for (int d0 = 0; d0 < 4; ++d0) p0 = __builtin_amdgcn_mfma_f32_32x32x16_bf16(kc[0][d0], qr[d0], p0, 0, 0, 0);
            if (do_hi) {
#pragma unroll
                for (int d0 = 0; d0 < 4; ++d0) p1 = __builtin_amdgcn_mfma_f32_32x32x16_bf16(kc[1][d0], qr[d0], p1, 0, 0, 0);
                if (first) sb_half<true>(p1, R, k0 + 32 + 4 * hi, t, hi); else sb_half<false>(p1, R, k0 + 32 + 4 * hi, t, hi);
            }
            if (first) sb_half<true>(p0, R, k0 + 4 * hi, t, hi); else sb_half<false>(p0, R, k0 + 4 * hi, t, hi);
#pragma unroll
            for (int hh = 1; hh >= 0; --hh) {
                if (hh == 1 && !do_hi) continue;
#pragma unroll
                for (int s = 0; s < 2; ++s) {
                    const bf16x8 pa = pack8(hh ? p1 : p0, s);
#pragma unroll
                    for (int dh = 0; dh < 2; ++dh) {
                        const LAS unsigned char* vb = vt + troff + (32 * hh + 16 * s) * VP + 64 * dh;
                        const s16x4 lo = vtr(vb), hi4 = vtr(vb + 8 * VP);
                        const bf16x8 vf = {lo[0], lo[1], lo[2], lo[3], hi4[0], hi4[1], hi4[2], hi4[3]};
                        o[dh] = __builtin_amdgcn_mfma_f32_32x32x16_bf16(pa, vf, o[dh], 0, 0, 0);
                    }
                }
            }
            if (__all(R < -151.f)) break;
        }
#undef LOAD_KV
        asm volatile("" ::: "memory");
        LAS float* os = (LAS float*)vt;
#pragma unroll
        for (int dh = 0; dh < 2; ++dh)
#pragma unroll
            for (int i = 0; i < 16; ++i) os[((i & 3) + 8 * (i >> 2) + 4 * hi) * 65 + 32 * dh + r32] = o[dh][i];
        asm volatile("" ::: "memory");
        const int q = lane >> 1, hf = lane & 1;
        float ov[32]; float ss = 0.f;
#pragma unroll
        for (int e = 0; e < 32; ++e) { ov[e] = os[q * 65 + 32 * hf + e]; ss += ov[e] * ov[e]; }
        ss += __shfl_xor(ss, 1);
        const float rstd = 1.0f / sqrtf(ss * (1.f / 64.f) + EPS);
        const size_t row = (size_t)b * SEQ + q0 + q;
        const int c0 = h * 64 + 32 * hf;
#pragma unroll
        for (int c = 0; c < 4; ++c) {
            const v4u zr = *(const v4u*)(F.PROJ + row * NPROJ + C_SBZ + c0 + 8 * c);
            const f32x4 w0 = *(const f32x4*)(F.sb_w + c0 + 8 * c), w1 = *(const f32x4*)(F.sb_w + c0 + 8 * c + 4);
            v4u w;
            w.x = pk2(ov[8 * c + 0] * rstd * w0.x * siluf_(bflo(zr.x)), ov[8 * c + 1] * rstd * w0.y * siluf_(bfhi(zr.x)));
            w.y = pk2(ov[8 * c + 2] * rstd * w0.z * siluf_(bflo(zr.y)), ov[8 * c + 3] * rstd * w0.w * siluf_(bfhi(zr.y)));
            w.z = pk2(ov[8 * c + 4] * rstd * w1.x * siluf_(bflo(zr.z)), ov[8 * c + 5] * rstd * w1.y * siluf_(bfhi(zr.z)));
            w.w = pk2(ov[8 * c + 6] * rstd * w1.z * siluf_(bflo(zr.w)), ov[8 * c + 7] * rstd * w1.w * siluf_(bfhi(zr.w)));
            *(v4u*)(F.Y + row * DM + c0 + 8 * c) = w;
        }
        asm volatile("" ::: "memory");
    }
}
constexpr int SL_N = 16384, SL_SC = 16512, SL_STRIDE = 16640;
__device__ __forceinline__ v4u scale8(v4u r, float s) {
    v4u o; o.x = cvtpk(bflo(r.x) * s, bfhi(r.x) * s); o.y = cvtpk(bflo(r.y) * s, bfhi(r.y) * s); o.z = cvtpk(bflo(r.z) * s, bfhi(r.z) * s); o.w = cvtpk(bflo(r.w) * s, bfhi(r.w) * s); return o;
}
template <int PASS> __device__ __forceinline__ void mlstm_fast(Ctx& F, float* SLOC) {
    constexpr int PT = 272, SP = 144, HP = 129;
    constexpr int L_Q = 0, L_K = 17408, L_V = 34816, L_VW = 52224, L_S = 69632, L_H = 78848, L_SC = 111872;
    LAS unsigned char* L = F.lds;
    LAS float* su = (LAS float*)(L + L_SC); LAS float* sM = su + 64; LAS float* sb = su + 128; LAS bf16* swb = (LAS bf16*)(su + 192);
    LAS float* Hs = (LAS float*)(L + L_H);
    int tid_ = F.tid; asm volatile("" : "+v"(tid_));
    const int tid = tid_, lane = tid & 63, w = __builtin_amdgcn_readfirstlane(tid >> 6), fr = lane & 15, fq = lane >> 4, tq = fr >> 2, tp = fr & 3;
    const int srow = tid >> 3, sc8 = tid & 7, v0 = 16 * w;
    const int nunits = PASS == 1 ? NB * 4 * 7 : NB * 4 * 8;
    for (int unit = blockIdx.x; unit < nunits; unit += gridDim.x) {
        int bh, seg; if (PASS == 1) { bh = unit / 7; seg = unit % 7; } else { bh = unit >> 3; seg = unit & 7; }
        const int b = bh >> 2, h = bh & 3;
        const size_t row0 = (size_t)b * SEQ + (size_t)seg * 512;
        f32x4 X[8], Xn[8];
#pragma unroll
        for (int t = 0; t < 8; ++t) { X[t] = (f32x4){0.f, 0.f, 0.f, 0.f}; Xn[t] = (f32x4){0.f, 0.f, 0.f, 0.f}; }
        float m_prev = PASS == 1 ? -1e30f : 0.f, bsum = 0.f;
        if (PASS == 2) {
            for (int j = 0; j < seg; ++j) {
                const float* S = SLOC + (size_t)(bh * 7 + j) * SL_STRIDE;
                const float mloc = S[SL_SC], Bs = S[SL_SC + 1];
                const float m_new = fmaxf(Bs + m_prev, mloc), fa = __expf(Bs + m_prev - m_new), fg = __expf(mloc - m_new);
#pragma unroll
                for (int t = 0; t < 8; ++t) { const f32x4 cl = *(const f32x4*)(S + (size_t)(t * 512 + tid) * 4); X[t] = X[t] * fa + cl * fg;
                    const f32x4 nl = *(const f32x4*)(S + SL_N + 16 * t + 4 * fq); Xn[t] = Xn[t] * fa + nl * fg; }
                m_prev = m_new;
            }
        }
        v4u pq0, pq1, pk0, pk1, pv0, pv1; float pig, plf;
#define MPREF(c_) do { const size_t rg_ = row0 + (size_t)(c_) * 64 + srow; \
            const bf16* qk_ = F.QKC + rg_ * 1024 + h * 128 + 8 * sc8; const bf16* vv_ = F.PROJ + rg_ * NPROJ + C_MLV + h * 128 + 8 * sc8; \
            if (PASS == 2) { pq0 = *(const v4u*)(qk_); pq1 = *(const v4u*)(qk_ + 64); } \
            pk0 = *(const v4u*)(qk_ + 512); pk1 = *(const v4u*)(qk_ + 512 + 64); pv0 = *(const v4u*)(vv_); pv1 = *(const v4u*)(vv_ + 64); \
            const float* gg_ = F.GATES + (row0 + (size_t)(c_) * 64 + lane) * 8; pig = gg_[h]; plf = gg_[4 + h]; } while (0)
        MPREF(0);
        for (int c = 0; c < 8; ++c) {
            const size_t rowc = row0 + (size_t)c * 64;
            __syncthreads();
            float bc = plf;
#pragma unroll
            for (int o = 1; o < 64; o <<= 1) { const float t_ = __shfl_up(bc, o); if (lane >= o) bc += t_; }
            const float u = pig - bc; float pm = u;
#pragma unroll
            for (int o = 1; o < 64; o <<= 1) { const float t_ = __shfl_up(pm, o); if (lane >= o) pm = fmaxf(pm, t_); }
            const float Mv = fmaxf(m_prev, pm), M63 = __shfl(Mv, 63), blast = __shfl(bc, 63);
            const float wgt = __expf(u - M63);
            if (w == 0) { su[lane] = u; sM[lane] = Mv; sb[lane] = bc; swb[lane] = (bf16)(cvtpk(wgt, 0.f) & 0xffffu); }
            const float wrow = __shfl(wgt, srow);
            *(LAS v4u*)(L + L_K + srow * PT + 16 * sc8) = pk0; *(LAS v4u*)(L + L_K + srow * PT + 16 * (sc8 + 8)) = pk1;
            *(LAS v4u*)(L + L_VW + srow * PT + 16 * sc8) = scale8(pv0, wrow); *(LAS v4u*)(L + L_VW + srow * PT + 16 * (sc8 + 8)) = scale8(pv1, wrow);
            if (PASS == 2) {
                *(LAS v4u*)(L + L_Q + srow * PT + 16 * sc8) = pq0; *(LAS v4u*)(L + L_Q + srow * PT + 16 * (sc8 + 8)) = pq1;
                *(LAS v4u*)(L + L_V + srow * PT + 16 * sc8) = pv0; *(LAS v4u*)(L + L_V + srow * PT + 16 * (sc8 + 8)) = pv1;
            }
            if (c + 1 < 8) MPREF(c + 1);
            __syncthreads();
            if (PASS == 2) {
                const int lt = w & 3, sp = w >> 2;
#pragma unroll
                for (int si = 0; si < 2; ++si) {
                    const int st = 2 * sp + si;
                    f32x4 acc = (f32x4){0.f, 0.f, 0.f, 0.f};
                    if (st <= lt) {
#pragma unroll
                        for (int ks = 0; ks < 4; ++ks) {
                            const bf16x8 ak = *(const LAS bf16x8*)(L + L_K + (16 * st + fr) * PT + (32 * ks + 8 * fq) * 2);
                            const bf16x8 bq = *(const LAS bf16x8*)(L + L_Q + (16 * lt + fr) * PT + (32 * ks + 8 * fq) * 2);
                            acc = __builtin_amdgcn_mfma_f32_16x16x32_bf16(ak, bq, acc, 0, 0, 0);
                        }
                        const f32x4 us = *(const LAS f32x4*)(su + 16 * st + 4 * fq); const float Ml = sM[16 * lt + fr];
                        const int l = 16 * lt + fr, s0 = 16 * st + 4 * fq;
#pragma unroll
                        for (int j = 0; j < 4; ++j) acc[j] = (s0 + j <= l) ? acc[j] * __expf(us[j] - Ml) : 0.f;
                    }
                    v2u pw; pw.x = cvtpk(acc[0], acc[1]); pw.y = cvtpk(acc[2], acc[3]);
                    *(LAS v2u*)(L + L_S + (16 * lt + fr) * SP + (16 * st + 4 * fq) * 2) = pw;
                }
                __syncthreads();
                f32x4 num[4], den[4];
#pragma unroll
                for (int i = 0; i < 4; ++i) { num[i] = (f32x4){0.f, 0.f, 0.f, 0.f}; den[i] = (f32x4){0.f, 0.f, 0.f, 0.f}; }
#pragma unroll
                for (int kk = 0; kk < 4; ++kk) {
                    v4u bsw, bnw;
                    bsw.x = cvtpk(X[2 * kk][0], X[2 * kk][1]); bsw.y = cvtpk(X[2 * kk][2], X[2 * kk][3]); bsw.z = cvtpk(X[2 * kk + 1][0], X[2 * kk + 1][1]); bsw.w = cvtpk(X[2 * kk + 1][2], X[2 * kk + 1][3]);
                    bnw.x = cvtpk(Xn[2 * kk][0], Xn[2 * kk][1]); bnw.y = cvtpk(Xn[2 * kk][2], Xn[2 * kk][3]); bnw.z = cvtpk(Xn[2 * kk + 1][0], Xn[2 * kk + 1][1]); bnw.w = cvtpk(Xn[2 * kk + 1][2], Xn[2 * kk + 1][3]);
                    const bf16x8 bs = __builtin_bit_cast(bf16x8, bsw), bn = __builtin_bit_cast(bf16x8, bnw);
#pragma unroll
                    for (int i = 0; i < 4; ++i) {
                        const LAS unsigned char* qa = L + L_Q + (16 * i + fr) * PT + (32 * kk + 4 * fq) * 2;
                        const v2u lo = *(const LAS v2u*)qa, hi = *(const LAS v2u*)(qa + 32);
                        const v4u aw = {lo.x, lo.y, hi.x, hi.y}; const bf16x8 aq = __builtin_bit_cast(bf16x8, aw);
                        num[i] = __builtin_amdgcn_mfma_f32_16x16x32_bf16(aq, bs, num[i], 0, 0, 0);
                        den[i] = __builtin_amdgcn_mfma_f32_16x16x32_bf16(aq, bn, den[i], 0, 0, 0);
                    }
                    __builtin_amdgcn_sched_barrier(0);
                }
#pragma unroll
                for (int i = 0; i < 4; ++i) { const f32x4 Ml = *(const LAS f32x4*)(sM + 16 * i + 4 * fq);
#pragma unroll
                    for (int j = 0; j < 4; ++j) { const float cs = __expf(m_prev - Ml[j]); num[i][j] *= cs; den[i][j] *= cs; } }
                const v4u onesw = {0x3f803f80u, 0x3f803f80u, 0x3f803f80u, 0x3f803f80u}; const bf16x8 ones = __builtin_bit_cast(bf16x8, onesw);
#pragma unroll
                for (int ks = 0; ks < 2; ++ks) {
                    const LAS unsigned char* vb = L + L_V + (32 * ks + 8 * fq + tq) * PT + (v0 + 4 * tp) * 2;
                    const s16x4 lo = vtr(vb), hi4 = vtr(vb + 4 * PT);
                    const bf16x8 bv = {lo[0], lo[1], lo[2], lo[3], hi4[0], hi4[1], hi4[2], hi4[3]};
#pragma unroll
                    for (int i = 0; i < 4; ++i) {
                        if (32 * ks > 16 * i + 15) continue;
                        const bf16x8 as = *(const LAS bf16x8*)(L + L_S + (16 * i + fr) * SP + (32 * ks + 8 * fq) * 2);
                        num[i] = __builtin_amdgcn_mfma_f32_16x16x32_bf16(as, bv, num[i], 0, 0, 0);
                        den[i] = __builtin_amdgcn_mfma_f32_16x16x32_bf16(as, ones, den[i], 0, 0, 0);
                    }
                }
#pragma unroll
                for (int i = 0; i < 4; ++i) { const f32x4 Ml = *(const LAS f32x4*)(sM + 16 * i + 4 * fq), bl = *(const LAS f32x4*)(sb + 16 * i + 4 * fq);
#pragma unroll
                    for (int j = 0; j < 4; ++j) Hs[(16 * i + 4 * fq + j) * HP + v0 + fr] = num[i][j] / fmaxf(fabsf(den[i][j]), __expf(-(bl[j] + Ml[j]))); }
            }
            {
                const float a = __expf(m_prev - M63);
#pragma unroll
                for (int t = 0; t < 8; ++t) { X[t] *= a; Xn[t] *= a; }
#pragma unroll
                for (int ks = 0; ks < 2; ++ks) {
                    const LAS unsigned char* vb = L + L_VW + (32 * ks + 8 * fq + tq) * PT + (v0 + 4 * tp) * 2;
                    const s16x4 lo = vtr(vb), hi4 = vtr(vb + 4 * PT);
                    const bf16x8 bv = {lo[0], lo[1], lo[2], lo[3], hi4[0], hi4[1], hi4[2], hi4[3]};
                    const bf16x8 bw = *(const LAS bf16x8*)(swb + 32 * ks + 8 * fq);
#pragma unroll
                    for (int t = 0; t < 8; ++t) {
                        const LAS unsigned char* kb = L + L_K + (32 * ks + 8 * fq + tq) * PT + (16 * t + 4 * tp) * 2;
                        const s16x4 klo = vtr(kb), khi = vtr(kb + 4 * PT);
                        const bf16x8 ak = {klo[0], klo[1], klo[2], klo[3], khi[0], khi[1], khi[2], khi[3]};
                        X[t] = __builtin_amdgcn_mfma_f32_16x16x32_bf16(ak, bv, X[t], 0, 0, 0);
                        Xn[t] = __builtin_amdgcn_mfma_f32_16x16x32_bf16(ak, bw, Xn[t], 0, 0, 0);
                        if (t & 1) __builtin_amdgcn_sched_barrier(0);
                    }
                }
                m_prev = blast + M63; bsum += blast;
            }
            if (PASS == 2) {
                v4u po0, po1, pz0, pz1;
                { const bf16* oz = F.PROJ + (rowc + srow) * NPROJ + h * 128 + 16 * sc8;
                  po0 = *(const v4u*)(oz + C_MLO); po1 = *(const v4u*)(oz + C_MLO + 8); pz0 = *(const v4u*)(oz + C_MLZ); pz1 = *(const v4u*)(oz + C_MLZ + 8); }
                __syncthreads();
                const unsigned ow[8] = {po0.x, po0.y, po0.z, po0.w, po1.x, po1.y, po1.z, po1.w}, zw[8] = {pz0.x, pz0.y, pz0.z, pz0.w, pz1.x, pz1.y, pz1.z, pz1.w};
                float yv[16]; float ss = 0.f;
#pragma unroll
                for (int e = 0; e < 8; ++e) { const float h0 = Hs[srow * HP + 16 * sc8 + 2 * e], h1 = Hs[srow * HP + 16 * sc8 + 2 * e + 1];
                    yv[2 * e] = sigmoidf_(bflo(ow[e])) * h0; yv[2 * e + 1] = sigmoidf_(bfhi(ow[e])) * h1; ss += yv[2 * e] * yv[2 * e] + yv[2 * e + 1] * yv[2 * e + 1]; }
                ss += __shfl_xor(ss, 1); ss += __shfl_xor(ss, 2); ss += __shfl_xor(ss, 4);
                const float rstd = 1.0f / sqrtf(ss * (1.f / 128.f) + EPS);
                const float* nw = F.ml_w + h * 128 + 16 * sc8;
                unsigned outw[8];
#pragma unroll
                for (int e = 0; e < 8; ++e) outw[e] = pk2(yv[2 * e] * rstd * nw[2 * e] * siluf_(bflo(zw[e])), yv[2 * e + 1] * rstd * nw[2 * e + 1] * siluf_(bfhi(zw[e])));
                bf16* yp = F.Y + (rowc + srow) * DM + 512 + h * 128 + 16 * sc8;
                *(v4u*)yp = (v4u){outw[0], outw[1], outw[2], outw[3]}; *(v4u*)(yp + 8) = (v4u){outw[4], outw[5], outw[6], outw[7]};
            }
        }
#undef MPREF
        if (PASS == 1) {
            float* S = SLOC + (size_t)(bh * 7 + seg) * SL_STRIDE;
#pragma unroll
            for (int t = 0; t < 8; ++t) { *(f32x4*)(S + (size_t)(t * 512 + tid) * 4) = X[t]; if (w == 0 && fr == 0) *(f32x4*)(S + SL_N + 16 * t + 4 * fq) = Xn[t]; }
            if (tid == 0) { S[SL_SC] = m_prev; S[SL_SC + 1] = bsum; }
        }
        __syncthreads();
    }
}
#define MIXERS(F) do { attn_fast(F); mlstm_fast<1>(F, (float*)(args.ws + WS_PB)); grid.sync(); mlstm_fast<2>(F, (float*)(args.ws + WS_PB)); } while (0)
__global__ void __launch_bounds__(512, 2) fwd_kernel(Args args) {
    extern __shared__ __attribute__((aligned(16))) unsigned char lds_raw[];
    cg::grid_group grid = cg::this_grid();
    Ctx F;
    F.lds = (LAS unsigned char*)lds_raw;
    F.tid = threadIdx.x; F.lane = F.tid & 63; F.wave = __builtin_amdgcn_readfirstlane(F.tid >> 6);
    F.gw = blockIdx.x * 8 + F.wave; F.NGW = gridDim.x * 8;
    F.x = args.in[0]; F.p = args.in[1]; F.pre_w = args.in[2]; F.w_in = args.in[3]; F.conv_w = args.in[4]; F.conv_b = args.in[5]; F.i_bias = args.in[6]; F.f_bias = args.in[7];
    F.sb_w = args.in[8]; F.ml_w = args.in[9]; F.w_out = args.in[10]; F.post_w = args.in[11]; F.w_up = args.in[12]; F.w_gate = args.in[13]; F.b_gate = args.in[14];
    F.out = args.out; unsigned char* ws = args.ws;
    F.WT_IN = (bf16*)(ws + WS_WIN); F.WT_OUT = (bf16*)(ws + WS_WOUT); F.WT_GATE = (bf16*)(ws + WS_WGATE); F.WT_UP = (bf16*)(ws + WS_WUP); F.GATES = (float*)(ws + WS_GATES);
    F.U = (bf16*)(ws + WS_U); F.Y = F.U; F.HB = F.U; F.PROJ = (bf16*)(ws + WS_PROJ); F.Y2 = F.PROJ; F.PU = (bf16*)(ws + WS_PU); F.PB = (bf16*)(ws + WS_PB); F.QKC = (bf16*)(ws + WS_QKC);

    phase0(F);
    grid.sync();
    {
        pg8::Gemm g{F.U, F.WT_IN, MTOK, NPROJ, DM}; pg8::StaticOrder S; S.init(MTOK, NPROJ, gridDim.x, blockIdx.x);
        pg8::EpiBf16<0> E{F.PROJ, NPROJ, nullptr, 512, 512, 0.125f * 1.4426950408889634f};
        pg8::gemm_phase<pg8::EpiBf16<0>, pg8::StaticOrder, true, true>(F.lds, g, S, E);
        pg8::Gemm g2{F.PB, F.WT_UP, MTOK, DM, PLE}; pg8::StaticOrder S2; S2.init(MTOK, DM, gridDim.x, blockIdx.x);
        pg8::EpiBf16<0> E2{F.PU, DM, nullptr, 0, 0, 1.f};
        pg8::gemm_phase<pg8::EpiBf16<0>, pg8::StaticOrder, true, true>(F.lds, g2, S2, E2);
    }
    grid.sync();
    phase_conv(F);
    grid.sync();
    MIXERS(F);
    grid.sync();
    {
        pg8::Gemm g{F.Y, F.WT_OUT, MTOK, DM, DM}; pg8::StaticOrder S; S.init(MTOK, DM, gridDim.x, blockIdx.x);
        pg8::EpiBf16<0> E{F.Y2, DM, nullptr, 0, 0, 1.f};
        pg8::gemm_phase<pg8::EpiBf16<0>, pg8::StaticOrder, true, true>(F.lds, g, S, E);
    }
    grid.sync();
    phase_norm(F);
    grid.sync();
    {
        pg8::Gemm g{F.HB, F.WT_GATE, MTOK, DM, DM}; pg8::StaticOrder S; S.init(MTOK, DM, gridDim.x, blockIdx.x);
        EpiGate E{F.out, F.PU, F.b_gate};
        pg8::gemm_phase<EpiGate, pg8::StaticOrder, true, true>(F.lds, g, S, E);
    }
}

extern "C" void kernel_launch(void* const* d_in, const int* in_sizes, int n_in, void* d_out, int out_size, void* d_ws, size_t ws_size, hipStream_t stream) {
    static int grid = 0;
    if (grid == 0) {
        if (n_in != 15 || out_size != MTOK * DM || ws_size < WS_END) { fprintf(stderr, "kernel_launch: unexpected shapes (n_in %d out %d ws %zu)\n", n_in, out_size, ws_size); grid = -1; return; }
        int dev = 0, cus = 0, per_cu = 0;
        (void)hipGetDevice(&dev); (void)hipDeviceGetAttribute(&cus, hipDeviceAttributeMultiprocessorCount, dev);
        if (hipFuncSetAttribute((const void*)fwd_kernel, hipFuncAttributeMaxDynamicSharedMemorySize, LDS_BYTES) != hipSuccess) { fprintf(stderr, "kernel_launch: hipFuncSetAttribute failed\n"); grid = -1; return; }
        if (hipOccupancyMaxActiveBlocksPerMultiprocessor(&per_cu, (const void*)fwd_kernel, 512, LDS_BYTES) != hipSuccess || per_cu < 1) { fprintf(stderr, "kernel_launch: occupancy query says %d\n", per_cu); per_cu = 1; }
        (void)hipGetLastError();
        grid = cus * 1;
        if (grid <= 0) grid = 256;
    }
    if (grid < 0) return;
    Args a{};
    for (int i = 0; i < 15; ++i) a.in[i] = (const float*)d_in[i];
    a.out = (float*)d_out; a.ws = (unsigned char*)d_ws;
    void* kargs[] = {&a};
    hipError_t e = hipLaunchCooperativeKernel((const void*)fwd_kernel, dim3(grid), dim3(512), kargs, LDS_BYTES, stream);
    if (e != hipSuccess) fprintf(stderr, "kernel_launch: cooperative launch failed: %s (grid %d)\n", hipGetErrorString(e), grid);
}
```

```cpp
#include <hip/hip_runtime.h>
#include <hip/hip_cooperative_groups.h>
#include <cstdio>
#include <cstdint>
namespace cg = cooperative_groups;
namespace pg8 {
#define PG8_LAS __attribute__((address_space(3)))
typedef unsigned short bf16_t;
typedef short bf16x8 __attribute__((ext_vector_type(8)));
typedef float f32x4 __attribute__((ext_vector_type(4)));
typedef unsigned u32x4 __attribute__((ext_vector_type(4)));
constexpr int BM = 256, BK = 64, HALF = 128, HTB = HALF * BK * 2  , STAGE_BYTES = 8 * HTB, NXCD = 8, WGM = 8;

__host__ __device__ __forceinline__ int lds_byte(int r, int c) { const int st = (r >> 4) * 2 + (c >> 5), rr = r & 15, cc = c & 31, ob = rr * 64 + cc * 2; return st * 1024 + (ob ^ (((ob >> 9) & 1) << 5)); }
__host__ __device__ __forceinline__ void stage_rc(int b, int& R, int& C) { const int st = b / 1024, sb = b % 1024, swz = sb ^ (((sb >> 9) & 1) << 5); R = (st >> 1) * 16 + swz / 64; C = (st & 1) * 32 + (swz % 64) / 2; }
__host__ __device__ __forceinline__ int perm32(int rho) { const int n = rho >> 4, i = rho & 15; return 8 * (i >> 2) + 4 * n + (i & 3); }

struct Unit { int pm, pn; };
struct Gemm { const bf16_t* A; const bf16_t* Bt; int M, N, K; };

struct StaticOrder {
    int nM, nN, nwg, G, c;
    __host__ __device__ void init(int M, int N, int G_, int c_) { nM = M / BM; nN = N / BM; nwg = nM * nN; G = G_; c = c_; }
    __host__ __device__ bool next(int i, Unit& u) const {
        const long L = (long)i * G + c; if (L >= nwg) return false;
        int wgid = (int)L; { const int q = nwg / NXCD, r = nwg % NXCD, xcd = wgid % NXCD, off = wgid / NXCD; wgid = (xcd < r ? xcd * (q + 1) : r * (q + 1) + (xcd - r) * q) + off; }
        const int nig = WGM * nN, gid = wgid / nig, fm = gid * WGM, gsz = (nM - fm) < WGM ? (nM - fm) : WGM;
        u.pm = fm + ((wgid % nig) % gsz); u.pn = (wgid % nig) / gsz; return true;
    }
    __device__ __forceinline__ void a_ready(const Unit&) const {}
    __device__ __forceinline__ void done(const Unit&) const {}
};

__device__ __forceinline__ unsigned cvt_pk_bf16(float lo, float hi) { unsigned r; asm volatile("v_cvt_pk_bf16_f32 %0, %1, %2" : "=v"(r) : "v"(lo), "v"(hi)); return r; }
typedef float f32x2 __attribute__((ext_vector_type(2)));
__device__ __forceinline__ f32x2 gelu_pk(f32x2 v) {
    const f32x2 av = __builtin_elementwise_abs(v), d = av * 0.2316418882f + 1.0f;
    f32x2 t; t.x = __builtin_amdgcn_rcpf(d.x); t.y = __builtin_amdgcn_rcpf(d.y);
    f32x2 q = t * 0.5307027145f + (-0.7265760135f); q = q * t + 0.7107068705f; q = q * t + (-0.142248368f); q = q * t + 0.127414796f; q = q * t;
    const f32x2 s = (v * v) * (-0.72134752044f);
    f32x2 e; e.x = __builtin_amdgcn_exp2f(s.x); e.y = __builtin_amdgcn_exp2f(s.y);
    const f32x2 m = v * (q * e), r = v - m;
    f32x2 o; o.x = v.x < 0.f ? m.x : r.x; o.y = v.y < 0.f ? m.y : r.y; return o;
}

template <int ACT  > struct EpiBf16 {
    static constexpr bool PERM = true, AFTER_DRAIN = false; static_assert(ACT == 0 || ACT == 1, "EpiBf16: ACT is 0 (none) or 1 (gelu_pk)");
    bf16_t* O; int ldc; const float* bias; int split_cols; size_t split_stride; float scale0;
    __device__ __forceinline__ void operator()(const f32x4 (&acc)[2][2][4][2], const Unit& u, int wr, int wc, int fr, int fq) const {
        const int row0 = u.pm * BM + wr * 64 + fr; int colt = u.pn * BM; bf16_t* base = O;
        float sc = 1.f; if (split_cols) { const int t = colt / split_cols; base += (size_t)t * split_stride; colt -= t * split_cols; if (t == 0) sc = scale0; }
        const int col0 = colt + wc * 32 + 8 * fq, bcol0 = u.pn * BM + wc * 32 + 8 * fq;
        f32x4 bv[2][2];
#pragma unroll
        for (int bj = 0; bj < 2; ++bj)
#pragma unroll
            for (int n = 0; n < 2; ++n) bv[bj][n] = bias ? *(const f32x4*)(bias + bcol0 + bj * HALF + 4 * n) : (f32x4){0.f, 0.f, 0.f, 0.f};
#pragma unroll
        for (int ai = 0; ai < 2; ++ai)
#pragma unroll
            for (int m = 0; m < 4; ++m) { bf16_t* rowp = base + (size_t)(row0 + ai * HALF + m * 16) * ldc + col0;
#pragma unroll
                for (int bj = 0; bj < 2; ++bj) { f32x4 v0 = acc[ai][bj][m][0] + bv[bj][0], v1 = acc[ai][bj][m][1] + bv[bj][1];
                    if (ACT == 1) { f32x2 a = gelu_pk((f32x2){v0[0], v0[1]}), b = gelu_pk((f32x2){v0[2], v0[3]}), c = gelu_pk((f32x2){v1[0], v1[1]}), d = gelu_pk((f32x2){v1[2], v1[3]});
                        v0 = (f32x4){a.x, a.y, b.x, b.y}; v1 = (f32x4){c.x, c.y, d.x, d.y}; }
                    v0 = v0 * sc; v1 = v1 * sc; u32x4 w; w.x = cvt_pk_bf16(v0[0], v0[1]); w.y = cvt_pk_bf16(v0[2], v0[3]); w.z = cvt_pk_bf16(v1[0], v1[1]); w.w = cvt_pk_bf16(v1[2], v1[3]);
                    *(u32x4*)(rowp + bj * HALF) = w; } }
    }
};

template <class Epi, class Sched, bool ALIGN_EPI = false, bool SP2 = false>
__device__ __forceinline__ void gemm_phase(PG8_LAS unsigned char* lds, const Gemm g, const Sched& S, const Epi& E) {
    int tid_ = threadIdx.x; asm volatile("" : "+v"(tid_));
    const int tid = tid_, wid = __builtin_amdgcn_readfirstlane(tid >> 6), lane = tid & 63, wr = wid >> 2, wc = wid & 3, fr = lane & 15, fq = lane >> 4;
    const int K = g.K, nt = K / BK;
    unsigned voffA[2], voffB[2];
#pragma unroll
    for (int i = 0; i < 2; ++i) { int R, C; stage_rc(tid * 16 + i * 8192, R, C); const int Rb = Epi::PERM ? ((R & ~31) + perm32(R & 31)) : R;
        voffA[i] = (unsigned)(R * K + C) * 2u; voffB[i] = (unsigned)(Rb * K + C) * 2u; }
    const size_t kstep = (size_t)(BK * 2);
    const size_t hstep = (size_t)HALF * K * 2;
    const size_t tstep = 2 * hstep;
    const unsigned ldsw = (unsigned)wid * 1024u;
    const int aoff = lds_byte(wr * 64 + fr, fq * 8), boff = lds_byte(wc * 32 + fr, fq * 8);
#define PG8_SA(b, h) (((b) * 2 + (h)) * HTB)
#define PG8_SB(b, h) ((4 + (b) * 2 + (h)) * HTB)
#define PG8_STAGE(bufoff, gbase, voff) do { _Pragma("unroll") for (int _i = 0; _i < 2; ++_i) \
        __builtin_amdgcn_global_load_lds((const unsigned*)((const char*)(gbase) + (voff)[_i]), (PG8_LAS unsigned*)(lds + (bufoff) + ldsw + _i * 8192), 16, 0, 0); } while (0)
#define PG8_LDA(dst, b, h) do { _Pragma("unroll") for (int m = 0; m < 4; ++m) _Pragma("unroll") for (int k = 0; k < 2; ++k) dst[m][k] = *(const PG8_LAS bf16x8*)(lds + PG8_SA(b, h) + aoff + m * 2048 + k * 1024); } while (0)
#define PG8_LDB(dst, b, h) do { _Pragma("unroll") for (int n = 0; n < 2; ++n) _Pragma("unroll") for (int k = 0; k < 2; ++k) dst[n][k] = *(const PG8_LAS bf16x8*)(lds + PG8_SB(b, h) + boff + n * 2048 + k * 1024); } while (0)
#define PG8_MMA(ai, bj, At, Bt) do { __builtin_amdgcn_s_setprio(1); _Pragma("unroll") for (int m = 0; m < 4; ++m) _Pragma("unroll") for (int n = 0; n < 2; ++n) _Pragma("unroll") for (int k = 0; k < 2; ++k) \
        acc[ai][bj][m][n] = __builtin_amdgcn_mfma_f32_16x16x32_bf16(Bt[n][k], At[m][k], acc[ai][bj][m][n], 0, 0, 0); __builtin_amdgcn_s_setprio(0); } while (0)
#define PG8_WAIT_V(n) asm volatile("s_waitcnt vmcnt(" #n ")" ::: "memory")
#define PG8_WAIT_L(n) asm volatile("s_waitcnt lgkmcnt(" #n ")" ::: "memory")
#define PG8_BAR __builtin_amdgcn_s_barrier()
#define PG8_SCHED __builtin_amdgcn_sched_barrier(0)
    Unit cur, nxt; int ui = 0;
    if (!S.next(0, cur)) return;
    f32x4 acc[2][2][4][2];
#pragma unroll
    for (int a = 0; a < 2; ++a)
#pragma unroll
        for (int b = 0; b < 2; ++b)
#pragma unroll
            for (int m = 0; m < 4; ++m)
#pragma unroll
                for (int n = 0; n < 2; ++n) acc[a][b][m][n] = (f32x4){0.f, 0.f, 0.f, 0.f};
    bf16x8 At[4][2], B0[2][2], B1[2][2];
    const char* cA = (const char*)g.A + (size_t)cur.pm * tstep; const char* cB = (const char*)g.Bt + (size_t)cur.pn * tstep;
    S.a_ready(cur);
    if constexpr (SP2) {
        PG8_STAGE(PG8_SB(0, 0), cB, voffB); PG8_STAGE(PG8_SB(0, 1), cB + hstep, voffB); PG8_STAGE(PG8_SA(0, 0), cA, voffA); PG8_STAGE(PG8_SA(0, 1), cA + hstep, voffA);
        if (wr == 1) PG8_BAR;
        PG8_WAIT_V(2); PG8_BAR;
        PG8_STAGE(PG8_SB(1, 0), cB + kstep, voffB); PG8_STAGE(PG8_SA(1, 0), cA + kstep, voffA); PG8_STAGE(PG8_SB(1, 1), cB + hstep + kstep, voffB);
        PG8_WAIT_V(6); PG8_BAR;
    } else {
        PG8_STAGE(PG8_SB(0, 0), cB, voffB); PG8_STAGE(PG8_SA(0, 0), cA, voffA); PG8_STAGE(PG8_SB(0, 1), cB + hstep, voffB); PG8_STAGE(PG8_SA(0, 1), cA + hstep, voffA);
        if (wr == 1) PG8_BAR;
        PG8_WAIT_V(4); PG8_BAR;
        PG8_STAGE(PG8_SB(1, 0), cB + kstep, voffB); PG8_STAGE(PG8_SA(1, 0), cA + kstep, voffA); PG8_STAGE(PG8_SB(1, 1), cB + hstep + kstep, voffB);
        PG8_WAIT_V(6); PG8_BAR;
    }
    for (;;) {
        const bool has_next = S.next(ui + 1, nxt);
        const char* nA = has_next ? (const char*)g.A + (size_t)nxt.pm * tstep : cA; const char* nB = has_next ? (const char*)g.Bt + (size_t)nxt.pn * tstep : cB;
        for (int t = 0; t < nt; t += 2) {
            const bool last = (t == nt - 2);
            const char* a1 = cA + (size_t)(t + 1) * kstep;
            const char* a2 = last ? nA : cA + (size_t)(t + 2) * kstep; const char* b2 = last ? nB : cB + (size_t)(t + 2) * kstep;
            const char* a3 = a2 + kstep; const char* b3 = b2 + kstep;
            if (last && has_next) S.a_ready(nxt);
            if constexpr (SP2) {
            PG8_LDB(B0, 0, 0); PG8_LDB(B1, 0, 1); PG8_SCHED; PG8_LDA(At, 0, 0); PG8_STAGE(PG8_SA(1, 1), a1 + hstep, voffA);
            PG8_WAIT_V(8); PG8_WAIT_L(0); PG8_BAR; PG8_MMA(0, 0, At, B0); PG8_MMA(0, 1, At, B1); PG8_BAR; PG8_SCHED;
            PG8_LDA(At, 0, 1); PG8_STAGE(PG8_SB(0, 0), b2, voffB); PG8_STAGE(PG8_SB(0, 1), b2 + hstep, voffB); PG8_STAGE(PG8_SA(0, 0), a2, voffA);
            PG8_WAIT_V(8); PG8_WAIT_L(0); PG8_BAR; PG8_MMA(1, 0, At, B0); PG8_MMA(1, 1, At, B1); PG8_BAR; PG8_SCHED;
            PG8_LDB(B0, 1, 0); PG8_LDB(B1, 1, 1); PG8_SCHED; PG8_LDA(At, 1, 0); PG8_STAGE(PG8_SA(0, 1), a2 + hstep, voffA);
            PG8_WAIT_V(8); PG8_WAIT_L(0); PG8_BAR; PG8_MMA(0, 0, At, B0); PG8_MMA(0, 1, At, B1); PG8_BAR; PG8_SCHED;
            PG8_LDA(At, 1, 1); PG8_STAGE(PG8_SB(1, 0), b3, voffB); PG8_STAGE(PG8_SB(1, 1), b3 + hstep, voffB); PG8_STAGE(PG8_SA(1, 0), a3, voffA);
            PG8_WAIT_V(8); PG8_WAIT_L(0); PG8_BAR; PG8_MMA(1, 0, At, B0); PG8_MMA(1, 1, At, B1); PG8_BAR; PG8_SCHED;
            } else {
            PG8_LDB(B0, 0, 0); PG8_SCHED; PG8_LDA(At, 0, 0); PG8_STAGE(PG8_SA(1, 1), a1 + hstep, voffA);
            PG8_WAIT_L(8); PG8_BAR; PG8_WAIT_L(0); PG8_MMA(0, 0, At, B0); PG8_BAR; PG8_SCHED;
            PG8_LDB(B1, 0, 1); PG8_STAGE(PG8_SB(0, 0), b2, voffB);
            PG8_BAR; PG8_WAIT_L(0); PG8_MMA(0, 1, At, B1); PG8_BAR;
            PG8_LDA(At, 0, 1); PG8_STAGE(PG8_SA(0, 0), a2, voffA);
            PG8_BAR; PG8_WAIT_L(0); PG8_MMA(1, 0, At, B0); PG8_BAR; PG8_SCHED;
            PG8_STAGE(PG8_SB(0, 1), b2 + hstep, voffB);
            PG8_WAIT_V(6); PG8_BAR; PG8_MMA(1, 1, At, B1); PG8_BAR;
            PG8_LDB(B0, 1, 0); PG8_SCHED; PG8_LDA(At, 1, 0); PG8_STAGE(PG8_SA(0, 1), a2 + hstep, voffA);
            PG8_WAIT_L(8); PG8_BAR; PG8_WAIT_L(0); PG8_MMA(0, 0, At, B0); PG8_BAR; PG8_SCHED;
            PG8_LDB(B1, 1, 1); PG8_STAGE(PG8_SB(1, 0), b3, voffB);
            PG8_BAR; PG8_WAIT_L(0); PG8_MMA(0, 1, At, B1); PG8_BAR;
            PG8_LDA(At, 1, 1); PG8_STAGE(PG8_SA(1, 0), a3, voffA);
            PG8_BAR; PG8_WAIT_L(0); PG8_MMA(1, 0, At, B0); PG8_BAR; PG8_SCHED;
            PG8_STAGE(PG8_SB(1, 1), b3 + hstep, voffB);
            PG8_WAIT_V(6); PG8_BAR; PG8_MMA(1, 1, At, B1); PG8_BAR;
            }
        }
        if constexpr (ALIGN_EPI) { if (wr == 0) PG8_BAR; }
        if constexpr (!Epi::AFTER_DRAIN) { E(acc, cur, wr, wc, fr, fq); S.done(cur); }
        if (!has_next) break;
#pragma unroll
        for (int a = 0; a < 2; ++a)
#pragma unroll
            for (int b = 0; b < 2; ++b)
#pragma unroll
                for (int m = 0; m < 4; ++m)
#pragma unroll
                    for (int n = 0; n < 2; ++n) acc[a][b][m][n] = (f32x4){0.f, 0.f, 0.f, 0.f};
        cur = nxt; cA = nA; cB = nB; ++ui;
        if constexpr (ALIGN_EPI) { if (wr == 1) PG8_BAR; }
    }
    PG8_WAIT_V(0);
    if constexpr (!ALIGN_EPI) { if (wr == 0) PG8_BAR; }
    PG8_BAR;
    if constexpr (Epi::AFTER_DRAIN) { E.fused(acc, cur, wr, wc, fr, fq, lds, wid, lane); S.done(cur); }
#undef PG8_SA
#undef PG8_SB
#undef PG8_STAGE
#undef PG8_LDA
#undef PG8_LDB
#undef PG8_MMA
#undef PG8_WAIT_V
#undef PG8_WAIT_L
#undef PG8_BAR
#undef PG8_SCHED
}
}
#define LAS __attribute__((address_space(3)))
typedef unsigned short bf16;
typedef unsigned v4u __attribute__((ext_vector_type(4)));
typedef unsigned v2u __attribute__((ext_vector_type(2)));
typedef float f32x4 __attribute__((ext_vector_type(4)));
typedef short bf16x8 __attribute__((ext_vector_type(8)));
typedef short s16x4 __attribute__((ext_vector_type(4)));
typedef float f32x16 __attribute__((ext_vector_type(16)));
constexpr int DM = 1024, NB = 8, SEQ = 4096, MTOK = NB * SEQ, NIN = 4616, NPROJ = 4608, PLE = 256;
constexpr int C_SBQ = 0, C_SBK = 512, C_SBV = 1024, C_SBZ = 1536, C_MLQ = 2048, C_MLK = 2560, C_MLV = 3072, C_MLO = 3584, C_MLZ = 4096;
constexpr float EPS = 1e-6f;
constexpr size_t MiB = 1u << 20;
constexpr size_t WS_WIN = 1 * MiB, WS_WOUT = 10 * MiB, WS_WGATE = 12 * MiB, WS_WUP = 14 * MiB, WS_GATES = 15 * MiB;
constexpr size_t WS_U = 16 * MiB;
constexpr size_t WS_PROJ = 80 * MiB;
constexpr size_t WS_PU = 368 * MiB, WS_PB = 432 * MiB, WS_QKC = 448 * MiB, WS_END = 512 * MiB;
constexpr int LDS_BYTES = 147456;

__device__ __forceinline__ unsigned f2bf(float f) { unsigned u = __builtin_bit_cast(unsigned, f); return (u + 0x7fffu + ((u >> 16) & 1u)) >> 16; }
__device__ __forceinline__ unsigned pk2(float lo, float hi) { return f2bf(lo) | (f2bf(hi) << 16); }
__device__ __forceinline__ float bflo(unsigned w) { return __builtin_bit_cast(float, w << 16); }
__device__ __forceinline__ float bfhi(unsigned w) { return __builtin_bit_cast(float, w & 0xffff0000u); }
__device__ __forceinline__ float bf1(bf16 v) { return __builtin_bit_cast(float, ((unsigned)v) << 16); }
__device__ __forceinline__ float wave_sum(float v) {
#pragma unroll
    for (int o = 1; o < 64; o <<= 1) v += __shfl_xor(v, o);
    return v;
}
__device__ __forceinline__ float sigmoidf_(float x) { return 1.f / (1.f + __expf(-x)); }
__device__ __forceinline__ float siluf_(float x) { return x / (1.f + __expf(-x)); }
#define LDS_WAIT() asm volatile("s_waitcnt lgkmcnt(0)" ::: "memory")

__device__ __forceinline__ void p0_transpose_item(const float* W, int K, int pitch, int nblk, bf16* WT, LAS float* scr, int item, int lane) {
    const int kb = item / nblk, nb = item % nblk, k0 = 64 * kb, n0 = 32 * nb;
#pragma unroll 8
    for (int i = 0; i < 32; ++i) { const int kk = 2 * i + (lane >> 5); scr[kk * 33 + (lane & 31)] = W[(size_t)(k0 + kk) * pitch + n0 + (lane & 31)]; }
    LDS_WAIT(); asm volatile("" ::: "memory");
    const int c = lane & 7;
#pragma unroll
    for (int j = 0; j < 4; ++j) { const int n = (lane >> 3) + 8 * j; const LAS float* s = scr + (8 * c) * 33 + n;
        v4u o; o.x = pk2(s[0 * 33], s[1 * 33]); o.y = pk2(s[2 * 33], s[3 * 33]); o.z = pk2(s[4 * 33], s[5 * 33]); o.w = pk2(s[6 * 33], s[7 * 33]);
        *(v4u*)(WT + (size_t)(n0 + n) * K + k0 + 8 * c) = o; }
    LDS_WAIT(); asm volatile("" ::: "memory");
}

struct EpiGate {
    static constexpr bool PERM = true, AFTER_DRAIN = false;
    float* out; const bf16* pu; const float* bias;
    __device__ __forceinline__ void operator()(const pg8::f32x4 (&acc)[2][2][4][2], const pg8::Unit& u, int wr, int wc, int fr, int fq) const {
        const int row0 = u.pm * 256 + wr * 64 + fr, col0 = u.pn * 256 + wc * 32 + 8 * fq;
#pragma unroll
        for (int ai = 0; ai < 2; ++ai)
#pragma unroll
            for (int m = 0; m < 4; ++m) { const size_t ro = (size_t)(row0 + ai * 128 + m * 16) * DM;
#pragma unroll
                for (int bj = 0; bj < 2; ++bj) { const int c = col0 + bj * 128;
                    const f32x4 b0 = *(const f32x4*)(bias + c), b1 = *(const f32x4*)(bias + c + 4);
                    const f32x4 h0 = *(const f32x4*)(out + ro + c), h1 = *(const f32x4*)(out + ro + c + 4);
                    const v4u pw = *(const v4u*)(pu + ro + c);
                    const f32x4 v0 = acc[ai][bj][m][0] + b0, v1 = acc[ai][bj][m][1] + b1;
                    f32x4 o0, o1;
                    o0[0] = h0[0] + sigmoidf_(v0[0]) * bflo(pw.x); o0[1] = h0[1] + sigmoidf_(v0[1]) * bfhi(pw.x);
                    o0[2] = h0[2] + sigmoidf_(v0[2]) * bflo(pw.y); o0[3] = h0[3] + sigmoidf_(v0[3]) * bfhi(pw.y);
                    o1[0] = h1[0] + sigmoidf_(v1[0]) * bflo(pw.z); o1[1] = h1[1] + sigmoidf_(v1[1]) * bfhi(pw.z);
                    o1[2] = h1[2] + sigmoidf_(v1[2]) * bflo(pw.w); o1[3] = h1[3] + sigmoidf_(v1[3]) * bfhi(pw.w);
                    *(f32x4*)(out + ro + c) = o0; *(f32x4*)(out + ro + c + 4) = o1; } }
    }
};

struct Args { const float* in[15]; float* out; unsigned char* ws; };
struct Ctx {
    LAS unsigned char* lds; int tid, lane, wave, gw, NGW;
    const float *x, *p, *pre_w, *w_in, *conv_w, *conv_b, *i_bias, *f_bias, *sb_w, *ml_w, *w_out, *post_w, *w_up, *w_gate, *b_gate;
    float* out; bf16 *WT_IN, *WT_OUT, *WT_GATE, *WT_UP, *U, *Y, *HB, *PROJ, *Y2, *PU, *PB, *QKC; float* GATES;
};

__device__ __forceinline__ void phase0(Ctx& F) {
    {
        LAS float* scr = (LAS float*)(F.lds + F.wave * 16384);
        constexpr int I_IN = 16 * 144, I_O = 16 * 32, I_G = 16 * 32, I_U = 4 * 32, NIT = I_IN + I_O + I_G + I_U;
        for (int it = F.gw; it < NIT; it += F.NGW) {
            int r = it;
            if (r < I_IN) { p0_transpose_item(F.w_in, DM, NIN, 144, F.WT_IN, scr, r, F.lane); continue; } r -= I_IN;
            if (r < I_O) { p0_transpose_item(F.w_out, DM, DM, 32, F.WT_OUT, scr, r, F.lane); continue; } r -= I_O;
            if (r < I_G) { p0_transpose_item(F.w_gate, DM, DM, 32, F.WT_GATE, scr, r, F.lane); continue; } r -= I_G;
            p0_transpose_item(F.w_up, PLE, DM, 32, F.WT_UP, scr, r, F.lane);
        }
    }
    __syncthreads();
    LAS float* Wg = (LAS float*)F.lds;
    for (int e = F.tid; e < 1024 * 8; e += 512) Wg[e] = F.w_in[(size_t)(e >> 3) * NIN + NPROJ + (e & 7)];
    __syncthreads();
    for (int m = F.gw; m < MTOK; m += F.NGW) {
        const f32x4* xr = (const f32x4*)(F.x + (size_t)m * DM) + F.lane;
        f32x4 v[4]; float s = 0.f;
#pragma unroll
        for (int j = 0; j < 4; ++j) { v[j] = xr[64 * j]; s += (v[j].x * v[j].x + v[j].y * v[j].y) + (v[j].z * v[j].z + v[j].w * v[j].w); }
        const float rstd = 1.0f / sqrtf(wave_sum(s) * (1.f / DM) + EPS);
        float g[8];
#pragma unroll
        for (int i = 0; i < 8; ++i) g[i] = 0.f;
        unsigned long long* o8 = (unsigned long long*)(F.U + (size_t)m * DM) + F.lane;
#pragma unroll
        for (int j = 0; j < 4; ++j) {
            const f32x4 w = *((const f32x4*)F.pre_w + F.lane + 64 * j);
            const f32x4 u = v[j] * rstd * w;
            o8[64 * j] = (unsigned long long)pk2(u.x, u.y) | ((unsigned long long)pk2(u.z, u.w) << 32);
#pragma unroll
            for (int e = 0; e < 4; ++e) { const LAS f32x4* wg = (const LAS f32x4*)(Wg + (256 * j + 4 * F.lane + e) * 8); const f32x4 a = wg[0], b = wg[1]; const float ue = u[e];
                g[0] += ue * a.x; g[1] += ue * a.y; g[2] += ue * a.z; g[3] += ue * a.w; g[4] += ue * b.x; g[5] += ue * b.y; g[6] += ue * b.z; g[7] += ue * b.w; }
        }
#pragma unroll
        for (int i = 0; i < 8; ++i) g[i] = wave_sum(g[i]);
        if (F.lane == 0) {
            f32x4 gi, gf;
#pragma unroll
            for (int i = 0; i < 4; ++i) { gi[i] = g[i] + F.i_bias[i]; const float fp = g[4 + i] + F.f_bias[i];
                gf[i] = fp >= 0.f ? -log1pf(expf(-fp)) : fp - log1pf(expf(fp)); }
            *(f32x4*)(F.GATES + (size_t)m * 8) = gi; *(f32x4*)(F.GATES + (size_t)m * 8 + 4) = gf;
        }
    }
    for (size_t e = (size_t)(blockIdx.x * 512 + F.tid) * 8; e < (size_t)MTOK * PLE; e += (size_t)gridDim.x * 512 * 8) {
        const f32x4 a = *(const f32x4*)(F.p + e), b = *(const f32x4*)(F.p + e + 4);
        v4u o; o.x = pk2(a.x, a.y); o.y = pk2(a.z, a.w); o.z = pk2(b.x, b.y); o.w = pk2(b.z, b.w);
        *(v4u*)(F.PB + e) = o;
    }
}

__device__ __forceinline__ void phase_conv(Ctx& F) {
    const size_t NITEM = (size_t)MTOK * 128;
    for (size_t it = (size_t)blockIdx.x * 512 + F.tid; it < NITEM; it += (size_t)gridDim.x * 512) {
        const int row = (int)(it >> 7), c0 = (int)(it & 127) * 8, t = row & (SEQ - 1);
        float acc[8];
#pragma unroll
        for (int e = 0; e < 8; ++e) acc[e] = F.conv_b[c0 + e];
#pragma unroll
        for (int j = 0; j < 4; ++j) {
            if (t - 3 + j < 0) continue;
            const v4u r = *(const v4u*)(F.PROJ + (size_t)(row - 3 + j) * NPROJ + C_MLQ + c0);
            const f32x4 w0 = *(const f32x4*)(F.conv_w + j * 1024 + c0), w1 = *(const f32x4*)(F.conv_w + j * 1024 + c0 + 4);
            acc[0] += w0.x * bflo(r.x); acc[1] += w0.y * bfhi(r.x); acc[2] += w0.z * bflo(r.y); acc[3] += w0.w * bfhi(r.y);
            acc[4] += w1.x * bflo(r.z); acc[5] += w1.y * bfhi(r.z); acc[6] += w1.z * bflo(r.w); acc[7] += w1.w * bfhi(r.w);
        }
        const float sc = c0 >= 512 ? 0.08838834764831845f : 1.0f;
#pragma unroll
        for (int e = 0; e < 8; ++e) acc[e] = siluf_(acc[e]) * sc;
        v4u o; o.x = pk2(acc[0], acc[1]); o.y = pk2(acc[2], acc[3]); o.z = pk2(acc[4], acc[5]); o.w = pk2(acc[6], acc[7]);
        *(v4u*)(F.QKC + (size_t)row * 1024 + c0) = o;
    }
}

__device__ __forceinline__ void phase_norm(Ctx& F) {
    for (int m = F.gw; m < MTOK; m += F.NGW) {
        const v4u* yr = (const v4u*)(F.Y2 + (size_t)m * DM) + F.lane;
        float y[16]; float s = 0.f;
#pragma unroll
        for (int j = 0; j < 2; ++j) { const v4u r = yr[64 * j];
            y[8 * j + 0] = bflo(r.x); y[8 * j + 1] = bfhi(r.x); y[8 * j + 2] = bflo(r.y); y[8 * j + 3] = bfhi(r.y);
            y[8 * j + 4] = bflo(r.z); y[8 * j + 5] = bfhi(r.z); y[8 * j + 6] = bflo(r.w); y[8 * j + 7] = bfhi(r.w); }
#pragma unroll
        for (int e = 0; e < 16; ++e) s += y[e] * y[e];
        const float rstd = 1.0f / sqrtf(wave_sum(s) * (1.f / DM) + EPS);
#pragma unroll
        for (int j = 0; j < 2; ++j) {
            const int c = 512 * j + 8 * F.lane; const size_t o = (size_t)m * DM + c;
            const f32x4 x0 = *(const f32x4*)(F.x + o), x1 = *(const f32x4*)(F.x + o + 4);
            const f32x4 w0 = *(const f32x4*)(F.post_w + c), w1 = *(const f32x4*)(F.post_w + c + 4);
            f32x4 h0, h1;
#pragma unroll
            for (int e = 0; e < 4; ++e) { h0[e] = x0[e] + y[8 * j + e] * rstd * w0[e]; h1[e] = x1[e] + y[8 * j + 4 + e] * rstd * w1[e]; }
            *(f32x4*)(F.out + o) = h0; *(f32x4*)(F.out + o + 4) = h1;
            v4u hb; hb.x = pk2(h0[0], h0[1]); hb.y = pk2(h0[2], h0[3]); hb.z = pk2(h1[0], h1[1]); hb.w = pk2(h1[2], h1[3]);
            *(v4u*)(F.HB + o) = hb;
        }
    }
}
#define XB_TMO      128
#define XB_XCNT(j)  (256  + 64 * (j))
#define XB_XSUB(j)  (1280 + 64 * (j))
#define XB_XGEN(j)  (2304 + 64 * (j))
#define XB_TOP      3328
#define XB_TOPGEN   3392
#define XCD_BAR_WORDS 3456
#define XB_SPIN_CAP (1u << 18)

__device__ __forceinline__ unsigned xb_ld(unsigned* p)              { return __hip_atomic_load(p, __ATOMIC_RELAXED, __HIP_MEMORY_SCOPE_AGENT); }
__device__ __forceinline__ unsigned xb_add(unsigned* p, unsigned v) { return __hip_atomic_fetch_add(p, v, __ATOMIC_RELAXED, __HIP_MEMORY_SCOPE_AGENT); }
__device__ __forceinline__ unsigned xb_xcc_id() { return (unsigned)__builtin_amdgcn_s_getreg((3 << 11) | 20) & 0xFu; }
#define XB_SPIN(cond, bar) do { unsigned _sp = 0; while (cond) { __builtin_amdgcn_s_sleep(1); \
    if ((++_sp & 255u) == 0u) { if (xb_ld(&(bar)[XB_TMO])) break; if (_sp > XB_SPIN_CAP) { atomicAdd(&(bar)[XB_TMO], 1u); break; } } } } while (0)

struct XcdBarrier {
    unsigned* bar; unsigned x;
    volatile LAS unsigned* st;
};

__device__ __forceinline__ XcdBarrier xcd_barrier_post(unsigned* bar, volatile LAS unsigned* st) {
    XcdBarrier b; b.bar = bar; b.x = xb_xcc_id(); b.st = st;
    if (threadIdx.x == 0) (void)xb_add(&bar[XB_XCNT(b.x)], 1u);
    return b;
}
__device__ __forceinline__ void xcd_barrier_complete(unsigned* bar, unsigned x, unsigned& nloc, unsigned& nx) {
    const unsigned G = gridDim.x * gridDim.y * gridDim.z;
    unsigned sum, cnt, mine, sp = 0u;
    for (;;) {
        sum = 0u; cnt = 0u; mine = 0u;
#pragma unroll
        for (unsigned j = 0; j < 16; ++j) { const unsigned c = xb_ld(&bar[XB_XCNT(j)]); sum += c; cnt += (c > 0u) ? 1u : 0u; mine = (j == x) ? c : mine; }
        if (sum == G) break;
        __builtin_amdgcn_s_sleep(1);
        if ((++sp & 255u) == 0u) { if (xb_ld(&bar[XB_TMO])) break; if (sp > XB_SPIN_CAP) { atomicAdd(&bar[XB_TMO], 1u); break; } }
    }
    nloc = mine > 0u ? mine : 1u; nx = cnt > 0u ? cnt : 1u;
}

__device__ __forceinline__ void xcd_barrier(const XcdBarrier& b) {
    asm volatile("s_waitcnt vmcnt(0)" ::: "memory");
    __syncthreads();
    if (threadIdx.x == 0) {
        unsigned* bar = b.bar;
        __builtin_amdgcn_s_waitcnt(0);
        unsigned nloc = b.st[0], nx = b.st[1];
        if (nloc == 0u) { xcd_barrier_complete(bar, b.x, nloc, nx); b.st[0] = nloc; b.st[1] = nx; }
        const unsigned old = xb_add(&bar[XB_XSUB(b.x)], 1u);
        const unsigned gen = old / nloc;
        if (old + 1u == (gen + 1u) * nloc) {
            __builtin_amdgcn_fence(__ATOMIC_RELEASE, "agent");
            asm volatile("s_waitcnt vmcnt(0)" ::: "memory");
            const unsigned og = xb_add(&bar[XB_TOP], 1u);
            const unsigned tg = og / nx;
            if (og + 1u == (tg + 1u) * nx) xb_add(&bar[XB_TOPGEN], 1u);
            else XB_SPIN(xb_ld(&bar[XB_TOPGEN]) == tg, bar);
            __builtin_amdgcn_fence(__ATOMIC_ACQUIRE, "agent");
            xb_add(&bar[XB_XGEN(b.x)], 1u);
            asm volatile("s_waitcnt vmcnt(0)" ::: "memory");
        } else {
            XB_SPIN(xb_ld(&bar[XB_XGEN(b.x)]) == gen, bar);
            __builtin_amdgcn_fence(__ATOMIC_ACQUIRE, "agent");
            asm volatile("s_waitcnt vmcnt(0)" ::: "memory");
        }
    }
    __syncthreads();
}

typedef short v4i16_t __attribute__((ext_vector_type(4)));
typedef float f32x2_t __attribute__((ext_vector_type(2)));
typedef __bf16 bf16x2_t __attribute__((ext_vector_type(2)));
__device__ __forceinline__ unsigned cvtpk(float lo, float hi) { f32x2_t v = {lo, hi}; bf16x2_t b = __builtin_convertvector(v, bf16x2_t); return __builtin_bit_cast(unsigned, b); }
__device__ __forceinline__ s16x4 vtr(const LAS unsigned char* p) { return __builtin_bit_cast(s16x4, __builtin_amdgcn_ds_read_tr16_b64_v4i16((LAS v4i16_t*)p)); }
__device__ __forceinline__ bf16x8 pack8(const f32x16& x, int s) {
    v4u p; p.x = cvtpk(x[8 * s + 0], x[8 * s + 1]); p.y = cvtpk(x[8 * s + 2], x[8 * s + 3]); p.z = cvtpk(x[8 * s + 4], x[8 * s + 5]); p.w = cvtpk(x[8 * s + 6], x[8 * s + 7]);
    return __builtin_bit_cast(bf16x8, p);
}
template <bool MASK> __device__ __forceinline__ void sb_half(f32x16& p, float& R, int kbase, int t, int hi) {
    float lk[16];
#pragma unroll
    for (int i = 0; i < 16; ++i) {
        const float z = p[i];
        float v = -(fmaxf(z, 0.f) + __builtin_amdgcn_logf(1.f + __builtin_amdgcn_exp2f(-fabsf(z))));
        if (MASK) { const int key = kbase + (i & 3) + 8 * (i >> 2); v = key < t ? v : 0.f; }
        lk[i] = v;
    }
#pragma unroll
    for (int g = 0; g < 4; ++g) { lk[4 * g + 2] += lk[4 * g + 3]; lk[4 * g + 1] += lk[4 * g + 2]; lk[4 * g] += lk[4 * g + 1]; }
    float Glo[4], Ghi[4];
#pragma unroll
    for (int g = 0; g < 4; ++g) { const float own = lk[4 * g], oth = __shfl_xor(own, 32); Glo[g] = hi ? oth : own; Ghi[g] = hi ? own : oth; }
    float acc = R;
#pragma unroll
    for (int g = 3; g >= 0; --g) {
        const float off1 = acc, off0 = acc + Ghi[g]; acc = off0 + Glo[g];
        const float off = hi ? off1 : off0;
#pragma unroll
        for (int e = 0; e < 4; ++e) { const int i = 4 * g + e;
            float a = __builtin_amdgcn_exp2f(p[i] + (lk[i] + off));
            if (MASK) { const int key = kbase + (i & 3) + 8 * (i >> 2); a = key < t ? a : 0.f; }
            p[i] = a; }
    }
    R = acc;
}
__device__ __forceinline__ void attn_fast(Ctx& F) {
    constexpr int VP = 144;
    LAS unsigned char* vt = F.lds + F.wave * 16384;
    int lane_ = F.lane; asm volatile("" : "+v"(lane_));
    const int lane = lane_, r32 = lane & 31, hi = lane >> 5;
    const int i16 = lane & 15, tq = i16 >> 2, tp = i16 & 3, blk = (lane >> 4) & 1;
    const int troff = (4 * hi + tq) * VP + (16 * blk + 4 * tp) * 2;
    for (int unit = F.gw; unit < NB * 8 * (SEQ / 32); unit += F.NGW) {
        const int bh = unit >> 7, qb = unit & 127, b = bh >> 3, h = bh & 7, q0 = 32 * qb, t = q0 + r32;
        const bf16* base = F.PROJ + (size_t)b * SEQ * NPROJ + h * 64;
        bf16x8 qr[4];
        { const bf16* qp = base + (size_t)t * NPROJ + C_SBQ + 8 * hi;
#pragma unroll
          for (int d0 = 0; d0 < 4; ++d0) qr[d0] = *(const bf16x8*)(qp + 16 * d0); }
        const int kt = (q0 + 31) >> 6;
        bf16x8 kf[2][4]; v4u vr[8];
#define LOAD_KV(KF, VR, k0_) do { const bf16* kp_ = base + (size_t)((k0_) + r32) * NPROJ + C_SBK + 8 * hi; \
            _Pragma("unroll") for (int hh = 0; hh < 2; ++hh) _Pragma("unroll") for (int d0 = 0; d0 < 4; ++d0) KF[hh][d0] = *(const bf16x8*)(kp_ + (size_t)hh * 32 * NPROJ + 16 * d0); \
            const bf16* vp_ = base + (size_t)((k0_) + (lane >> 3)) * NPROJ + C_SBV + 8 * (lane & 7); \
            _Pragma("unroll") for (int i = 0; i < 8; ++i) VR[i] = *(const v4u*)(vp_ + (size_t)(8 * i) * NPROJ); } while (0)
        LOAD_KV(kf, vr, 64 * kt);
        f32x16 o[2];
#pragma unroll
        for (int i = 0; i < 16; ++i) { o[0][i] = 0.f; o[1][i] = 0.f; }
        float R = 0.f;
        for (int it = kt; it >= 0; --it) {
            const int k0 = 64 * it;
            asm volatile("" ::: "memory");
#pragma unroll
            for (int i = 0; i < 8; ++i) *(LAS v4u*)(vt + (8 * i + (lane >> 3)) * VP + 16 * (lane & 7)) = vr[i];
            asm volatile("" ::: "memory");
            bf16x8 kc[2][4];
#pragma unroll
            for (int hh = 0; hh < 2; ++hh)
#pragma unroll
                for (int d0 = 0; d0 < 4; ++d0) kc[hh][d0] = kf[hh][d0];
            if (it > 0) LOAD_KV(kf, vr, k0 - 64);
            const bool first = (it == kt);
            const bool do_hi = !first || (k0 + 32 <= q0 + 30);
            f32x16 p0, p1;
#pragma unroll
            for (int i = 0; i < 16; ++i) { p0[i] = 0.f; p1[i] = 0.f; }
#pragma unroll
            for (int d0 = 0; d0 < 4; ++d0) p0 = __builtin_amdgcn_mfma_f32_32x32x16_bf16(kc[0][d0], qr[d0], p0, 0, 0, 0);
            if (do_hi) {
#pragma unroll
                for (int d0 = 0; d0 < 4; ++d0) p1 = __builtin_amdgcn_mfma_f32_32x32x16_bf16(kc[1][d0], qr[d0], p1, 0, 0, 0);
                if (first) sb_half<true>(p1, R, k0 + 32 + 4 * hi, t, hi); else sb_half<false>(p1, R, k0 + 32 + 4 * hi, t, hi);
            }
            if (first) sb_half<true>(p0, R, k0 + 4 * hi, t, hi); else sb_half<false>(p0, R, k0 + 4 * hi, t, hi);
#pragma unroll
            for (int hh = 1; hh >= 0; --hh) {
                if (hh == 1 && !do_hi) continue;
#pragma unroll
                for (int s = 0; s < 2; ++s) {
                    const bf16x8 pa = pack8(hh ? p1 : p0, s);
#pragma unroll
                    for (int dh = 0; dh < 2; ++dh) {
                        const LAS unsigned char* vb = vt + troff + (32 * hh + 16 * s) * VP + 64 * dh;
                        const s16x4 lo = vtr(vb), hi4 = vtr(vb + 8 * VP);
                        const bf16x8 vf = {lo[0], lo[1], lo[2], lo[3], hi4[0], hi4[1], hi4[2], hi4[3]};
                        o[dh] = __builtin_amdgcn_mfma_f32_32x32x16_bf16(pa, vf, o[dh], 0, 0, 0);
                    }
                }
            }
            if (__all(R < -151.f)) break;
        }
#undef LOAD_KV
        asm volatile("" ::: "memory");
        LAS float* os = (LAS float*)vt;
#pragma unroll
        for (int dh = 0; dh < 2; ++dh)
#pragma unroll
            for (int i = 0; i < 16; ++i) os[((i & 3) + 8 * (i >> 2) + 4 * hi) * 65 + 32 * dh + r32] = o[dh][i];
        asm volatile("" ::: "memory");
        const int q = lane >> 1, hf = lane & 1;
        float ov[32]; float ss = 0.f;
#pragma unroll
        for (int e = 0; e < 32; ++e) { ov[e] = os[q * 65 + 32 * hf + e]; ss += ov[e] * ov[e]; }
        ss += __shfl_xor(ss, 1);
        const float rstd = 1.0f / sqrtf(ss * (1.f / 64.f) + EPS);
        const size_t row = (size_t)b * SEQ + q0 + q;
        const int c0 = h * 64 + 32 * hf;
#pragma unroll
        for (int c = 0; c < 4; ++c) {
            const v4u zr = *(const v4u*)(F.PROJ + row * NPROJ + C_SBZ + c0 + 8 * c);
            const f32x4 w0 = *(const f32x4*)(F.sb_w + c0 + 8 * c), w1 = *(const f32x4*)(F.sb_w + c0 + 8 * c + 4);
            v4u w;
            w.x = pk2(ov[8 * c + 0] * rstd * w0.x * siluf_(bflo(zr.x)), ov[8 * c + 1] * rstd * w0.y * siluf_(bfhi(zr.x)));
            w.y = pk2(ov[8 * c + 2] * rstd * w0.z * siluf_(bflo(zr.y)), ov[8 * c + 3] * rstd * w0.w * siluf_(bfhi(zr.y)));
            w.z = pk2(ov[8 * c + 4] * rstd * w1.x * siluf_(bflo(zr.z)), ov[8 * c + 5] * rstd * w1.y * siluf_(bfhi(zr.z)));
            w.w = pk2(ov[8 * c + 6] * rstd * w1.z * siluf_(bflo(zr.w)), ov[8 * c + 7] * rstd * w1.w * siluf_(bfhi(zr.w)));
            *(v4u*)(F.Y + row * DM + c0 + 8 * c) = w;
        }
        asm volatile("" ::: "memory");
    }
}
constexpr int SL_N = 16384, SL_SC = 16512, SL_STRIDE = 16640;
__device__ __forceinline__ v4u scale8(v4u r, float s) {
    v4u o; o.x = cvtpk(bflo(r.x) * s, bfhi(r.x) * s); o.y = cvtpk(bflo(r.y) * s, bfhi(r.y) * s); o.z = cvtpk(bflo(r.z) * s, bfhi(r.z) * s); o.w = cvtpk(bflo(r.w) * s, bfhi(r.w) * s); return o;
}
template <int PASS> __device__ __forceinline__ void mlstm_fast(Ctx& F, float* SLOC) {
    constexpr int PT = 272, SP = 144, HP = 129;
    constexpr int L_Q = 0, L_K = 17408, L_V = 34816, L_VW = 52224, L_S = 69632, L_H = 78848, L_SC = 111872;
    LAS unsigned char* L = F.lds;
    LAS float* su = (LAS float*)(L + L_SC); LAS float* sM = su + 64; LAS float* sb = su + 128; LAS bf16* swb = (LAS bf16*)(su + 192);
    LAS float* Hs = (LAS float*)(L + L_H);
    int tid_ = F.tid; asm volatile("" : "+v"(tid_));
    const int tid = tid_, lane = tid & 63, w = __builtin_amdgcn_readfirstlane(tid >> 6), fr = lane & 15, fq = lane >> 4, tq = fr >> 2, tp = fr & 3;
    const int srow = tid >> 3, sc8 = tid & 7, v0 = 16 * w;
    const int nunits = PASS == 1 ? NB * 4 * 7 : NB * 4 * 8;
    for (int unit = blockIdx.x; unit < nunits; unit += gridDim.x) {
        int bh, seg; if (PASS == 1) { bh = unit / 7; seg = unit % 7; } else { bh = unit >> 3; seg = unit & 7; }
        const int b = bh >> 2, h = bh & 3;
        const size_t row0 = (size_t)b * SEQ + (size_t)seg * 512;
        f32x4 X[8], Xn[8];
#pragma unroll
        for (int t = 0; t < 8; ++t) { X[t] = (f32x4){0.f, 0.f, 0.f, 0.f}; Xn[t] = (f32x4){0.f, 0.f, 0.f, 0.f}; }
        float m_prev = PASS == 1 ? -1e30f : 0.f, bsum = 0.f;
        if (PASS == 2) {
            for (int j = 0; j < seg; ++j) {
                const float* S = SLOC + (size_t)(bh * 7 + j) * SL_STRIDE;
                const float mloc = S[SL_SC], Bs = S[SL_SC + 1];
                const float m_new = fmaxf(Bs + m_prev, mloc), fa = __expf(Bs + m_prev - m_new), fg = __expf(mloc - m_new);
#pragma unroll
                for (int t = 0; t < 8; ++t) { const f32x4 cl = *(const f32x4*)(S + (size_t)(t * 512 + tid) * 4); X[t] = X[t] * fa + cl * fg;
                    const f32x4 nl = *(const f32x4*)(S + SL_N + 16 * t + 4 * fq); Xn[t] = Xn[t] * fa + nl * fg; }
                m_prev = m_new;
            }
        }
        v4u pq0, pq1, pk0, pk1, pv0, pv1; float pig, plf;
#define MPREF(c_) do { const size_t rg_ = row0 + (size_t)(c_) * 64 + srow; \
            const bf16* qk_ = F.QKC + rg_ * 1024 + h * 128 + 8 * sc8; const bf16* vv_ = F.PROJ + rg_ * NPROJ + C_MLV + h * 128 + 8 * sc8; \
            if (PASS == 2) { pq0 = *(const v4u*)(qk_); pq1 = *(const v4u*)(qk_ + 64); } \
            pk0 = *(const v4u*)(qk_ + 512); pk1 = *(const v4u*)(qk_ + 512 + 64); pv0 = *(const v4u*)(vv_); pv1 = *(const v4u*)(vv_ + 64); \
            const float* gg_ = F.GATES + (row0 + (size_t)(c_) * 64 + lane) * 8; pig = gg_[h]; plf = gg_[4 + h]; } while (0)
        MPREF(0);
        for (int c = 0; c < 8; ++c) {
            const size_t rowc = row0 + (size_t)c * 64;
            __syncthreads();
            float bc = plf;
#pragma unroll
            for (int o = 1; o < 64; o <<= 1) { const float t_ = __shfl_up(bc, o); if (lane >= o) bc += t_; }
            const float u = pig - bc; float pm = u;
#pragma unroll
            for (int o = 1; o < 64; o <<= 1) { const float t_ = __shfl_up(pm, o); if (lane >= o) pm = fmaxf(pm, t_); }
            const float Mv = fmaxf(m_prev, pm), M63 = __shfl(Mv, 63), blast = __shfl(bc, 63);
            const float wgt = __expf(u - M63);
            if (w == 0) { su[lane] = u; sM[lane] = Mv; sb[lane] = bc; swb[lane] = (bf16)(cvtpk(wgt, 0.f) & 0xffffu); }
            const float wrow = __shfl(wgt, srow);
            *(LAS v4u*)(L + L_K + srow * PT + 16 * sc8) = pk0; *(LAS v4u*)(L + L_K + srow * PT + 16 * (sc8 + 8)) = pk1;
            *(LAS v4u*)(L + L_VW + srow * PT + 16 * sc8) = scale8(pv0, wrow); *(LAS v4u*)(L + L_VW + srow * PT + 16 * (sc8 + 8)) = scale8(pv1, wrow);
            if (PASS == 2) {
                *(LAS v4u*)(L + L_Q + srow * PT + 16 * sc8) = pq0; *(LAS v4u*)(L + L_Q + srow * PT + 16 * (sc8 + 8)) = pq1;
                *(LAS v4u*)(L + L_V + srow * PT + 16 * sc8) = pv0; *(LAS v4u*)(L + L_V + srow * PT + 16 * (sc8 + 8)) = pv1;
            }
            if (c + 1 < 8) MPREF(c + 1);
            __syncthreads();
            if (PASS == 2) {
                const int lt = w & 3, sp = w >> 2;
#pragma unroll
                for (int si = 0; si < 2; ++si) {
                    const int st = 2 * sp + si;
                    f32x4 acc = (f32x4){0.f, 0.f, 0.f, 0.f};
                    if (st <= lt) {
#pragma unroll
                        for (int ks = 0; ks < 4; ++ks) {
                            const bf16x8 ak = *(const LAS bf16x8*)(L + L_K + (16 * st + fr) * PT + (32 * ks + 8 * fq) * 2);
                            const bf16x8 bq = *(const LAS bf16x8*)(L + L_Q + (16 * lt + fr) * PT + (32 * ks + 8 * fq) * 2);
                            acc = __builtin_amdgcn_mfma_f32_16x16x32_bf16(ak, bq, acc, 0, 0, 0);
                        }
                        const f32x4 us = *(const LAS f32x4*)(su + 16 * st + 4 * fq); const float Ml = sM[16 * lt + fr];
                        const int l = 16 * lt + fr, s0 = 16 * st + 4 * fq;
#pragma unroll
                        for (int j = 0; j < 4; ++j) acc[j] = (s0 + j <= l) ? acc[j] * __expf(us[j] - Ml) : 0.f;
                    }
                    v2u pw; pw.x = cvtpk(acc[0], acc[1]); pw.y = cvtpk(acc[2], acc[3]);
                    *(LAS v2u*)(L + L_S + (16 * lt + fr) * SP + (16 * st + 4 * fq) * 2) = pw;
                }
                __syncthreads();
                f32x4 num[4], den[4];
#pragma unroll
                for (int i = 0; i < 4; ++i) { num[i] = (f32x4){0.f, 0.f, 0.f, 0.f}; den[i] = (f32x4){0.f, 0.f, 0.f, 0.f}; }
#pragma unroll
                for (int kk = 0; kk < 4; ++kk) {
                    v4u bsw, bnw;
                    bsw.x = cvtpk(X[2 * kk][0], X[2 * kk][1]); bsw.y = cvtpk(X[2 * kk][2], X[2 * kk][3]); bsw.z = cvtpk(X[2 * kk + 1][0], X[2 * kk + 1][1]); bsw.w = cvtpk(X[2 * kk + 1][2], X[2 * kk + 1][3]);
                    bnw.x = cvtpk(Xn[2 * kk][0], Xn[2 * kk][1]); bnw.y = cvtpk(Xn[2 * kk][2], Xn[2 * kk][3]); bnw.z = cvtpk(Xn[2 * kk + 1][0], Xn[2 * kk + 1][1]); bnw.w = cvtpk(Xn[2 * kk + 1][2], Xn[2 * kk + 1][3]);
                    const bf16x8 bs = __builtin_bit_cast(bf16x8, bsw), bn = __builtin_bit_cast(bf16x8, bnw);
#pragma unroll
                    for (int i = 0; i < 4; ++i) {
                        const LAS unsigned char* qa = L + L_Q + (16 * i + fr) * PT + (32 * kk + 4 * fq) * 2;
                        const v2u lo = *(const LAS v2u*)qa, hi = *(const LAS v2u*)(qa + 32);
                        const v4u aw = {lo.x, lo.y, hi.x, hi.y}; const bf16x8 aq = __builtin_bit_cast(bf16x8, aw);
                        num[i] = __builtin_amdgcn_mfma_f32_16x16x32_bf16(aq, bs, num[i], 0, 0, 0);
                        den[i] = __builtin_amdgcn_mfma_f32_16x16x32_bf16(aq, bn, den[i], 0, 0, 0);
                    }
                    __builtin_amdgcn_sched_barrier(0);
                }
#pragma unroll
                for (int i = 0; i < 4; ++i) { const f32x4 Ml = *(const LAS f32x4*)(sM + 16 * i + 4 * fq);
#pragma unroll
                    for (int j = 0; j < 4; ++j) { const float cs = __expf(m_prev - Ml[j]); num[i][j] *= cs; den[i][j] *= cs; } }
                const v4u onesw = {0x3f803f80u, 0x3f803f80u, 0x3f803f80u, 0x3f803f80u}; const bf16x8 ones = __builtin_bit_cast(bf16x8, onesw);
#pragma unroll
                for (int ks = 0; ks < 2; ++ks) {
                    const LAS unsigned char* vb = L + L_V + (32 * ks + 8 * fq + tq) * PT + (v0 + 4 * tp) * 2;
                    const s16x4 lo = vtr(vb), hi4 = vtr(vb + 4 * PT);
                    const bf16x8 bv = {lo[0], lo[1], lo[2], lo[3], hi4[0], hi4[1], hi4[2], hi4[3]};
#pragma unroll
                    for (int i = 0; i < 4; ++i) {
                        if (32 * ks > 16 * i + 15) continue;
                        const bf16x8 as = *(const LAS bf16x8*)(L + L_S + (16 * i + fr) * SP + (32 * ks + 8 * fq) * 2);
                        num[i] = __builtin_amdgcn_mfma_f32_16x16x32_bf16(as, bv, num[i], 0, 0, 0);
                        den[i] = __builtin_amdgcn_mfma_f32_16x16x32_bf16(as, ones, den[i], 0, 0, 0);
                    }
                }
#pragma unroll
                for (int i = 0; i < 4; ++i) { const f32x4 Ml = *(const LAS f32x4*)(sM + 16 * i + 4 * fq), bl = *(const LAS f32x4*)(sb + 16 * i + 4 * fq);
#pragma unroll
                    for (int j = 0; j < 4; ++j) Hs[(16 * i + 4 * fq + j) * HP + v0 + fr] = num[i][j] / fmaxf(fabsf(den[i][j]), __expf(-(bl[j] + Ml[j]))); }
            }
            {
                const float a = __expf(m_prev - M63);
#pragma unroll
                for (int t = 0; t < 8; ++t) { X[t] *= a; Xn[t] *= a; }
#pragma unroll
                for (int ks = 0; ks < 2; ++ks) {
                    const LAS unsigned char* vb = L + L_VW + (32 * ks + 8 * fq + tq) * PT + (v0 + 4 * tp) * 2;
                    const s16x4 lo = vtr(vb), hi4 = vtr(vb + 4 * PT);
                    const bf16x8 bv = {lo[0], lo[1], lo[2], lo[3], hi4[0], hi4[1], hi4[2], hi4[3]};
                    const bf16x8 bw = *(const LAS bf16x8*)(swb + 32 * ks + 8 * fq);
#pragma unroll
                    for (int t = 0; t < 8; ++t) {
                        const LAS unsigned char* kb = L + L_K + (32 * ks + 8 * fq + tq) * PT + (16 * t + 4 * tp) * 2;
                        const s16x4 klo = vtr(kb), khi = vtr(kb + 4 * PT);
                        const bf16x8 ak = {klo[0], klo[1], klo[2], klo[3], khi[0], khi[1], khi[2], khi[3]};
                        X[t] = __builtin_amdgcn_mfma_f32_16x16x32_bf16(ak, bv, X[t], 0, 0, 0);
                        Xn[t] = __builtin_amdgcn_mfma_f32_16x16x32_bf16(ak, bw, Xn[t], 0, 0, 0);
                        if (t & 1) __builtin_amdgcn_sched_barrier(0);
                    }
                }
                m_prev = blast + M63; bsum += blast;
            }
            if (PASS == 2) {
                v4u po0, po1, pz0, pz1;
                { const bf16* oz = F.PROJ + (rowc + srow) * NPROJ + h * 128 + 16 * sc8;
                  po0 = *(const v4u*)(oz + C_MLO); po1 = *(const v4u*)(oz + C_MLO + 8); pz0 = *(const v4u*)(oz + C_MLZ); pz1 = *(const v4u*)(oz + C_MLZ + 8); }
                __syncthreads();
                const unsigned ow[8] = {po0.x, po0.y, po0.z, po0.w, po1.x, po1.y, po1.z, po1.w}, zw[8] = {pz0.x, pz0.y, pz0.z, pz0.w, pz1.x, pz1.y, pz1.z, pz1.w};
                float yv[16]; float ss = 0.f;
#pragma unroll
                for (int e = 0; e < 8; ++e) { const float h0 = Hs[srow * HP + 16 * sc8 + 2 * e], h1 = Hs[srow * HP + 16 * sc8 + 2 * e + 1];
                    yv[2 * e] = sigmoidf_(bflo(ow[e])) * h0; yv[2 * e + 1] = sigmoidf_(bfhi(ow[e])) * h1; ss += yv[2 * e] * yv[2 * e] + yv[2 * e + 1] * yv[2 * e + 1]; }
                ss += __shfl_xor(ss, 1); ss += __shfl_xor(ss, 2); ss += __shfl_xor(ss, 4);
                const float rstd = 1.0f / sqrtf(ss * (1.f / 128.f) + EPS);
                const float* nw = F.ml_w + h * 128 + 16 * sc8;
                unsigned outw[8];
#pragma unroll
                for (int e = 0; e < 8; ++e) outw[e] = pk2(yv[2 * e] * rstd * nw[2 * e] * siluf_(bflo(zw[e])), yv[2 * e + 1] * rstd * nw[2 * e + 1] * siluf_(bfhi(zw[e])));
                bf16* yp = F.Y + (rowc + srow) * DM + 512 + h * 128 + 16 * sc8;
                *(v4u*)yp = (v4u){outw[0], outw[1], outw[2], outw[3]}; *(v4u*)(yp + 8) = (v4u){outw[4], outw[5], outw[6], outw[7]};
            }
        }
#undef MPREF
        if (PASS == 1) {
            float* S = SLOC + (size_t)(bh * 7 + seg) * SL_STRIDE;
#pragma unroll
            for (int t = 0; t < 8; ++t) { *(f32x4*)(S + (size_t)(t * 512 + tid) * 4) = X[t]; if (w == 0 && fr == 0) *(f32x4*)(S + SL_N + 16 * t + 4 * fq) = Xn[t]; }
            if (tid == 0) { S[SL_SC] = m_prev; S[SL_SC + 1] = bsum; }
        }
        __syncthreads();
    }
}
#define MIXERS(F) do { attn_fast(F); mlstm_fast<1>(F, (float*)(args.ws + WS_PB)); GRID_SEAM(); mlstm_fast<2>(F, (float*)(args.ws + WS_PB)); } while (0)
#ifndef REP_SYNC
#define REP_SYNC 0
#endif
#ifndef REP_P0
#define REP_P0 1
#endif
#ifndef REP_P1
#define REP_P1 1
#endif
#ifndef REP_P3
#define REP_P3 1
#endif
__global__ void __launch_bounds__(512, 2) fwd_kernel(Args args) {
    extern __shared__ __attribute__((aligned(16))) unsigned char lds_raw[];
    cg::grid_group grid = cg::this_grid();
    Ctx F;
    F.lds = (LAS unsigned char*)lds_raw;
    F.tid = threadIdx.x; F.lane = F.tid & 63; F.wave = __builtin_amdgcn_readfirstlane(F.tid >> 6);
    F.gw = blockIdx.x * 8 + F.wave; F.NGW = gridDim.x * 8;
    F.x = args.in[0]; F.p = args.in[1]; F.pre_w = args.in[2]; F.w_in = args.in[3]; F.conv_w = args.in[4]; F.conv_b = args.in[5]; F.i_bias = args.in[6]; F.f_bias = args.in[7];
    F.sb_w = args.in[8]; F.ml_w = args.in[9]; F.w_out = args.in[10]; F.post_w = args.in[11]; F.w_up = args.in[12]; F.w_gate = args.in[13]; F.b_gate = args.in[14];
    F.out = args.out; unsigned char* ws = args.ws;
    F.WT_IN = (bf16*)(ws + WS_WIN); F.WT_OUT = (bf16*)(ws + WS_WOUT); F.WT_GATE = (bf16*)(ws + WS_WGATE); F.WT_UP = (bf16*)(ws + WS_WUP); F.GATES = (float*)(ws + WS_GATES);
    F.U = (bf16*)(ws + WS_U); F.Y = F.U; F.HB = F.U; F.PROJ = (bf16*)(ws + WS_PROJ); F.Y2 = F.PROJ; F.PU = (bf16*)(ws + WS_PU); F.PB = (bf16*)(ws + WS_PB); F.QKC = (bf16*)(ws + WS_QKC);

    volatile LAS unsigned* bar_st = (volatile LAS unsigned*)(F.lds + 131072 + 512);
    if (F.tid < 2) bar_st[F.tid] = 0u;
    unsigned* bar_words = (unsigned*)args.ws;
    if (blockIdx.x == 0) for (int i = F.tid; i < XCD_BAR_WORDS; i += 512) __hip_atomic_store(bar_words + i, 0u, __ATOMIC_RELAXED, __HIP_MEMORY_SCOPE_AGENT);
    for (int rep_ = 0; rep_ < REP_P0; ++rep_) phase0(F);
    grid.sync();
    const XcdBarrier xbar = xcd_barrier_post(bar_words, bar_st);
#define GRID_SEAM() xcd_barrier(xbar)
    for (int rep_ = 0; rep_ < REP_SYNC; ++rep_) GRID_SEAM();
    for (int rep_ = 0; rep_ < REP_P1; ++rep_) {
        pg8::Gemm g{F.U, F.WT_IN, MTOK, NPROJ, DM}; pg8::StaticOrder S; S.init(MTOK, NPROJ, gridDim.x, blockIdx.x);
        pg8::EpiBf16<0> E{F.PROJ, NPROJ, nullptr, 512, 512, 0.125f * 1.4426950408889634f};
        pg8::gemm_phase<pg8::EpiBf16<0>, pg8::StaticOrder, true, true>(F.lds, g, S, E);
        pg8::Gemm g2{F.PB, F.WT_UP, MTOK, DM, PLE}; pg8::StaticOrder S2; S2.init(MTOK, DM, gridDim.x, blockIdx.x);
        pg8::EpiBf16<0> E2{F.PU, DM, nullptr, 0, 0, 1.f};
        pg8::gemm_phase<pg8::EpiBf16<0>, pg8::StaticOrder, true, true>(F.lds, g2, S2, E2);
    }
    GRID_SEAM();
    for (int rep_ = 0; rep_ < REP_P0; ++rep_) phase_conv(F);
    GRID_SEAM();
    MIXERS(F);
    GRID_SEAM();
    for (int rep_ = 0; rep_ < REP_P3; ++rep_) {
        pg8::Gemm g{F.Y, F.WT_OUT, MTOK, DM, DM}; pg8::StaticOrder S; S.init(MTOK, DM, gridDim.x, blockIdx.x);
        pg8::EpiBf16<0> E{F.Y2, DM, nullptr, 0, 0, 1.f};
        pg8::gemm_phase<pg8::EpiBf16<0>, pg8::StaticOrder, true, true>(F.lds, g, S, E);
    }
    GRID_SEAM();
    for (int rep_ = 0; rep_ < REP_P0; ++rep_) phase_norm(F);
    GRID_SEAM();
    {
        pg8::Gemm g{F.HB, F.WT_GATE, MTOK, DM, DM}; pg8::StaticOrder S; S.init(MTOK, DM, gridDim.x, blockIdx.x);
        EpiGate E{F.out, F.PU, F.b_gate};
        pg8::gemm_phase<EpiGate, pg8::StaticOrder, true, true>(F.lds, g, S, E);
    }
}

extern "C" void kernel_launch(void* const* d_in, const int* in_sizes, int n_in, void* d_out, int out_size, void* d_ws, size_t ws_size, hipStream_t stream) {
    static int grid = 0;
    if (grid == 0) {
        if (n_in != 15 || out_size != MTOK * DM || ws_size < WS_END) { fprintf(stderr, "kernel_launch: unexpected shapes (n_in %d out %d ws %zu)\n", n_in, out_size, ws_size); grid = -1; return; }
        int dev = 0, cus = 0, per_cu = 0;
        (void)hipGetDevice(&dev); (void)hipDeviceGetAttribute(&cus, hipDeviceAttributeMultiprocessorCount, dev);
        if (hipFuncSetAttribute((const void*)fwd_kernel, hipFuncAttributeMaxDynamicSharedMemorySize, LDS_BYTES) != hipSuccess) { fprintf(stderr, "kernel_launch: hipFuncSetAttribute failed\n"); grid = -1; return; }
        if (hipOccupancyMaxActiveBlocksPerMultiprocessor(&per_cu, (const void*)fwd_kernel, 512, LDS_BYTES) != hipSuccess || per_cu < 1) { fprintf(stderr, "kernel_launch: occupancy query says %d\n", per_cu); per_cu = 1; }
        (void)hipGetLastError();
        grid = cus * 1;
        if (grid <= 0) grid = 256;
    }
    if (grid < 0) return;
    Args a{};
    for (int i = 0; i < 15; ++i) a.in[i] = (const float*)d_in[i];
    a.out = (float*)d_out; a.ws = (unsigned char*)d_ws;
    void* kargs[] = {&a};
    hipError_t e = hipLaunchCooperativeKernel((const void*)fwd_kernel, dim3(grid), dim3(512), kargs, LDS_BYTES, stream);
    if (e != hipSuccess) fprintf(stderr, "kernel_launch: cooperative launch failed: %s (grid %d)\n", hipGetErrorString(e), grid);
}
```

```cpp
#include <hip/hip_runtime.h>
#include <hip/hip_cooperative_groups.h>
#include <cstdio>
#include <cstdint>
namespace cg = cooperative_groups;

namespace pg8 {
#define PG8_LAS __attribute__((address_space(3)))
typedef unsigned short bf16_t;
typedef short bf16x8 __attribute__((ext_vector_type(8)));
typedef float f32x4 __attribute__((ext_vector_type(4)));
typedef unsigned u32x4 __attribute__((ext_vector_type(4)));
constexpr int BM = 256, BK = 64, HALF = 128, HTB = HALF * BK * 2  , STAGE_BYTES = 8 * HTB, NXCD = 8, WGM = 8;

__host__ __device__ __forceinline__ int lds_byte(int r, int c) { const int st = (r >> 4) * 2 + (c >> 5), rr = r & 15, cc = c & 31, ob = rr * 64 + cc * 2; return st * 1024 + (ob ^ (((ob >> 9) & 1) << 5)); }
__host__ __device__ __forceinline__ void stage_rc(int b, int& R, int& C) { const int st = b / 1024, sb = b % 1024, swz = sb ^ (((sb >> 9) & 1) << 5); R = (st >> 1) * 16 + swz / 64; C = (st & 1) * 32 + (swz % 64) / 2; }
__host__ __device__ __forceinline__ int perm32(int rho) { const int n = rho >> 4, i = rho & 15; return 8 * (i >> 2) + 4 * n + (i & 3); }

struct Unit { int pm, pn; };
struct Gemm { const bf16_t* A; const bf16_t* Bt; int M, N, K; };

struct StaticOrder {
    int nM, nN, nwg, G, c;
    __host__ __device__ void init(int M, int N, int G_, int c_) { nM = M / BM; nN = N / BM; nwg = nM * nN; G = G_; c = c_; }
    __host__ __device__ bool next(int i, Unit& u) const {
        const long L = (long)i * G + c; if (L >= nwg) return false;
        int wgid = (int)L; { const int q = nwg / NXCD, r = nwg % NXCD, xcd = wgid % NXCD, off = wgid / NXCD; wgid = (xcd < r ? xcd * (q + 1) : r * (q + 1) + (xcd - r) * q) + off; }
        const int nig = WGM * nN, gid = wgid / nig, fm = gid * WGM, gsz = (nM - fm) < WGM ? (nM - fm) : WGM;
        u.pm = fm + ((wgid % nig) % gsz); u.pn = (wgid % nig) / gsz; return true;
    }
    __device__ __forceinline__ void a_ready(const Unit&) const {}
    __device__ __forceinline__ void done(const Unit&) const {}
};

__device__ __forceinline__ unsigned cvt_pk_bf16(float lo, float hi) { unsigned r; asm volatile("v_cvt_pk_bf16_f32 %0, %1, %2" : "=v"(r) : "v"(lo), "v"(hi)); return r; }
typedef float f32x2 __attribute__((ext_vector_type(2)));
__device__ __forceinline__ f32x2 gelu_pk(f32x2 v) {
    const f32x2 av = __builtin_elementwise_abs(v), d = av * 0.2316418882f + 1.0f;
    f32x2 t; t.x = __builtin_amdgcn_rcpf(d.x); t.y = __builtin_amdgcn_rcpf(d.y);
    f32x2 q = t * 0.5307027145f + (-0.7265760135f); q = q * t + 0.7107068705f; q = q * t + (-0.142248368f); q = q * t + 0.127414796f; q = q * t;
    const f32x2 s = (v * v) * (-0.72134752044f);
    f32x2 e; e.x = __builtin_amdgcn_exp2f(s.x); e.y = __builtin_amdgcn_exp2f(s.y);
    const f32x2 m = v * (q * e), r = v - m;
    f32x2 o; o.x = v.x < 0.f ? m.x : r.x; o.y = v.y < 0.f ? m.y : r.y; return o;
}

template <int ACT  > struct EpiBf16 {
    static constexpr bool PERM = true, AFTER_DRAIN = false; static_assert(ACT == 0 || ACT == 1, "EpiBf16: ACT is 0 (none) or 1 (gelu_pk)");
    bf16_t* O; int ldc; const float* bias; int split_cols; size_t split_stride; float scale0;
    __device__ __forceinline__ void operator()(const f32x4 (&acc)[2][2][4][2], const Unit& u, int wr, int wc, int fr, int fq) const {
        const int row0 = u.pm * BM + wr * 64 + fr; int colt = u.pn * BM; bf16_t* base = O;
        float sc = 1.f; if (split_cols) { const int t = colt / split_cols; base += (size_t)t * split_stride; colt -= t * split_cols; if (t == 0) sc = scale0; }
        const int col0 = colt + wc * 32 + 8 * fq, bcol0 = u.pn * BM + wc * 32 + 8 * fq;
        f32x4 bv[2][2];
#pragma unroll
        for (int bj = 0; bj < 2; ++bj)
#pragma unroll
            for (int n = 0; n < 2; ++n) bv[bj][n] = bias ? *(const f32x4*)(bias + bcol0 + bj * HALF + 4 * n) : (f32x4){0.f, 0.f, 0.f, 0.f};
#pragma unroll
        for (int ai = 0; ai < 2; ++ai)
#pragma unroll
            for (int m = 0; m < 4; ++m) { bf16_t* rowp = base + (size_t)(row0 + ai * HALF + m * 16) * ldc + col0;
#pragma unroll
                for (int bj = 0; bj < 2; ++bj) { f32x4 v0 = acc[ai][bj][m][0] + bv[bj][0], v1 = acc[ai][bj][m][1] + bv[bj][1];
                    if (ACT == 1) { f32x2 a = gelu_pk((f32x2){v0[0], v0[1]}), b = gelu_pk((f32x2){v0[2], v0[3]}), c = gelu_pk((f32x2){v1[0], v1[1]}), d = gelu_pk((f32x2){v1[2], v1[3]});
                        v0 = (f32x4){a.x, a.y, b.x, b.y}; v1 = (f32x4){c.x, c.y, d.x, d.y}; }
                    v0 = v0 * sc; v1 = v1 * sc; u32x4 w; w.x = cvt_pk_bf16(v0[0], v0[1]); w.y = cvt_pk_bf16(v0[2], v0[3]); w.z = cvt_pk_bf16(v1[0], v1[1]); w.w = cvt_pk_bf16(v1[2], v1[3]);
                    *(u32x4*)(rowp + bj * HALF) = w; } }
    }
};

template <class Epi, class Sched, bool ALIGN_EPI = false, bool SP2 = false>
__device__ __forceinline__ void gemm_phase(PG8_LAS unsigned char* lds, const Gemm g, const Sched& S, const Epi& E) {
    int tid_ = threadIdx.x; asm volatile("" : "+v"(tid_));
    const int tid = tid_, wid = __builtin_amdgcn_readfirstlane(tid >> 6), lane = tid & 63, wr = wid >> 2, wc = wid & 3, fr = lane & 15, fq = lane >> 4;
    const int K = g.K, nt = K / BK;
    unsigned voffA[2], voffB[2];
#pragma unroll
    for (int i = 0; i < 2; ++i) { int R, C; stage_rc(tid * 16 + i * 8192, R, C); const int Rb = Epi::PERM ? ((R & ~31) + perm32(R & 31)) : R;
        voffA[i] = (unsigned)(R * K + C) * 2u; voffB[i] = (unsigned)(Rb * K + C) * 2u; }
    const size_t kstep = (size_t)(BK * 2);
    const size_t hstep = (size_t)HALF * K * 2;
    const size_t tstep = 2 * hstep;
    const unsigned ldsw = (unsigned)wid * 1024u;
    const int aoff = lds_byte(wr * 64 + fr, fq * 8), boff = lds_byte(wc * 32 + fr, fq * 8);
#define PG8_SA(b, h) (((b) * 2 + (h)) * HTB)
#define PG8_SB(b, h) ((4 + (b) * 2 + (h)) * HTB)
#define PG8_STAGE(bufoff, gbase, voff) do { _Pragma("unroll") for (int _i = 0; _i < 2; ++_i) \
        __builtin_amdgcn_global_load_lds((const unsigned*)((const char*)(gbase) + (voff)[_i]), (PG8_LAS unsigned*)(lds + (bufoff) + ldsw + _i * 8192), 16, 0, 0); } while (0)
#define PG8_LDA(dst, b, h) do { _Pragma("unroll") for (int m = 0; m < 4; ++m) _Pragma("unroll") for (int k = 0; k < 2; ++k) dst[m][k] = *(const PG8_LAS bf16x8*)(lds + PG8_SA(b, h) + aoff + m * 2048 + k * 1024); } while (0)
#define PG8_LDB(dst, b, h) do { _Pragma("unroll") for (int n = 0; n < 2; ++n) _Pragma("unroll") for (int k = 0; k < 2; ++k) dst[n][k] = *(const PG8_LAS bf16x8*)(lds + PG8_SB(b, h) + boff + n * 2048 + k * 1024); } while (0)
#define PG8_MMA(ai, bj, At, Bt) do { __builtin_amdgcn_s_setprio(1); _Pragma("unroll") for (int m = 0; m < 4; ++m) _Pragma("unroll") for (int n = 0; n < 2; ++n) _Pragma("unroll") for (int k = 0; k < 2; ++k) \
        acc[ai][bj][m][n] = __builtin_amdgcn_mfma_f32_16x16x32_bf16(Bt[n][k], At[m][k], acc[ai][bj][m][n], 0, 0, 0); __builtin_amdgcn_s_setprio(0); } while (0)
#define PG8_WAIT_V(n) asm volatile("s_waitcnt vmcnt(" #n ")" ::: "memory")
#define PG8_WAIT_L(n) asm volatile("s_waitcnt lgkmcnt(" #n ")" ::: "memory")
#define PG8_BAR __builtin_amdgcn_s_barrier()
#define PG8_SCHED __builtin_amdgcn_sched_barrier(0)
    Unit cur, nxt; int ui = 0;
    if (!S.next(0, cur)) return;
    f32x4 acc[2][2][4][2];
#pragma unroll
    for (int a = 0; a < 2; ++a)
#pragma unroll
        for (int b = 0; b < 2; ++b)
#pragma unroll
            for (int m = 0; m < 4; ++m)
#pragma unroll
                for (int n = 0; n < 2; ++n) acc[a][b][m][n] = (f32x4){0.f, 0.f, 0.f, 0.f};
    bf16x8 At[4][2], B0[2][2], B1[2][2];
    const char* cA = (const char*)g.A + (size_t)cur.pm * tstep; const char* cB = (const char*)g.Bt + (size_t)cur.pn * tstep;
    S.a_ready(cur);
    if constexpr (SP2) {
        PG8_STAGE(PG8_SB(0, 0), cB, voffB); PG8_STAGE(PG8_SB(0, 1), cB + hstep, voffB); PG8_STAGE(PG8_SA(0, 0), cA, voffA); PG8_STAGE(PG8_SA(0, 1), cA + hstep, voffA);
        if (wr == 1) PG8_BAR;
        PG8_WAIT_V(2); PG8_BAR;
        PG8_STAGE(PG8_SB(1, 0), cB + kstep, voffB); PG8_STAGE(PG8_SA(1, 0), cA + kstep, voffA); PG8_STAGE(PG8_SB(1, 1), cB + hstep + kstep, voffB);
        PG8_WAIT_V(6); PG8_BAR;
    } else {
        PG8_STAGE(PG8_SB(0, 0), cB, voffB); PG8_STAGE(PG8_SA(0, 0), cA, voffA); PG8_STAGE(PG8_SB(0, 1), cB + hstep, voffB); PG8_STAGE(PG8_SA(0, 1), cA + hstep, voffA);
        if (wr == 1) PG8_BAR;
        PG8_WAIT_V(4); PG8_BAR;
        PG8_STAGE(PG8_SB(1, 0), cB + kstep, voffB); PG8_STAGE(PG8_SA(1, 0), cA + kstep, voffA); PG8_STAGE(PG8_SB(1, 1), cB + hstep + kstep, voffB);
        PG8_WAIT_V(6); PG8_BAR;
    }
    for (;;) {
        const bool has_next = S.next(ui + 1, nxt);
        const char* nA = has_next ? (const char*)g.A + (size_t)nxt.pm * tstep : cA; const char* nB = has_next ? (const char*)g.Bt + (size_t)nxt.pn * tstep : cB;
        for (int t = 0; t < nt; t += 2) {
            const bool last = (t == nt - 2);
            const char* a1 = cA + (size_t)(t + 1) * kstep;
            const char* a2 = last ? nA : cA + (size_t)(t + 2) * kstep; const char* b2 = last ? nB : cB + (size_t)(t + 2) * kstep;
            const char* a3 = a2 + kstep; const char* b3 = b2 + kstep;
            if (last && has_next) S.a_ready(nxt);
            if constexpr (SP2) {
            PG8_LDB(B0, 0, 0); PG8_LDB(B1, 0, 1); PG8_SCHED; PG8_LDA(At, 0, 0); PG8_STAGE(PG8_SA(1, 1), a1 + hstep, voffA);
            PG8_WAIT_V(8); PG8_WAIT_L(0); PG8_BAR; PG8_MMA(0, 0, At, B0); PG8_MMA(0, 1, At, B1); PG8_BAR; PG8_SCHED;
            PG8_LDA(At, 0, 1); PG8_STAGE(PG8_SB(0, 0), b2, voffB); PG8_STAGE(PG8_SB(0, 1), b2 + hstep, voffB); PG8_STAGE(PG8_SA(0, 0), a2, voffA);
            PG8_WAIT_V(8); PG8_WAIT_L(0); PG8_BAR; PG8_MMA(1, 0, At, B0); PG8_MMA(1, 1, At, B1); PG8_BAR; PG8_SCHED;
            PG8_LDB(B0, 1, 0); PG8_LDB(B1, 1, 1); PG8_SCHED; PG8_LDA(At, 1, 0); PG8_STAGE(PG8_SA(0, 1), a2 + hstep, voffA);
            PG8_WAIT_V(8); PG8_WAIT_L(0); PG8_BAR; PG8_MMA(0, 0, At, B0); PG8_MMA(0, 1, At, B1); PG8_BAR; PG8_SCHED;
            PG8_LDA(At, 1, 1); PG8_STAGE(PG8_SB(1, 0), b3, voffB); PG8_STAGE(PG8_SB(1, 1), b3 + hstep, voffB); PG8_STAGE(PG8_SA(1, 0), a3, voffA);
            PG8_WAIT_V(8); PG8_WAIT_L(0); PG8_BAR; PG8_MMA(1, 0, At, B0); PG8_MMA(1, 1, At, B1); PG8_BAR; PG8_SCHED;
            } else {
            PG8_LDB(B0, 0, 0); PG8_SCHED; PG8_LDA(At, 0, 0); PG8_STAGE(PG8_SA(1, 1), a1 + hstep, voffA);
            PG8_WAIT_L(8); PG8_BAR; PG8_WAIT_L(0); PG8_MMA(0, 0, At, B0); PG8_BAR; PG8_SCHED;
            PG8_LDB(B1, 0, 1); PG8_STAGE(PG8_SB(0, 0), b2, voffB);
            PG8_BAR; PG8_WAIT_L(0); PG8_MMA(0, 1, At, B1); PG8_BAR;
            PG8_LDA(At, 0, 1); PG8_STAGE(PG8_SA(0, 0), a2, voffA);
            PG8_BAR; PG8_WAIT_L(0); PG8_MMA(1, 0, At, B0); PG8_BAR; PG8_SCHED;
            PG8_STAGE(PG8_SB(0, 1), b2 + hstep, voffB);
            PG8_WAIT_V(6); PG8_BAR; PG8_MMA(1, 1, At, B1); PG8_BAR;
            PG8_LDB(B0, 1, 0); PG8_SCHED; PG8_LDA(At, 1, 0); PG8_STAGE(PG8_SA(0, 1), a2 + hstep, voffA);
            PG8_WAIT_L(8); PG8_BAR; PG8_WAIT_L(0); PG8_MMA(0, 0, At, B0); PG8_BAR; PG8_SCHED;
            PG8_LDB(B1, 1, 1); PG8_STAGE(PG8_SB(1, 0), b3, voffB);
            PG8_BAR; PG8_WAIT_L(0); PG8_MMA(0, 1, At, B1); PG8_BAR;
            PG8_LDA(At, 1, 1); PG8_STAGE(PG8_SA(1, 0), a3, voffA);
            PG8_BAR; PG8_WAIT_L(0); PG8_MMA(1, 0, At, B0); PG8_BAR; PG8_SCHED;
            PG8_STAGE(PG8_SB(1, 1), b3 + hstep, voffB);
            PG8_WAIT_V(6); PG8_BAR; PG8_MMA(1, 1, At, B1); PG8_BAR;
            }
        }
        if constexpr (ALIGN_EPI) { if (wr == 0) PG8_BAR; }
        if constexpr (!Epi::AFTER_DRAIN) { E(acc, cur, wr, wc, fr, fq); S.done(cur); }
        if (!has_next) break;
#pragma unroll
        for (int a = 0; a < 2; ++a)
#pragma unroll
            for (int b = 0; b < 2; ++b)
#pragma unroll
                for (int m = 0; m < 4; ++m)
#pragma unroll
                    for (int n = 0; n < 2; ++n) acc[a][b][m][n] = (f32x4){0.f, 0.f, 0.f, 0.f};
        cur = nxt; cA = nA; cB = nB; ++ui;
        if constexpr (ALIGN_EPI) { if (wr == 1) PG8_BAR; }
    }
    PG8_WAIT_V(0);
    if constexpr (!ALIGN_EPI) { if (wr == 0) PG8_BAR; }
    PG8_BAR;
    if constexpr (Epi::AFTER_DRAIN) { E.fused(acc, cur, wr, wc, fr, fq, lds, wid, lane); S.done(cur); }
#undef PG8_SA
#undef PG8_SB
#undef PG8_STAGE
#undef PG8_LDA
#undef PG8_LDB
#undef PG8_MMA
#undef PG8_WAIT_V
#undef PG8_WAIT_L
#undef PG8_BAR
#undef PG8_SCHED
}
}
#define LAS __attribute__((address_space(3)))
typedef unsigned short bf16;
typedef unsigned v4u __attribute__((ext_vector_type(4)));
typedef unsigned v2u __attribute__((ext_vector_type(2)));
typedef float f32x4 __attribute__((ext_vector_type(4)));
typedef short bf16x8 __attribute__((ext_vector_type(8)));
typedef short s16x4 __attribute__((ext_vector_type(4)));
typedef float f32x16 __attribute__((ext_vector_type(16)));
constexpr int DM = 1024, NB = 8, SEQ = 4096, MTOK = NB * SEQ, NIN = 4616, NPROJ = 4608, PLE = 256;
constexpr int C_SBQ = 0, C_SBK = 512, C_SBV = 1024, C_SBZ = 1536, C_MLQ = 2048, C_MLK = 2560, C_MLV = 3072, C_MLO = 3584, C_MLZ = 4096;
constexpr float EPS = 1e-6f;
constexpr size_t MiB = 1u << 20;
constexpr size_t WS_WIN = 1 * MiB, WS_WOUT = 10 * MiB, WS_WGATE = 12 * MiB, WS_WUP = 14 * MiB, WS_GATES = 15 * MiB;
constexpr size_t WS_U = 16 * MiB;
constexpr size_t WS_PROJ = 80 * MiB;
constexpr size_t WS_PU = 368 * MiB, WS_PB = 432 * MiB, WS_QKC = 448 * MiB, WS_END = 512 * MiB;
constexpr int LDS_BYTES = 147456;

__device__ __forceinline__ unsigned f2bf(float f) { unsigned u = __builtin_bit_cast(unsigned, f); return (u + 0x7fffu + ((u >> 16) & 1u)) >> 16; }
__device__ __forceinline__ unsigned pk2(float lo, float hi) { return f2bf(lo) | (f2bf(hi) << 16); }
__device__ __forceinline__ float bflo(unsigned w) { return __builtin_bit_cast(float, w << 16); }
__device__ __forceinline__ float bfhi(unsigned w) { return __builtin_bit_cast(float, w & 0xffff0000u); }
__device__ __forceinline__ float bf1(bf16 v) { return __builtin_bit_cast(float, ((unsigned)v) << 16); }
__device__ __forceinline__ float wave_sum(float v) {
#pragma unroll
    for (int o = 1; o < 64; o <<= 1) v += __shfl_xor(v, o);
    return v;
}
__device__ __forceinline__ float sigmoidf_(float x) { return 1.f / (1.f + __expf(-x)); }
__device__ __forceinline__ float siluf_(float x) { return x / (1.f + __expf(-x)); }
#define LDS_WAIT() asm volatile("s_waitcnt lgkmcnt(0)" ::: "memory")

__device__ __forceinline__ void p0_transpose_item(const float* W, int K, int pitch, int nblk, bf16* WT, LAS float* scr, int item, int lane) {
    const int kb = item / nblk, nb = item % nblk, k0 = 64 * kb, n0 = 32 * nb;
#pragma unroll 8
    for (int i = 0; i < 32; ++i) { const int kk = 2 * i + (lane >> 5); scr[kk * 33 + (lane & 31)] = W[(size_t)(k0 + kk) * pitch + n0 + (lane & 31)]; }
    LDS_WAIT(); asm volatile("" ::: "memory");
    const int c = lane & 7;
#pragma unroll
    for (int j = 0; j < 4; ++j) { const int n = (lane >> 3) + 8 * j; const LAS float* s = scr + (8 * c) * 33 + n;
        v4u o; o.x = pk2(s[0 * 33], s[1 * 33]); o.y = pk2(s[2 * 33], s[3 * 33]); o.z = pk2(s[4 * 33], s[5 * 33]); o.w = pk2(s[6 * 33], s[7 * 33]);
        *(v4u*)(WT + (size_t)(n0 + n) * K + k0 + 8 * c) = o; }
    LDS_WAIT(); asm volatile("" ::: "memory");
}

struct EpiGate {
    static constexpr bool PERM = true, AFTER_DRAIN = false;
    float* out; const bf16* pu; const float* bias;
    __device__ __forceinline__ void operator()(const pg8::f32x4 (&acc)[2][2][4][2], const pg8::Unit& u, int wr, int wc, int fr, int fq) const {
        const int row0 = u.pm * 256 + wr * 64 + fr, col0 = u.pn * 256 + wc * 32 + 8 * fq;
#pragma unroll
        for (int ai = 0; ai < 2; ++ai)
#pragma unroll
            for (int m = 0; m < 4; ++m) { const size_t ro = (size_t)(row0 + ai * 128 + m * 16) * DM;
#pragma unroll
                for (int bj = 0; bj < 2; ++bj) { const int c = col0 + bj * 128;
                    const f32x4 b0 = *(const f32x4*)(bias + c), b1 = *(const f32x4*)(bias + c + 4);
                    const f32x4 h0 = *(const f32x4*)(out + ro + c), h1 = *(const f32x4*)(out + ro + c + 4);
                    const v4u pw = *(const v4u*)(pu + ro + c);
                    const f32x4 v0 = acc[ai][bj][m][0] + b0, v1 = acc[ai][bj][m][1] + b1;
                    f32x4 o0, o1;
                    o0[0] = h0[0] + sigmoidf_(v0[0]) * bflo(pw.x); o0[1] = h0[1] + sigmoidf_(v0[1]) * bfhi(pw.x);
                    o0[2] = h0[2] + sigmoidf_(v0[2]) * bflo(pw.y); o0[3] = h0[3] + sigmoidf_(v0[3]) * bfhi(pw.y);
                    o1[0] = h1[0] + sigmoidf_(v1[0]) * bflo(pw.z); o1[1] = h1[1] + sigmoidf_(v1[1]) * bfhi(pw.z);
                    o1[2] = h1[2] + sigmoidf_(v1[2]) * bflo(pw.w); o1[3] = h1[3] + sigmoidf_(v1[3]) * bfhi(pw.w);
                    *(f32x4*)(out + ro + c) = o0; *(f32x4*)(out + ro + c + 4) = o1; } }
    }
};

struct Args { const float* in[15]; float* out; unsigned char* ws; };
struct Ctx {
    LAS unsigned char* lds; int tid, lane, wave, gw, NGW;
    const float *x, *p, *pre_w, *w_in, *conv_w, *conv_b, *i_bias, *f_bias, *sb_w, *ml_w, *w_out, *post_w, *w_up, *w_gate, *b_gate;
    float* out; bf16 *WT_IN, *WT_OUT, *WT_GATE, *WT_UP, *U, *Y, *HB, *PROJ, *Y2, *PU, *PB, *QKC; float* GATES;
};

__device__ __forceinline__ void phase0(Ctx& F) {
    {
        LAS float* scr = (LAS float*)(F.lds + F.wave * 16384);
        constexpr int I_IN = 16 * 144, I_O = 16 * 32, I_G = 16 * 32, I_U = 4 * 32, NIT = I_IN + I_O + I_G + I_U;
        for (int it = F.gw; it < NIT; it += F.NGW) {
            int r = it;
            if (r < I_IN) { p0_transpose_item(F.w_in, DM, NIN, 144, F.WT_IN, scr, r, F.lane); continue; } r -= I_IN;
            if (r < I_O) { p0_transpose_item(F.w_out, DM, DM, 32, F.WT_OUT, scr, r, F.lane); continue; } r -= I_O;
            if (r < I_G) { p0_transpose_item(F.w_gate, DM, DM, 32, F.WT_GATE, scr, r, F.lane); continue; } r -= I_G;
            p0_transpose_item(F.w_up, PLE, DM, 32, F.WT_UP, scr, r, F.lane);
        }
    }
    __syncthreads();
    LAS float* Wg = (LAS float*)F.lds;
    for (int e = F.tid; e < 1024 * 8; e += 512) Wg[e] = F.w_in[(size_t)(e >> 3) * NIN + NPROJ + (e & 7)];
    __syncthreads();
    {
        f32x4 pw[4];
#pragma unroll
        for (int j = 0; j < 4; ++j) pw[j] = *((const f32x4*)F.pre_w + F.lane + 64 * j);
        f32x4 ib = *(const f32x4*)F.i_bias, fb = *(const f32x4*)F.f_bias;
        f32x4 vn[4];
        { const f32x4* xr = (const f32x4*)(F.x + (size_t)F.gw * DM) + F.lane;
#pragma unroll
          for (int j = 0; j < 4; ++j) vn[j] = xr[64 * j]; }
        for (int m = F.gw; m < MTOK; m += F.NGW) {
            f32x4 v[4];
#pragma unroll
            for (int j = 0; j < 4; ++j) v[j] = vn[j];
            if (m + F.NGW < MTOK) { const f32x4* xr = (const f32x4*)(F.x + (size_t)(m + F.NGW) * DM) + F.lane;
#pragma unroll
                for (int j = 0; j < 4; ++j) vn[j] = xr[64 * j]; }
            float s = 0.f;
#pragma unroll
            for (int j = 0; j < 4; ++j) s += (v[j].x * v[j].x + v[j].y * v[j].y) + (v[j].z * v[j].z + v[j].w * v[j].w);
            const float rstd = 1.0f / sqrtf(wave_sum(s) * (1.f / DM) + EPS);
            float g[8];
#pragma unroll
            for (int i = 0; i < 8; ++i) g[i] = 0.f;
            unsigned long long* o8 = (unsigned long long*)(F.U + (size_t)m * DM) + F.lane;
#pragma unroll
            for (int j = 0; j < 4; ++j) {
                const f32x4 u = v[j] * rstd * pw[j];
                o8[64 * j] = (unsigned long long)pk2(u.x, u.y) | ((unsigned long long)pk2(u.z, u.w) << 32);
#pragma unroll
                for (int e = 0; e < 4; ++e) { const LAS f32x4* wg = (const LAS f32x4*)(Wg + (256 * j + 4 * F.lane + e) * 8); const f32x4 a = wg[0], b = wg[1]; const float ue = u[e];
                    g[0] += ue * a.x; g[1] += ue * a.y; g[2] += ue * a.z; g[3] += ue * a.w; g[4] += ue * b.x; g[5] += ue * b.y; g[6] += ue * b.z; g[7] += ue * b.w; }
            }
#pragma unroll
            for (int i = 0; i < 8; ++i) g[i] = wave_sum(g[i]);
            if (F.lane == 0) {
                f32x4 gi, gf;
#pragma unroll
                for (int i = 0; i < 4; ++i) { gi[i] = g[i] + ib[i]; const float fp = g[4 + i] + fb[i];
                    gf[i] = fp >= 0.f ? -log1pf(expf(-fp)) : fp - log1pf(expf(fp)); }
                *(f32x4*)(F.GATES + (size_t)m * 8) = gi; *(f32x4*)(F.GATES + (size_t)m * 8 + 4) = gf;
            }
        }
    }
    for (size_t e = (size_t)(blockIdx.x * 512 + F.tid) * 8; e < (size_t)MTOK * PLE; e += (size_t)gridDim.x * 512 * 8) {
        const f32x4 a = *(const f32x4*)(F.p + e), b = *(const f32x4*)(F.p + e + 4);
        v4u o; o.x = pk2(a.x, a.y); o.y = pk2(a.z, a.w); o.z = pk2(b.x, b.y); o.w = pk2(b.z, b.w);
        *(v4u*)(F.PB + e) = o;
    }
}

__device__ __forceinline__ void phase_conv(Ctx& F) {
    const size_t NITEM = (size_t)MTOK * 128;
    for (size_t it = (size_t)blockIdx.x * 512 + F.tid; it < NITEM; it += (size_t)gridDim.x * 512) {
        const int row = (int)(it >> 7), c0 = (int)(it & 127) * 8, t = row & (SEQ - 1);
        float acc[8];
#pragma unroll
        for (int e = 0; e < 8; ++e) acc[e] = F.conv_b[c0 + e];
#pragma unroll
        for (int j = 0; j < 4; ++j) {
            if (t - 3 + j < 0) continue;
            const v4u r = *(const v4u*)(F.PROJ + (size_t)(row - 3 + j) * NPROJ + C_MLQ + c0);
            const f32x4 w0 = *(const f32x4*)(F.conv_w + j * 1024 + c0), w1 = *(const f32x4*)(F.conv_w + j * 1024 + c0 + 4);
            acc[0] += w0.x * bflo(r.x); acc[1] += w0.y * bfhi(r.x); acc[2] += w0.z * bflo(r.y); acc[3] += w0.w * bfhi(r.y);
            acc[4] += w1.x * bflo(r.z); acc[5] += w1.y * bfhi(r.z); acc[6] += w1.z * bflo(r.w); acc[7] += w1.w * bfhi(r.w);
        }
        const float sc = c0 >= 512 ? 0.08838834764831845f : 1.0f;
#pragma unroll
        for (int e = 0; e < 8; ++e) acc[e] = siluf_(acc[e]) * sc;
        v4u o; o.x = pk2(acc[0], acc[1]); o.y = pk2(acc[2], acc[3]); o.z = pk2(acc[4], acc[5]); o.w = pk2(acc[6], acc[7]);
        *(v4u*)(F.QKC + (size_t)row * 1024 + c0) = o;
    }
}

__device__ __forceinline__ void phase_norm(Ctx& F) {
    f32x4 pw[4];
#pragma unroll
    for (int j = 0; j < 2; ++j) { pw[2 * j] = *(const f32x4*)(F.post_w + 512 * j + 8 * F.lane); pw[2 * j + 1] = *(const f32x4*)(F.post_w + 512 * j + 8 * F.lane + 4); }
    v4u yn[2]; f32x4 xn[4];
#define NLOAD(m_) do { const v4u* yr_ = (const v4u*)(F.Y2 + (size_t)(m_) * DM) + F.lane; yn[0] = yr_[0]; yn[1] = yr_[64]; \
        const float* xp_ = F.x + (size_t)(m_) * DM + 8 * F.lane; xn[0] = *(const f32x4*)xp_; xn[1] = *(const f32x4*)(xp_ + 4); xn[2] = *(const f32x4*)(xp_ + 512); xn[3] = *(const f32x4*)(xp_ + 516); } while (0)
    NLOAD(F.gw);
    for (int m = F.gw; m < MTOK; m += F.NGW) {
        v4u yc[2] = {yn[0], yn[1]}; f32x4 xc[4] = {xn[0], xn[1], xn[2], xn[3]};
        if (m + F.NGW < MTOK) NLOAD(m + F.NGW);
        float y[16]; float s = 0.f;
#pragma unroll
        for (int j = 0; j < 2; ++j) { const v4u r = yc[j];
            y[8 * j + 0] = bflo(r.x); y[8 * j + 1] = bfhi(r.x); y[8 * j + 2] = bflo(r.y); y[8 * j + 3] = bfhi(r.y);
            y[8 * j + 4] = bflo(r.z); y[8 * j + 5] = bfhi(r.z); y[8 * j + 6] = bflo(r.w); y[8 * j + 7] = bfhi(r.w); }
#pragma unroll
        for (int e = 0; e < 16; ++e) s += y[e] * y[e];
        const float rstd = 1.0f / sqrtf(wave_sum(s) * (1.f / DM) + EPS);
#pragma unroll
        for (int j = 0; j < 2; ++j) {
            const int c = 512 * j + 8 * F.lane; const size_t o = (size_t)m * DM + c;
            f32x4 h0, h1;
#pragma unroll
            for (int e = 0; e < 4; ++e) { h0[e] = xc[2 * j][e] + y[8 * j + e] * rstd * pw[2 * j][e]; h1[e] = xc[2 * j + 1][e] + y[8 * j + 4 + e] * rstd * pw[2 * j + 1][e]; }
            *(f32x4*)(F.out + o) = h0; *(f32x4*)(F.out + o + 4) = h1;
            v4u hb; hb.x = pk2(h0[0], h0[1]); hb.y = pk2(h0[2], h0[3]); hb.z = pk2(h1[0], h1[1]); hb.w = pk2(h1[2], h1[3]);
            *(v4u*)(F.HB + o) = hb;
        }
    }
#undef NLOAD
}
#define XB_TMO      128
#define XB_XCNT(j)  (256  + 64 * (j))
#define XB_XSUB(j)  (1280 + 64 * (j))
#define XB_XGEN(j)  (2304 + 64 * (j))
#define XB_TOP      3328
#define XB_TOPGEN   3392
#define XCD_BAR_WORDS 3456
#define XB_SPIN_CAP (1u << 18)

__device__ __forceinline__ unsigned xb_ld(unsigned* p)              { return __hip_atomic_load(p, __ATOMIC_RELAXED, __HIP_MEMORY_SCOPE_AGENT); }
__device__ __forceinline__ unsigned xb_add(unsigned* p, unsigned v) { return __hip_atomic_fetch_add(p, v, __ATOMIC_RELAXED, __HIP_MEMORY_SCOPE_AGENT); }
__device__ __forceinline__ unsigned xb_xcc_id() { return (unsigned)__builtin_amdgcn_s_getreg((3 << 11) | 20) & 0xFu; }
#define XB_SPIN(cond, bar) do { unsigned _sp = 0; while (cond) { __builtin_amdgcn_s_sleep(1); \
    if ((++_sp & 255u) == 0u) { if (xb_ld(&(bar)[XB_TMO])) break; if (_sp > XB_SPIN_CAP) { atomicAdd(&(bar)[XB_TMO], 1u); break; } } } } while (0)

struct XcdBarrier {
    unsigned* bar; unsigned x;
    volatile LAS unsigned* st;
};

__device__ __forceinline__ XcdBarrier xcd_barrier_post(unsigned* bar, volatile LAS unsigned* st) {
    XcdBarrier b; b.bar = bar; b.x = xb_xcc_id(); b.st = st;
    if (threadIdx.x == 0) (void)xb_add(&bar[XB_XCNT(b.x)], 1u);
    return b;
}
__device__ __forceinline__ void xcd_barrier_complete(unsigned* bar, unsigned x, unsigned& nloc, unsigned& nx) {
    const unsigned G = gridDim.x * gridDim.y * gridDim.z;
    unsigned sum, cnt, mine, sp = 0u;
    for (;;) {
        sum = 0u; cnt = 0u; mine = 0u;
#pragma unroll
        for (unsigned j = 0; j < 16; ++j) { const unsigned c = xb_ld(&bar[XB_XCNT(j)]); sum += c; cnt += (c > 0u) ? 1u : 0u; mine = (j == x) ? c : mine; }
        if (sum == G) break;
        __builtin_amdgcn_s_sleep(1);
        if ((++sp & 255u) == 0u) { if (xb_ld(&bar[XB_TMO])) break; if (sp > XB_SPIN_CAP) { atomicAdd(&bar[XB_TMO], 1u); break; } }
    }
    nloc = mine > 0u ? mine : 1u; nx = cnt > 0u ? cnt : 1u;
}

__device__ __forceinline__ void xcd_barrier(const XcdBarrier& b) {
    asm volatile("s_waitcnt vmcnt(0)" ::: "memory");
    __syncthreads();
    if (threadIdx.x == 0) {
        unsigned* bar = b.bar;
        __builtin_amdgcn_s_waitcnt(0);
        unsigned nloc = b.st[0], nx = b.st[1];
        if (nloc == 0u) { xcd_barrier_complete(bar, b.x, nloc, nx); b.st[0] = nloc; b.st[1] = nx; }
        const unsigned old = xb_add(&bar[XB_XSUB(b.x)], 1u);
        const unsigned gen = old / nloc;
        if (old + 1u == (gen + 1u) * nloc) {
            __builtin_amdgcn_fence(__ATOMIC_RELEASE, "agent");
            asm volatile("s_waitcnt vmcnt(0)" ::: "memory");
            const unsigned og = xb_add(&bar[XB_TOP], 1u);
            const unsigned tg = og / nx;
            if (og + 1u == (tg + 1u) * nx) xb_add(&bar[XB_TOPGEN], 1u);
            else XB_SPIN(xb_ld(&bar[XB_TOPGEN]) == tg, bar);
            __builtin_amdgcn_fence(__ATOMIC_ACQUIRE, "agent");
            xb_add(&bar[XB_XGEN(b.x)], 1u);
            asm volatile("s_waitcnt vmcnt(0)" ::: "memory");
        } else {
            XB_SPIN(xb_ld(&bar[XB_XGEN(b.x)]) == gen, bar);
            __builtin_amdgcn_fence(__ATOMIC_ACQUIRE, "agent");
            asm volatile("s_waitcnt vmcnt(0)" ::: "memory");
        }
    }
    __syncthreads();
}

typedef short v4i16_t __attribute__((ext_vector_type(4)));
typedef float f32x2_t __attribute__((ext_vector_type(2)));
typedef __bf16 bf16x2_t __attribute__((ext_vector_type(2)));
__device__ __forceinline__ unsigned cvtpk(float lo, float hi) { f32x2_t v = {lo, hi}; bf16x2_t b = __builtin_convertvector(v, bf16x2_t); return __builtin_bit_cast(unsigned, b); }
__device__ __forceinline__ s16x4 vtr(const LAS unsigned char* p) { return __builtin_bit_cast(s16x4, __builtin_amdgcn_ds_read_tr16_b64_v4i16((LAS v4i16_t*)p)); }
__device__ __forceinline__ bf16x8 pack8(const f32x16& x, int s) {
    v4u p; p.x = cvtpk(x[8 * s + 0], x[8 * s + 1]); p.y = cvtpk(x[8 * s + 2], x[8 * s + 3]); p.z = cvtpk(x[8 * s + 4], x[8 * s + 5]); p.w = cvtpk(x[8 * s + 6], x[8 * s + 7]);
    return __builtin_bit_cast(bf16x8, p);
}
template <bool MASK> __device__ __forceinline__ void sb_half(f32x16& p, float& R, int kbase, int t, int hi) {
    float lk[16];
#pragma unroll
    for (int i = 0; i < 16; ++i) {
        const float z = p[i];
        float v = -(fmaxf(z, 0.f) + __builtin_amdgcn_logf(1.f + __builtin_amdgcn_exp2f(-fabsf(z))));
        if (MASK) { const int key = kbase + (i & 3) + 8 * (i >> 2); v = key < t ? v : 0.f; }
        lk[i] = v;
    }
#pragma unroll
    for (int g = 0; g < 4; ++g) { lk[4 * g + 2] += lk[4 * g + 3]; lk[4 * g + 1] += lk[4 * g + 2]; lk[4 * g] += lk[4 * g + 1]; }
    float Glo[4], Ghi[4];
#pragma unroll
    for (int g = 0; g < 4; ++g) { const float own = lk[4 * g], oth = __shfl_xor(own, 32); Glo[g] = hi ? oth : own; Ghi[g] = hi ? own : oth; }
    float acc = R;
#pragma unroll
    for (int g = 3; g >= 0; --g) {
        const float off1 = acc, off0 = acc + Ghi[g]; acc = off0 + Glo[g];
        const float off = hi ? off1 : off0;
#pragma unroll
        for (int e = 0; e < 4; ++e) { const int i = 4 * g + e;
            float a = __builtin_amdgcn_exp2f(p[i] + (lk[i] + off));
            if (MASK) { const int key = kbase + (i & 3) + 8 * (i >> 2); a = key < t ? a : 0.f; }
            p[i] = a; }
    }
    R = acc;
}
__device__ __forceinline__ void attn_fast(Ctx& F, unsigned* ctr) {
    constexpr int VP = 144;
    LAS unsigned char* vt = F.lds + F.wave * 16384;
    int lane_ = F.lane; asm volatile("" : "+v"(lane_));
    const int lane = lane_, r32 = lane & 31, hi = lane >> 5;
    const int i16 = lane & 15, tq = i16 >> 2, tp = i16 & 3, blk = (lane >> 4) & 1;
    const int troff = (4 * hi + tq) * VP + (16 * blk + 4 * tp) * 2;
    for (int unit = F.gw; unit < NB * 8 * (SEQ / 32); unit += F.NGW) {
        const int bh = unit >> 7, qb = unit & 127, b = bh >> 3, h = bh & 7, q0 = 32 * qb, t = q0 + r32;
        const bf16* base = F.PROJ + (size_t)b * SEQ * NPROJ + h * 64;
        bf16x8 qr[4];
        { const bf16* qp = base + (size_t)t * NPROJ + C_SBQ + 8 * hi;
#pragma unroll
          for (int d0 = 0; d0 < 4; ++d0) qr[d0] = *(const bf16x8*)(qp + 16 * d0); }
        const int kt = (q0 + 31) >> 6;
        bf16x8 kf[2][4]; v4u vr[8];
#define LOAD_KV(KF, VR, k0_) do { const bf16* kp_ = base + (size_t)((k0_) + r32) * NPROJ + C_SBK + 8 * hi; \
            _Pragma("unroll") for (int hh = 0; hh < 2; ++hh) _Pragma("unroll") for (int d0 = 0; d0 < 4; ++d0) KF[hh][d0] = *(const bf16x8*)(kp_ + (size_t)hh * 32 * NPROJ + 16 * d0); \
            const bf16* vp_ = base + (size_t)((k0_) + (lane >> 3)) * NPROJ + C_SBV + 8 * (lane & 7); \
            _Pragma("unroll") for (int i = 0; i < 8; ++i) VR[i] = *(const v4u*)(vp_ + (size_t)(8 * i) * NPROJ); } while (0)
        LOAD_KV(kf, vr, 64 * kt);
        f32x16 o[2];
#pragma unroll
        for (int i = 0; i < 16; ++i) { o[0][i] = 0.f; o[1][i] = 0.f; }
        float R = 0.f;
        for (int it = kt; it >= 0; --it) {
            const int k0 = 64 * it;
            asm volatile("" ::: "memory");
#pragma unroll
            for (int i = 0; i < 8; ++i) *(LAS v4u*)(vt + (8 * i + (lane >> 3)) * VP + 16 * (lane & 7)) = vr[i];
            asm volatile("" ::: "memory");
            bf16x8 kc[2][4];
#pragma unroll
            for (int hh = 0; hh < 2; ++hh)
#pragma unroll
                for (int d0 = 0; d0 < 4; ++d0) kc[hh][d0] = kf[hh][d0];
            if (it > 0) LOAD_KV(kf, vr, k0 - 64);
            const bool first = (it == kt);
            const bool do_hi = !first || (k0 + 32 <= q0 + 30);
            f32x16 p0, p1;
#pragma unroll
            for (int i = 0; i < 16; ++i) { p0[i] = 0.f; p1[i] = 0.f; }
#pragma unroll
            for (int d0 = 0; d0 < 4; ++d0) p0 = __builtin_amdgcn_mfma_f32_32x32x16_bf16(kc[0][d0], qr[d0], p0, 0, 0, 0);
            if (do_hi) {
#pragma unroll
                for (int d0 = 0; d0 < 4; ++d0) p1 = __builtin_amdgcn_mfma_f32_32x32x16_bf16(kc[1][d0], qr[d0], p1, 0, 0, 0);
                if (first) sb_half<true>(p1, R, k0 + 32 + 4 * hi, t, hi); else sb_half<false>(p1, R, k0 + 32 + 4 * hi, t, hi);
            }
            const bool do_lo = !(do_hi && __all(R < -151.f));
            if (do_lo) { if (first) sb_half<true>(p0, R, k0 + 4 * hi, t, hi); else sb_half<false>(p0, R, k0 + 4 * hi, t, hi); }
#pragma unroll
            for (int hh = 1; hh >= 0; --hh) {
                if (hh == 1 && !do_hi) continue;
                if (hh == 0 && !do_lo) continue;
#pragma unroll
                for (int s = 0; s < 2; ++s) {
                    const bf16x8 pa = pack8(hh ? p1 : p0, s);
#pragma unroll
                    for (int dh = 0; dh < 2; ++dh) {
                        const LAS unsigned char* vb = vt + troff + (32 * hh + 16 * s) * VP + 64 * dh;
                        const s16x4 lo = vtr(vb), hi4 = vtr(vb + 8 * VP);
                        const bf16x8 vf = {lo[0], lo[1], lo[2], lo[3], hi4[0], hi4[1], hi4[2], hi4[3]};
                        o[dh] = __builtin_amdgcn_mfma_f32_32x32x16_bf16(pa, vf, o[dh], 0, 0, 0);
                    }
                }
            }
            if (!do_lo || __all(R < -151.f)) break;
        }
#undef LOAD_KV
        asm volatile("" ::: "memory");
        LAS float* os = (LAS float*)vt;
#pragma unroll
        for (int dh = 0; dh < 2; ++dh)
#pragma unroll
            for (int i = 0; i < 16; ++i) os[((i & 3) + 8 * (i >> 2) + 4 * hi) * 65 + 32 * dh + r32] = o[dh][i];
        asm volatile("" ::: "memory");
        const int q = lane >> 1, hf = lane & 1;
        float ov[32]; float ss = 0.f;
#pragma unroll
        for (int e = 0; e < 32; ++e) { ov[e] = os[q * 65 + 32 * hf + e]; ss += ov[e] * ov[e]; }
        ss += __shfl_xor(ss, 1);
        const float rstd = 1.0f / sqrtf(ss * (1.f / 64.f) + EPS);
        const size_t row = (size_t)b * SEQ + q0 + q;
        const int c0 = h * 64 + 32 * hf;
#pragma unroll
        for (int c = 0; c < 4; ++c) {
            const v4u zr = *(const v4u*)(F.PROJ + row * NPROJ + C_SBZ + c0 + 8 * c);
            const f32x4 w0 = *(const f32x4*)(F.sb_w + c0 + 8 * c), w1 = *(const f32x4*)(F.sb_w + c0 + 8 * c + 4);
            v4u w;
            w.x = pk2(ov[8 * c + 0] * rstd * w0.x * siluf_(bflo(zr.x)), ov[8 * c + 1] * rstd * w0.y * siluf_(bfhi(zr.x)));
            w.y = pk2(ov[8 * c + 2] * rstd * w0.z * siluf_(bflo(zr.y)), ov[8 * c + 3] * rstd * w0.w * siluf_(bfhi(zr.y)));
            w.z = pk2(ov[8 * c + 4] * rstd * w1.x * siluf_(bflo(zr.z)), ov[8 * c + 5] * rstd * w1.y * siluf_(bfhi(zr.z)));
            w.w = pk2(ov[8 * c + 6] * rstd * w1.z * siluf_(bflo(zr.w)), ov[8 * c + 7] * rstd * w1.w * siluf_(bfhi(zr.w)));
            *(v4u*)(F.Y + row * DM + c0 + 8 * c) = w;
        }
        asm volatile("" ::: "memory");
    }
}
constexpr int SL_N = 16384, SL_SC = 16512, SL_STRIDE = 16640;
__device__ __forceinline__ v4u scale8(v4u r, float s) {
    v4u o; o.x = cvtpk(bflo(r.x) * s, bfhi(r.x) * s); o.y = cvtpk(bflo(r.y) * s, bfhi(r.y) * s); o.z = cvtpk(bflo(r.z) * s, bfhi(r.z) * s); o.w = cvtpk(bflo(r.w) * s, bfhi(r.w) * s); return o;
}
template <int PASS> __device__ __forceinline__ void mlstm_fast(Ctx& F, float* SLOC) {
    constexpr int PT = 272, SP = 144, HP = 129;
    constexpr int L_Q = 0, L_K = 17408, L_V = 34816, L_VW = 52224, L_S = 69632, L_H = 78848, L_SC = 111872;
    LAS unsigned char* L = F.lds;
    LAS float* su = (LAS float*)(L + L_SC); LAS float* sM = su + 64; LAS float* sb = su + 128; LAS bf16* swb = (LAS bf16*)(su + 192);
    LAS float* Hs = (LAS float*)(L + L_H);
    int tid_ = F.tid; asm volatile("" : "+v"(tid_));
    const int tid = tid_, lane = tid & 63, w = __builtin_amdgcn_readfirstlane(tid >> 6), fr = lane & 15, fq = lane >> 4, tq = fr >> 2, tp = fr & 3;
    const int srow = tid >> 3, sc8 = tid & 7, v0 = 16 * w;
    const int nunits = PASS == 1 ? NB * 4 * 7 : NB * 4 * 8;
    for (int unit = blockIdx.x; unit < nunits; unit += gridDim.x) {
        int bh, seg; if (PASS == 1) { bh = unit / 7; seg = unit % 7; } else { bh = unit >> 3; seg = unit & 7; }
        const int b = bh >> 2, h = bh & 3;
        const size_t row0 = (size_t)b * SEQ + (size_t)seg * 512;
        f32x4 X[8], Xn[8];
#pragma unroll
        for (int t = 0; t < 8; ++t) { X[t] = (f32x4){0.f, 0.f, 0.f, 0.f}; Xn[t] = (f32x4){0.f, 0.f, 0.f, 0.f}; }
        float m_prev = PASS == 1 ? -1e30f : 0.f, bsum = 0.f;
        if (PASS == 2) {
            for (int j = 0; j < seg; ++j) {
                const float* S = SLOC + (size_t)(bh * 7 + j) * SL_STRIDE;
                const float mloc = S[SL_SC], Bs = S[SL_SC + 1];
                const float m_new = fmaxf(Bs + m_prev, mloc), fa = __expf(Bs + m_prev - m_new), fg = __expf(mloc - m_new);
#pragma unroll
                for (int t = 0; t < 8; ++t) { const f32x4 cl = *(const f32x4*)(S + (size_t)(t * 512 + tid) * 4); X[t] = X[t] * fa + cl * fg;
                    const f32x4 nl = *(const f32x4*)(S + SL_N + 16 * t + 4 * fq); Xn[t] = Xn[t] * fa + nl * fg; }
                m_prev = m_new;
            }
        }
        v4u pq0, pq1, pk0, pk1, pv0, pv1; float pig, plf;
#define MPREF(c_) do { const size_t rg_ = row0 + (size_t)(c_) * 64 + srow; \
            const bf16* qk_ = F.QKC + rg_ * 1024 + h * 128 + 8 * sc8; const bf16* vv_ = F.PROJ + rg_ * NPROJ + C_MLV + h * 128 + 8 * sc8; \
            if (PASS == 2) { pq0 = *(const v4u*)(qk_); pq1 = *(const v4u*)(qk_ + 64); } \
            pk0 = *(const v4u*)(qk_ + 512); pk1 = *(const v4u*)(qk_ + 512 + 64); pv0 = *(const v4u*)(vv_); pv1 = *(const v4u*)(vv_ + 64); \
            const float* gg_ = F.GATES + (row0 + (size_t)(c_) * 64 + lane) * 8; pig = gg_[h]; plf = gg_[4 + h]; } while (0)
        MPREF(0);
        for (int c = 0; c < 8; ++c) {
            const size_t rowc = row0 + (size_t)c * 64;
            __syncthreads();
            float bc = plf;
#pragma unroll
            for (int o = 1; o < 64; o <<= 1) { const float t_ = __shfl_up(bc, o); if (lane >= o) bc += t_; }
            const float u = pig - bc; float pm = u;
#pragma unroll
            for (int o = 1; o < 64; o <<= 1) { const float t_ = __shfl_up(pm, o); if (lane >= o) pm = fmaxf(pm, t_); }
            const float Mv = fmaxf(m_prev, pm), M63 = __shfl(Mv, 63), blast = __shfl(bc, 63);
            const float wgt = __expf(u - M63);
            if (w == 0) { su[lane] = u; sM[lane] = Mv; sb[lane] = bc; swb[lane] = (bf16)(cvtpk(wgt, 0.f) & 0xffffu); }
            const float wrow = __shfl(wgt, srow);
            *(LAS v4u*)(L + L_K + srow * PT + 16 * sc8) = pk0; *(LAS v4u*)(L + L_K + srow * PT + 16 * (sc8 + 8)) = pk1;
            *(LAS v4u*)(L + L_VW + srow * PT + 16 * sc8) = scale8(pv0, wrow); *(LAS v4u*)(L + L_VW + srow * PT + 16 * (sc8 + 8)) = scale8(pv1, wrow);
            if (PASS == 2) {
                *(LAS v4u*)(L + L_Q + srow * PT + 16 * sc8) = pq0; *(LAS v4u*)(L + L_Q + srow * PT + 16 * (sc8 + 8)) = pq1;
                *(LAS v4u*)(L + L_V + srow * PT + 16 * sc8) = pv0; *(LAS v4u*)(L + L_V + srow * PT + 16 * (sc8 + 8)) = pv1;
            }
            if (c + 1 < 8) MPREF(c + 1);
            __syncthreads();
            if (PASS == 2) {
                const int lt = w & 3, sp = w >> 2;
#pragma unroll
                for (int si = 0; si < 2; ++si) {
                    const int st = 2 * sp + si;
                    f32x4 acc = (f32x4){0.f, 0.f, 0.f, 0.f};
                    if (st <= lt) {
#pragma unroll
                        for (int ks = 0; ks < 4; ++ks) {
                            const bf16x8 ak = *(const LAS bf16x8*)(L + L_K + (16 * st + fr) * PT + (32 * ks + 8 * fq) * 2);
                            const bf16x8 bq = *(const LAS bf16x8*)(L + L_Q + (16 * lt + fr) * PT + (32 * ks + 8 * fq) * 2);
                            acc = __builtin_amdgcn_mfma_f32_16x16x32_bf16(ak, bq, acc, 0, 0, 0);
                        }
                        const f32x4 us = *(const LAS f32x4*)(su + 16 * st + 4 * fq); const float Ml = sM[16 * lt + fr];
                        const int l = 16 * lt + fr, s0 = 16 * st + 4 * fq;
#pragma unroll
                        for (int j = 0; j < 4; ++j) acc[j] = (s0 + j <= l) ? acc[j] * __expf(us[j] - Ml) : 0.f;
                    }
                    v2u pw; pw.x = cvtpk(acc[0], acc[1]); pw.y = cvtpk(acc[2], acc[3]);
                    *(LAS v2u*)(L + L_S + (16 * lt + fr) * SP + (16 * st + 4 * fq) * 2) = pw;
                }
                __syncthreads();
                f32x4 num[4], den[4];
#pragma unroll
                for (int i = 0; i < 4; ++i) { num[i] = (f32x4){0.f, 0.f, 0.f, 0.f}; den[i] = (f32x4){0.f, 0.f, 0.f, 0.f}; }
#pragma unroll
                for (int kk = 0; kk < 4; ++kk) {
                    v4u bsw, bnw;
                    bsw.x = cvtpk(X[2 * kk][0], X[2 * kk][1]); bsw.y = cvtpk(X[2 * kk][2], X[2 * kk][3]); bsw.z = cvtpk(X[2 * kk + 1][0], X[2 * kk + 1][1]); bsw.w = cvtpk(X[2 * kk + 1][2], X[2 * kk + 1][3]);
                    bnw.x = cvtpk(Xn[2 * kk][0], Xn[2 * kk][1]); bnw.y = cvtpk(Xn[2 * kk][2], Xn[2 * kk][3]); bnw.z = cvtpk(Xn[2 * kk + 1][0], Xn[2 * kk + 1][1]); bnw.w = cvtpk(Xn[2 * kk + 1][2], Xn[2 * kk + 1][3]);
                    const bf16x8 bs = __builtin_bit_cast(bf16x8, bsw), bn = __builtin_bit_cast(bf16x8, bnw);
#pragma unroll
                    for (int i = 0; i < 4; ++i) {
                        const LAS unsigned char* qa = L + L_Q + (16 * i + fr) * PT + (32 * kk + 4 * fq) * 2;
                        const v2u lo = *(const LAS v2u*)qa, hi = *(const LAS v2u*)(qa + 32);
                        const v4u aw = {lo.x, lo.y, hi.x, hi.y}; const bf16x8 aq = __builtin_bit_cast(bf16x8, aw);
                        num[i] = __builtin_amdgcn_mfma_f32_16x16x32_bf16(aq, bs, num[i], 0, 0, 0);
                        den[i] = __builtin_amdgcn_mfma_f32_16x16x32_bf16(aq, bn, den[i], 0, 0, 0);
                    }
                    __builtin_amdgcn_sched_barrier(0);
                }
#pragma unroll
                for (int i = 0; i < 4; ++i) { const f32x4 Ml = *(const LAS f32x4*)(sM + 16 * i + 4 * fq);
#pragma unroll
                    for (int j = 0; j < 4; ++j) { const float cs = __expf(m_prev - Ml[j]); num[i][j] *= cs; den[i][j] *= cs; } }
                const v4u onesw = {0x3f803f80u, 0x3f803f80u, 0x3f803f80u, 0x3f803f80u}; const bf16x8 ones = __builtin_bit_cast(bf16x8, onesw);
#pragma unroll
                for (int ks = 0; ks < 2; ++ks) {
                    const LAS unsigned char* vb = L + L_V + (32 * ks + 8 * fq + tq) * PT + (v0 + 4 * tp) * 2;
                    const s16x4 lo = vtr(vb), hi4 = vtr(vb + 4 * PT);
                    const bf16x8 bv = {lo[0], lo[1], lo[2], lo[3], hi4[0], hi4[1], hi4[2], hi4[3]};
#pragma unroll
                    for (int i = 0; i < 4; ++i) {
                        if (32 * ks > 16 * i + 15) continue;
                        const bf16x8 as = *(const LAS bf16x8*)(L + L_S + (16 * i + fr) * SP + (32 * ks + 8 * fq) * 2);
                        num[i] = __builtin_amdgcn_mfma_f32_16x16x32_bf16(as, bv, num[i], 0, 0, 0);
                        den[i] = __builtin_amdgcn_mfma_f32_16x16x32_bf16(as, ones, den[i], 0, 0, 0);
                    }
                }
#pragma unroll
                for (int i = 0; i < 4; ++i) { const f32x4 Ml = *(const LAS f32x4*)(sM + 16 * i + 4 * fq), bl = *(const LAS f32x4*)(sb + 16 * i + 4 * fq);
#pragma unroll
                    for (int j = 0; j < 4; ++j) Hs[(16 * i + 4 * fq + j) * HP + v0 + fr] = num[i][j] / fmaxf(fabsf(den[i][j]), __expf(-(bl[j] + Ml[j]))); }
            }
            {
                const float a = __expf(m_prev - M63);
#pragma unroll
                for (int t = 0; t < 8; ++t) { X[t] *= a; Xn[t] *= a; }
#pragma unroll
                for (int ks = 0; ks < 2; ++ks) {
                    const LAS unsigned char* vb = L + L_VW + (32 * ks + 8 * fq + tq) * PT + (v0 + 4 * tp) * 2;
                    const s16x4 lo = vtr(vb), hi4 = vtr(vb + 4 * PT);
                    const bf16x8 bv = {lo[0], lo[1], lo[2], lo[3], hi4[0], hi4[1], hi4[2], hi4[3]};
                    const bf16x8 bw = *(const LAS bf16x8*)(swb + 32 * ks + 8 * fq);
#pragma unroll
                    for (int t = 0; t < 8; ++t) {
                        const LAS unsigned char* kb = L + L_K + (32 * ks + 8 * fq + tq) * PT + (16 * t + 4 * tp) * 2;
                        const s16x4 klo = vtr(kb), khi = vtr(kb + 4 * PT);
                        const bf16x8 ak = {klo[0], klo[1], klo[2], klo[3], khi[0], khi[1], khi[2], khi[3]};
                        X[t] = __builtin_amdgcn_mfma_f32_16x16x32_bf16(ak, bv, X[t], 0, 0, 0);
                        Xn[t] = __builtin_amdgcn_mfma_f32_16x16x32_bf16(ak, bw, Xn[t], 0, 0, 0);
                        if (t & 1) __builtin_amdgcn_sched_barrier(0);
                    }
                }
                m_prev = blast + M63; bsum += blast;
            }
            if (PASS == 2) {
                v4u po0, po1, pz0, pz1;
                { const bf16* oz = F.PROJ + (rowc + srow) * NPROJ + h * 128 + 16 * sc8;
                  po0 = *(const v4u*)(oz + C_MLO); po1 = *(const v4u*)(oz + C_MLO + 8); pz0 = *(const v4u*)(oz + C_MLZ); pz1 = *(const v4u*)(oz + C_MLZ + 8); }
                __syncthreads();
                const unsigned ow[8] = {po0.x, po0.y, po0.z, po0.w, po1.x, po1.y, po1.z, po1.w}, zw[8] = {pz0.x, pz0.y, pz0.z, pz0.w, pz1.x, pz1.y, pz1.z, pz1.w};
                float yv[16]; float ss = 0.f;
#pragma unroll
                for (int e = 0; e < 8; ++e) { const float h0 = Hs[srow * HP + 16 * sc8 + 2 * e], h1 = Hs[srow * HP + 16 * sc8 + 2 * e + 1];
                    yv[2 * e] = sigmoidf_(bflo(ow[e])) * h0; yv[2 * e + 1] = sigmoidf_(bfhi(ow[e])) * h1; ss += yv[2 * e] * yv[2 * e] + yv[2 * e + 1] * yv[2 * e + 1]; }
                ss += __shfl_xor(ss, 1); ss += __shfl_xor(ss, 2); ss += __shfl_xor(ss, 4);
                const float rstd = 1.0f / sqrtf(ss * (1.f / 128.f) + EPS);
                const float* nw = F.ml_w + h * 128 + 16 * sc8;
                unsigned outw[8];
#pragma unroll
                for (int e = 0; e < 8; ++e) outw[e] = pk2(yv[2 * e] * rstd * nw[2 * e] * siluf_(bflo(zw[e])), yv[2 * e + 1] * rstd * nw[2 * e + 1] * siluf_(bfhi(zw[e])));
                bf16* yp = F.Y + (rowc + srow) * DM + 512 + h * 128 + 16 * sc8;
                *(v4u*)yp = (v4u){outw[0], outw[1], outw[2], outw[3]}; *(v4u*)(yp + 8) = (v4u){outw[4], outw[5], outw[6], outw[7]};
            }
        }
#undef MPREF
        if (PASS == 1) {
            float* S = SLOC + (size_t)(bh * 7 + seg) * SL_STRIDE;
#pragma unroll
            for (int t = 0; t < 8; ++t) { *(f32x4*)(S + (size_t)(t * 512 + tid) * 4) = X[t]; if (w == 0 && fr == 0) *(f32x4*)(S + SL_N + 16 * t + 4 * fq) = Xn[t]; }
            if (tid == 0) { S[SL_SC] = m_prev; S[SL_SC + 1] = bsum; }
        }
        __syncthreads();
    }
}
#define MIXERS(F) do { attn_fast(F, nullptr); mlstm_fast<1>(F, (float*)(args.ws + WS_PB)); GRID_SEAM(); mlstm_fast<2>(F, (float*)(args.ws + WS_PB)); } while (0)
#define GRID_SEAM() xcd_barrier(xbar)
#define GRID_SEAM_() xcd_barrier(xbar)
#ifndef REP_SYNC
#define REP_SYNC 0
#endif
#ifndef REP_P0
#define REP_P0 1
#endif
#ifndef REP_P1
#define REP_P1 1
#endif
#ifndef REP_P3
#define REP_P3 1
#endif
__global__ void __launch_bounds__(512, 2) fwd_kernel(Args args) {
    extern __shared__ __attribute__((aligned(16))) unsigned char lds_raw[];
    cg::grid_group grid = cg::this_grid();
    Ctx F;
    F.lds = (LAS unsigned char*)lds_raw;
    F.tid = threadIdx.x; F.lane = F.tid & 63; F.wave = __builtin_amdgcn_readfirstlane(F.tid >> 6);
    F.gw = blockIdx.x * 8 + F.wave; F.NGW = gridDim.x * 8;
    F.x = args.in[0]; F.p = args.in[1]; F.pre_w = args.in[2]; F.w_in = args.in[3]; F.conv_w = args.in[4]; F.conv_b = args.in[5]; F.i_bias = args.in[6]; F.f_bias = args.in[7];
    F.sb_w = args.in[8]; F.ml_w = args.in[9]; F.w_out = args.in[10]; F.post_w = args.in[11]; F.w_up = args.in[12]; F.w_gate = args.in[13]; F.b_gate = args.in[14];
    F.out = args.out; unsigned char* ws = args.ws;
    F.WT_IN = (bf16*)(ws + WS_WIN); F.WT_OUT = (bf16*)(ws + WS_WOUT); F.WT_GATE = (bf16*)(ws + WS_WGATE); F.WT_UP = (bf16*)(ws + WS_WUP); F.GATES = (float*)(ws + WS_GATES);
    F.U = (bf16*)(ws + WS_U); F.Y = F.U; F.HB = F.U; F.PROJ = (bf16*)(ws + WS_PROJ); F.Y2 = F.PROJ; F.PU = (bf16*)(ws + WS_PU); F.PB = (bf16*)(ws + WS_PB); F.QKC = (bf16*)(ws + WS_QKC);

    volatile LAS unsigned* bar_st = (volatile LAS unsigned*)(F.lds + 131072 + 512);
    if (F.tid < 2) bar_st[F.tid] = 0u;
    __syncthreads();
    unsigned* bar_words = (unsigned*)args.ws;
    if (args.ws == nullptr) grid.sync();
    const XcdBarrier xbar = xcd_barrier_post(bar_words, bar_st);
    for (int rep_ = 0; rep_ < REP_P0; ++rep_) phase0(F);
    GRID_SEAM_();

    for (int rep_ = 0; rep_ < REP_SYNC; ++rep_) GRID_SEAM();
    for (int rep_ = 0; rep_ < REP_P1; ++rep_) {
        pg8::Gemm g{F.U, F.WT_IN, MTOK, NPROJ, DM}; pg8::StaticOrder S; S.init(MTOK, NPROJ, gridDim.x, blockIdx.x);
        pg8::EpiBf16<0> E{F.PROJ, NPROJ, nullptr, 512, 512, 0.125f * 1.4426950408889634f};
        pg8::gemm_phase<pg8::EpiBf16<0>, pg8::StaticOrder, true, true>(F.lds, g, S, E);
        pg8::Gemm g2{F.PB, F.WT_UP, MTOK, DM, PLE}; pg8::StaticOrder S2; S2.init(MTOK, DM, gridDim.x, blockIdx.x);
        pg8::EpiBf16<0> E2{F.PU, DM, nullptr, 0, 0, 1.f};
        pg8::gemm_phase<pg8::EpiBf16<0>, pg8::StaticOrder, true, true>(F.lds, g2, S2, E2);
    }
    GRID_SEAM();
    for (int rep_ = 0; rep_ < REP_P0; ++rep_) phase_conv(F);
    GRID_SEAM();
    MIXERS(F);
    GRID_SEAM();
    for (int rep_ = 0; rep_ < REP_P3; ++rep_) {
        pg8::Gemm g{F.Y, F.WT_OUT, MTOK, DM, DM}; pg8::StaticOrder S; S.init(MTOK, DM, gridDim.x, blockIdx.x);
        pg8::EpiBf16<0> E{F.Y2, DM, nullptr, 0, 0, 1.f};
        pg8::gemm_phase<pg8::EpiBf16<0>, pg8::StaticOrder, true, true>(F.lds, g, S, E);
    }
    GRID_SEAM();
    for (int rep_ = 0; rep_ < REP_P0; ++rep_) phase_norm(F);
    GRID_SEAM();
    {
        pg8::Gemm g{F.HB, F.WT_GATE, MTOK, DM, DM}; pg8::StaticOrder S; S.init(MTOK, DM, gridDim.x, blockIdx.x);
        EpiGate E{F.out, F.PU, F.b_gate};
        pg8::gemm_phase<EpiGate, pg8::StaticOrder, true, true>(F.lds, g, S, E);
    }
}

extern "C" void kernel_launch(void* const* d_in, const int* in_sizes, int n_in, void* d_out, int out_size, void* d_ws, size_t ws_size, hipStream_t stream) {
    static int grid = 0;
    if (grid == 0) {
        if (n_in != 15 || out_size != MTOK * DM || ws_size < WS_END) { fprintf(stderr, "kernel_launch: unexpected shapes (n_in %d out %d ws %zu)\n", n_in, out_size, ws_size); grid = -1; return; }
        int dev = 0, cus = 0, per_cu = 0;
        (void)hipGetDevice(&dev); (void)hipDeviceGetAttribute(&cus, hipDeviceAttributeMultiprocessorCount, dev);
        if (hipFuncSetAttribute((const void*)fwd_kernel, hipFuncAttributeMaxDynamicSharedMemorySize, LDS_BYTES) != hipSuccess) { fprintf(stderr, "kernel_launch: hipFuncSetAttribute failed\n"); grid = -1; return; }
        if (hipOccupancyMaxActiveBlocksPerMultiprocessor(&per_cu, (const void*)fwd_kernel, 512, LDS_BYTES) != hipSuccess || per_cu < 1) { fprintf(stderr, "kernel_launch: occupancy query says %d\n", per_cu); per_cu = 1; }
        (void)hipGetLastError();
        grid = cus * 1;
        if (grid <= 0) grid = 256;
    }
    if (grid < 0) return;
    Args a{};
    for (int i = 0; i < 15; ++i) a.in[i] = (const float*)d_in[i];
    a.out = (float*)d_out; a.ws = (unsigned char*)d_ws;
    if (hipMemsetAsync(d_ws, 0, 32768, stream) != hipSuccess) { fprintf(stderr, "kernel_launch: memset of the control words failed\n"); return; }
    void* kargs[] = {&a};
    hipError_t e = hipLaunchCooperativeKernel((const void*)fwd_kernel, dim3(grid), dim3(512), kargs, LDS_BYTES, stream);
    if (e != hipSuccess) fprintf(stderr, "kernel_launch: cooperative launch failed: %s (grid %d)\n", hipGetErrorString(e), grid);
}
```

```cpp
#include <hip/hip_runtime.h>
#include <hip/hip_cooperative_groups.h>
#include <cstdio>
#include <cstdint>
namespace cg = cooperative_groups;

namespace pg8 {
#define PG8_LAS __attribute__((address_space(3)))
typedef unsigned short bf16_t;
typedef short bf16x8 __attribute__((ext_vector_type(8)));
typedef float f32x4 __attribute__((ext_vector_type(4)));
typedef unsigned u32x4 __attribute__((ext_vector_type(4)));
constexpr int BM = 256, BK = 64, HALF = 128, HTB = HALF * BK * 2  , STAGE_BYTES = 8 * HTB, NXCD = 8, WGM = 8;

__host__ __device__ __forceinline__ int lds_byte(int r, int c) { const int st = (r >> 4) * 2 + (c >> 5), rr = r & 15, cc = c & 31, ob = rr * 64 + cc * 2; return st * 1024 + (ob ^ (((ob >> 9) & 1) << 5)); }
__host__ __device__ __forceinline__ void stage_rc(int b, int& R, int& C) { const int st = b / 1024, sb = b % 1024, swz = sb ^ (((sb >> 9) & 1) << 5); R = (st >> 1) * 16 + swz / 64; C = (st & 1) * 32 + (swz % 64) / 2; }
__host__ __device__ __forceinline__ int perm32(int rho) { const int n = rho >> 4, i = rho & 15; return 8 * (i >> 2) + 4 * n + (i & 3); }

struct Unit { int pm, pn; };
struct Gemm { const bf16_t* A; const bf16_t* Bt; int M, N, K; };

struct StaticOrder {
    int nM, nN, nwg, G, c;
    __host__ __device__ void init(int M, int N, int G_, int c_) { nM = M / BM; nN = N / BM; nwg = nM * nN; G = G_; c = c_; }
    __host__ __device__ bool next(int i, Unit& u) const {
        const long L = (long)i * G + c; if (L >= nwg) return false;
        int wgid = (int)L; { const int q = nwg / NXCD, r = nwg % NXCD, xcd = wgid % NXCD, off = wgid / NXCD; wgid = (xcd < r ? xcd * (q + 1) : r * (q + 1) + (xcd - r) * q) + off; }
        const int nig = WGM * nN, gid = wgid / nig, fm = gid * WGM, gsz = (nM - fm) < WGM ? (nM - fm) : WGM;
        u.pm = fm + ((wgid % nig) % gsz); u.pn = (wgid % nig) / gsz; return true;
    }
    __device__ __forceinline__ void a_ready(const Unit&) const {}
    __device__ __forceinline__ void done(const Unit&) const {}
};

__device__ __forceinline__ unsigned cvt_pk_bf16(float lo, float hi) { unsigned r; asm volatile("v_cvt_pk_bf16_f32 %0, %1, %2" : "=v"(r) : "v"(lo), "v"(hi)); return r; }
typedef float f32x2 __attribute__((ext_vector_type(2)));
__device__ __forceinline__ f32x2 gelu_pk(f32x2 v) {
    const f32x2 av = __builtin_elementwise_abs(v), d = av * 0.2316418882f + 1.0f;
    f32x2 t; t.x = __builtin_amdgcn_rcpf(d.x); t.y = __builtin_amdgcn_rcpf(d.y);
    f32x2 q = t * 0.5307027145f + (-0.7265760135f); q = q * t + 0.7107068705f; q = q * t + (-0.142248368f); q = q * t + 0.127414796f; q = q * t;
    const f32x2 s = (v * v) * (-0.72134752044f);
    f32x2 e; e.x = __builtin_amdgcn_exp2f(s.x); e.y = __builtin_amdgcn_exp2f(s.y);
    const f32x2 m = v * (q * e), r = v - m;
    f32x2 o; o.x = v.x < 0.f ? m.x : r.x; o.y = v.y < 0.f ? m.y : r.y; return o;
}

template <int ACT  > struct EpiBf16 {
    static constexpr bool PERM = true, AFTER_DRAIN = false; static_assert(ACT == 0 || ACT == 1, "EpiBf16: ACT is 0 (none) or 1 (gelu_pk)");
    bf16_t* O; int ldc; const float* bias; int split_cols; size_t split_stride; float scale0;
    __device__ __forceinline__ void operator()(const f32x4 (&acc)[2][2][4][2], const Unit& u, int wr, int wc, int fr, int fq) const {
        const int row0 = u.pm * BM + wr * 64 + fr; int colt = u.pn * BM; bf16_t* base = O;
        float sc = 1.f; if (split_cols) { const int t = colt / split_cols; base += (size_t)t * split_stride; colt -= t * split_cols; if (t == 0) sc = scale0; }
        const int col0 = colt + wc * 32 + 8 * fq, bcol0 = u.pn * BM + wc * 32 + 8 * fq;
        f32x4 bv[2][2];
#pragma unroll
        for (int bj = 0; bj < 2; ++bj)
#pragma unroll
            for (int n = 0; n < 2; ++n) bv[bj][n] = bias ? *(const f32x4*)(bias + bcol0 + bj * HALF + 4 * n) : (f32x4){0.f, 0.f, 0.f, 0.f};
#pragma unroll
        for (int ai = 0; ai < 2; ++ai)
#pragma unroll
            for (int m = 0; m < 4; ++m) { bf16_t* rowp = base + (size_t)(row0 + ai * HALF + m * 16) * ldc + col0;
#pragma unroll
                for (int bj = 0; bj < 2; ++bj) { f32x4 v0 = acc[ai][bj][m][0] + bv[bj][0], v1 = acc[ai][bj][m][1] + bv[bj][1];
                    if (ACT == 1) { f32x2 a = gelu_pk((f32x2){v0[0], v0[1]}), b = gelu_pk((f32x2){v0[2], v0[3]}), c = gelu_pk((f32x2){v1[0], v1[1]}), d = gelu_pk((f32x2){v1[2], v1[3]});
                        v0 = (f32x4){a.x, a.y, b.x, b.y}; v1 = (f32x4){c.x, c.y, d.x, d.y}; }
                    v0 = v0 * sc; v1 = v1 * sc; u32x4 w; w.x = cvt_pk_bf16(v0[0], v0[1]); w.y = cvt_pk_bf16(v0[2], v0[3]); w.z = cvt_pk_bf16(v1[0], v1[1]); w.w = cvt_pk_bf16(v1[2], v1[3]);
                    *(u32x4*)(rowp + bj * HALF) = w; } }
    }
};

template <class Epi, class Sched, bool ALIGN_EPI = false, bool SP2 = false>
__device__ __forceinline__ void gemm_phase(PG8_LAS unsigned char* lds, const Gemm g, const Sched& S, const Epi& E) {
    int tid_ = threadIdx.x; asm volatile("" : "+v"(tid_));
    const int tid = tid_, wid = __builtin_amdgcn_readfirstlane(tid >> 6), lane = tid & 63, wr = wid >> 2, wc = wid & 3, fr = lane & 15, fq = lane >> 4;
    const int K = g.K, nt = K / BK;
    unsigned voffA[2], voffB[2];
#pragma unroll
    for (int i = 0; i < 2; ++i) { int R, C; stage_rc(tid * 16 + i * 8192, R, C); const int Rb = Epi::PERM ? ((R & ~31) + perm32(R & 31)) : R;
        voffA[i] = (unsigned)(R * K + C) * 2u; voffB[i] = (unsigned)(Rb * K + C) * 2u; }
    const size_t kstep = (size_t)(BK * 2);
    const size_t hstep = (size_t)HALF * K * 2;
    const size_t tstep = 2 * hstep;
    const unsigned ldsw = (unsigned)wid * 1024u;
    const int aoff = lds_byte(wr * 64 + fr, fq * 8), boff = lds_byte(wc * 32 + fr, fq * 8);
#define PG8_SA(b, h) (((b) * 2 + (h)) * HTB)
#define PG8_SB(b, h) ((4 + (b) * 2 + (h)) * HTB)
#define PG8_STAGE(bufoff, gbase, voff) do { _Pragma("unroll") for (int _i = 0; _i < 2; ++_i) \
        __builtin_amdgcn_global_load_lds((const unsigned*)((const char*)(gbase) + (voff)[_i]), (PG8_LAS unsigned*)(lds + (bufoff) + ldsw + _i * 8192), 16, 0, 0); } while (0)
#define PG8_LDA(dst, b, h) do { _Pragma("unroll") for (int m = 0; m < 4; ++m) _Pragma("unroll") for (int k = 0; k < 2; ++k) dst[m][k] = *(const PG8_LAS bf16x8*)(lds + PG8_SA(b, h) + aoff + m * 2048 + k * 1024); } while (0)
#define PG8_LDB(dst, b, h) do { _Pragma("unroll") for (int n = 0; n < 2; ++n) _Pragma("unroll") for (int k = 0; k < 2; ++k) dst[n][k] = *(const PG8_LAS bf16x8*)(lds + PG8_SB(b, h) + boff + n * 2048 + k * 1024); } while (0)
#define PG8_MMA(ai, bj, At, Bt) do { __builtin_amdgcn_s_setprio(1); _Pragma("unroll") for (int m = 0; m < 4; ++m) _Pragma("unroll") for (int n = 0; n < 2; ++n) _Pragma("unroll") for (int k = 0; k < 2; ++k) \
        acc[ai][bj][m][n] = __builtin_amdgcn_mfma_f32_16x16x32_bf16(Bt[n][k], At[m][k], acc[ai][bj][m][n], 0, 0, 0); __builtin_amdgcn_s_setprio(0); } while (0)
#define PG8_WAIT_V(n) asm volatile("s_waitcnt vmcnt(" #n ")" ::: "memory")
#define PG8_WAIT_L(n) asm volatile("s_waitcnt lgkmcnt(" #n ")" ::: "memory")
#define PG8_BAR __builtin_amdgcn_s_barrier()
#define PG8_SCHED __builtin_amdgcn_sched_barrier(0)
    Unit cur, nxt; int ui = 0;
    if (!S.next(0, cur)) return;
    f32x4 acc[2][2][4][2];
#pragma unroll
    for (int a = 0; a < 2; ++a)
#pragma unroll
        for (int b = 0; b < 2; ++b)
#pragma unroll
            for (int m = 0; m < 4; ++m)
#pragma unroll
                for (int n = 0; n < 2; ++n) acc[a][b][m][n] = (f32x4){0.f, 0.f, 0.f, 0.f};
    bf16x8 At[4][2], B0[2][2], B1[2][2];
    const char* cA = (const char*)g.A + (size_t)cur.pm * tstep; const char* cB = (const char*)g.Bt + (size_t)cur.pn * tstep;
    S.a_ready(cur);
    if constexpr (SP2) {
        PG8_STAGE(PG8_SB(0, 0), cB, voffB); PG8_STAGE(PG8_SB(0, 1), cB + hstep, voffB); PG8_STAGE(PG8_SA(0, 0), cA, voffA); PG8_STAGE(PG8_SA(0, 1), cA + hstep, voffA);
        if (wr == 1) PG8_BAR;
        PG8_WAIT_V(2); PG8_BAR;
        PG8_STAGE(PG8_SB(1, 0), cB + kstep, voffB); PG8_STAGE(PG8_SA(1, 0), cA + kstep, voffA); PG8_STAGE(PG8_SB(1, 1), cB + hstep + kstep, voffB);
        PG8_WAIT_V(6); PG8_BAR;
    } else {
        PG8_STAGE(PG8_SB(0, 0), cB, voffB); PG8_STAGE(PG8_SA(0, 0), cA, voffA); PG8_STAGE(PG8_SB(0, 1), cB + hstep, voffB); PG8_STAGE(PG8_SA(0, 1), cA + hstep, voffA);
        if (wr == 1) PG8_BAR;
        PG8_WAIT_V(4); PG8_BAR;
        PG8_STAGE(PG8_SB(1, 0), cB + kstep, voffB); PG8_STAGE(PG8_SA(1, 0), cA + kstep, voffA); PG8_STAGE(PG8_SB(1, 1), cB + hstep + kstep, voffB);
        PG8_WAIT_V(6); PG8_BAR;
    }
    for (;;) {
        const bool has_next = S.next(ui + 1, nxt);
        const char* nA = has_next ? (const char*)g.A + (size_t)nxt.pm * tstep : cA; const char* nB = has_next ? (const char*)g.Bt + (size_t)nxt.pn * tstep : cB;
        for (int t = 0; t < nt; t += 2) {
            const bool last = (t == nt - 2);
            const char* a1 = cA + (size_t)(t + 1) * kstep;
            const char* a2 = last ? nA : cA + (size_t)(t + 2) * kstep; const char* b2 = last ? nB : cB + (size_t)(t + 2) * kstep;
            const char* a3 = a2 + kstep; const char* b3 = b2 + kstep;
            if (last && has_next) S.a_ready(nxt);
            if constexpr (SP2) {
            PG8_LDB(B0, 0, 0); PG8_LDB(B1, 0, 1); PG8_SCHED; PG8_LDA(At, 0, 0); PG8_STAGE(PG8_SA(1, 1), a1 + hstep, voffA);
            PG8_WAIT_V(8); PG8_WAIT_L(0); PG8_BAR; PG8_MMA(0, 0, At, B0); PG8_MMA(0, 1, At, B1); PG8_BAR; PG8_SCHED;
            PG8_LDA(At, 0, 1); PG8_STAGE(PG8_SB(0, 0), b2, voffB); PG8_STAGE(PG8_SB(0, 1), b2 + hstep, voffB); PG8_STAGE(PG8_SA(0, 0), a2, voffA);
            PG8_WAIT_V(8); PG8_WAIT_L(0); PG8_BAR; PG8_MMA(1, 0, At, B0); PG8_MMA(1, 1, At, B1); PG8_BAR; PG8_SCHED;
            PG8_LDB(B0, 1, 0); PG8_LDB(B1, 1, 1); PG8_SCHED; PG8_LDA(At, 1, 0); PG8_STAGE(PG8_SA(0, 1), a2 + hstep, voffA);
            PG8_WAIT_V(8); PG8_WAIT_L(0); PG8_BAR; PG8_MMA(0, 0, At, B0); PG8_MMA(0, 1, At, B1); PG8_BAR; PG8_SCHED;
            PG8_LDA(At, 1, 1); PG8_STAGE(PG8_SB(1, 0), b3, voffB); PG8_STAGE(PG8_SB(1, 1), b3 + hstep, voffB); PG8_STAGE(PG8_SA(1, 0), a3, voffA);
            PG8_WAIT_V(8); PG8_WAIT_L(0); PG8_BAR; PG8_MMA(1, 0, At, B0); PG8_MMA(1, 1, At, B1); PG8_BAR; PG8_SCHED;
            } else {
            PG8_LDB(B0, 0, 0); PG8_SCHED; PG8_LDA(At, 0, 0); PG8_STAGE(PG8_SA(1, 1), a1 + hstep, voffA);
            PG8_WAIT_L(8); PG8_BAR; PG8_WAIT_L(0); PG8_MMA(0, 0, At, B0); PG8_BAR; PG8_SCHED;
            PG8_LDB(B1, 0, 1); PG8_STAGE(PG8_SB(0, 0), b2, voffB);
            PG8_BAR; PG8_WAIT_L(0); PG8_MMA(0, 1, At, B1); PG8_BAR;
            PG8_LDA(At, 0, 1); PG8_STAGE(PG8_SA(0, 0), a2, voffA);
            PG8_BAR; PG8_WAIT_L(0); PG8_MMA(1, 0, At, B0); PG8_BAR; PG8_SCHED;
            PG8_STAGE(PG8_SB(0, 1), b2 + hstep, voffB);
            PG8_WAIT_V(6); PG8_BAR; PG8_MMA(1, 1, At, B1); PG8_BAR;
            PG8_LDB(B0, 1, 0); PG8_SCHED; PG8_LDA(At, 1, 0); PG8_STAGE(PG8_SA(0, 1), a2 + hstep, voffA);
            PG8_WAIT_L(8); PG8_BAR; PG8_WAIT_L(0); PG8_MMA(0, 0, At, B0); PG8_BAR; PG8_SCHED;
            PG8_LDB(B1, 1, 1); PG8_STAGE(PG8_SB(1, 0), b3, voffB);
            PG8_BAR; PG8_WAIT_L(0); PG8_MMA(0, 1, At, B1); PG8_BAR;
            PG8_LDA(At, 1, 1); PG8_STAGE(PG8_SA(1, 0), a3, voffA);
            PG8_BAR; PG8_WAIT_L(0); PG8_MMA(1, 0, At, B0); PG8_BAR; PG8_SCHED;
            PG8_STAGE(PG8_SB(1, 1), b3 + hstep, voffB);
            PG8_WAIT_V(6); PG8_BAR; PG8_MMA(1, 1, At, B1); PG8_BAR;
            }
        }
        if constexpr (ALIGN_EPI) { if (wr == 0) PG8_BAR; }
        if constexpr (!Epi::AFTER_DRAIN) { E(acc, cur, wr, wc, fr, fq); S.done(cur); }
        if (!has_next) break;
#pragma unroll
        for (int a = 0; a < 2; ++a)
#pragma unroll
            for (int b = 0; b < 2; ++b)
#pragma unroll
                for (int m = 0; m < 4; ++m)
#pragma unroll
                    for (int n = 0; n < 2; ++n) acc[a][b][m][n] = (f32x4){0.f, 0.f, 0.f, 0.f};
        cur = nxt; cA = nA; cB = nB; ++ui;
        if constexpr (ALIGN_EPI) { if (wr == 1) PG8_BAR; }
    }
    PG8_WAIT_V(0);
    if constexpr (!ALIGN_EPI) { if (wr == 0) PG8_BAR; }
    PG8_BAR;
    if constexpr (Epi::AFTER_DRAIN) { E.fused(acc, cur, wr, wc, fr, fq, lds, wid, lane); S.done(cur); }
#undef PG8_SA
#undef PG8_SB
#undef PG8_STAGE
#undef PG8_LDA
#undef PG8_LDB
#undef PG8_MMA
#undef PG8_WAIT_V
#undef PG8_WAIT_L
#undef PG8_BAR
#undef PG8_SCHED
}
}
#define LAS __attribute__((address_space(3)))
typedef unsigned short bf16;
typedef unsigned v4u __attribute__((ext_vector_type(4)));
typedef unsigned v2u __attribute__((ext_vector_type(2)));
typedef float f32x4 __attribute__((ext_vector_type(4)));
typedef short bf16x8 __attribute__((ext_vector_type(8)));
typedef short s16x4 __attribute__((ext_vector_type(4)));
typedef float f32x16 __attribute__((ext_vector_type(16)));
constexpr int DM = 1024, NB = 8, SEQ = 4096, MTOK = NB * SEQ, NIN = 4616, NPROJ = 4608, PLE = 256;
constexpr int C_SBQ = 0, C_SBK = 512, C_SBV = 1024, C_SBZ = 1536, C_MLQ = 2048, C_MLK = 2560, C_MLV = 3072, C_MLO = 3584, C_MLZ = 4096;
constexpr float EPS = 1e-6f;
constexpr size_t MiB = 1u << 20;
constexpr size_t WS_WIN = 1 * MiB, WS_WOUT = 10 * MiB, WS_WGATE = 12 * MiB, WS_WUP = 14 * MiB, WS_GATES = 15 * MiB;
constexpr size_t WS_U = 16 * MiB;
constexpr size_t WS_PROJ = 80 * MiB;
constexpr size_t WS_PU = 368 * MiB, WS_PB = 432 * MiB, WS_QKC = 448 * MiB, WS_END = 512 * MiB;
constexpr int LDS_BYTES = 147456;

__device__ __forceinline__ unsigned f2bf(float f) { unsigned u = __builtin_bit_cast(unsigned, f); return (u + 0x7fffu + ((u >> 16) & 1u)) >> 16; }
__device__ __forceinline__ unsigned pk2(float lo, float hi) { return f2bf(lo) | (f2bf(hi) << 16); }
__device__ __forceinline__ float bflo(unsigned w) { return __builtin_bit_cast(float, w << 16); }
__device__ __forceinline__ float bfhi(unsigned w) { return __builtin_bit_cast(float, w & 0xffff0000u); }
__device__ __forceinline__ float bf1(bf16 v) { return __builtin_bit_cast(float, ((unsigned)v) << 16); }
__device__ __forceinline__ float wave_sum(float v) {
#pragma unroll
    for (int o = 1; o < 64; o <<= 1) v += __shfl_xor(v, o);
    return v;
}
__device__ __forceinline__ float sigmoidf_(float x) { return 1.f / (1.f + __expf(-x)); }
__device__ __forceinline__ float siluf_(float x) { return x / (1.f + __expf(-x)); }
#define LDS_WAIT() asm volatile("s_waitcnt lgkmcnt(0)" ::: "memory")

__device__ __forceinline__ void p0_transpose_item(const float* W, int K, int pitch, int nblk, bf16* WT, LAS float* scr, int item, int lane) {
    const int kb = item / nblk, nb = item % nblk, k0 = 64 * kb, n0 = 32 * nb;
#pragma unroll 8
    for (int i = 0; i < 32; ++i) { const int kk = 2 * i + (lane >> 5); scr[kk * 33 + (lane & 31)] = W[(size_t)(k0 + kk) * pitch + n0 + (lane & 31)]; }
    LDS_WAIT(); asm volatile("" ::: "memory");
    const int c = lane & 7;
#pragma unroll
    for (int j = 0; j < 4; ++j) { const int n = (lane >> 3) + 8 * j; const LAS float* s = scr + (8 * c) * 33 + n;
        v4u o; o.x = pk2(s[0 * 33], s[1 * 33]); o.y = pk2(s[2 * 33], s[3 * 33]); o.z = pk2(s[4 * 33], s[5 * 33]); o.w = pk2(s[6 * 33], s[7 * 33]);
        *(v4u*)(WT + (size_t)(n0 + n) * K + k0 + 8 * c) = o; }
    LDS_WAIT(); asm volatile("" ::: "memory");
}

struct EpiGate {
    static constexpr bool PERM = true, AFTER_DRAIN = false;
    float* out; const bf16* pu; const float* bias;
    __device__ __forceinline__ void operator()(const pg8::f32x4 (&acc)[2][2][4][2], const pg8::Unit& u, int wr, int wc, int fr, int fq) const {
        const int row0 = u.pm * 256 + wr * 64 + fr, col0 = u.pn * 256 + wc * 32 + 8 * fq;
        f32x4 bv[2][2];
#pragma unroll
        for (int bj = 0; bj < 2; ++bj) { bv[bj][0] = *(const f32x4*)(bias + col0 + bj * 128); bv[bj][1] = *(const f32x4*)(bias + col0 + bj * 128 + 4); }
#pragma unroll
        for (int ai = 0; ai < 2; ++ai)
#pragma unroll
            for (int mp = 0; mp < 2; ++mp) {
                f32x4 hh[2][2][2]; v4u pw[2][2];
#pragma unroll
                for (int mm = 0; mm < 2; ++mm) { const size_t ro = (size_t)(row0 + ai * 128 + (2 * mp + mm) * 16) * DM;
#pragma unroll
                    for (int bj = 0; bj < 2; ++bj) { const int c = col0 + bj * 128;
                        hh[mm][bj][0] = *(const f32x4*)(out + ro + c); hh[mm][bj][1] = *(const f32x4*)(out + ro + c + 4); pw[mm][bj] = *(const v4u*)(pu + ro + c); } }
#pragma unroll
                for (int mm = 0; mm < 2; ++mm) { const int m = 2 * mp + mm; const size_t ro = (size_t)(row0 + ai * 128 + m * 16) * DM;
#pragma unroll
                    for (int bj = 0; bj < 2; ++bj) { const int c = col0 + bj * 128;
                        const f32x4 v0 = acc[ai][bj][m][0] + bv[bj][0], v1 = acc[ai][bj][m][1] + bv[bj][1];
                        const f32x4 h0 = hh[mm][bj][0], h1 = hh[mm][bj][1]; const v4u q = pw[mm][bj];
                        f32x4 o0, o1;
                        o0[0] = h0[0] + sigmoidf_(v0[0]) * bflo(q.x); o0[1] = h0[1] + sigmoidf_(v0[1]) * bfhi(q.x);
                        o0[2] = h0[2] + sigmoidf_(v0[2]) * bflo(q.y); o0[3] = h0[3] + sigmoidf_(v0[3]) * bfhi(q.y);
                        o1[0] = h1[0] + sigmoidf_(v1[0]) * bflo(q.z); o1[1] = h1[1] + sigmoidf_(v1[1]) * bfhi(q.z);
                        o1[2] = h1[2] + sigmoidf_(v1[2]) * bflo(q.w); o1[3] = h1[3] + sigmoidf_(v1[3]) * bfhi(q.w);
                        *(f32x4*)(out + ro + c) = o0; *(f32x4*)(out + ro + c + 4) = o1; } }
            }
    }
};

struct Args { const float* in[15]; float* out; unsigned char* ws; };
struct Ctx {
    LAS unsigned char* lds; int tid, lane, wave, gw, NGW;
    const float *x, *p, *pre_w, *w_in, *conv_w, *conv_b, *i_bias, *f_bias, *sb_w, *ml_w, *w_out, *post_w, *w_up, *w_gate, *b_gate;
    float* out; bf16 *WT_IN, *WT_OUT, *WT_GATE, *WT_UP, *U, *Y, *HB, *PROJ, *Y2, *PU, *PB, *QKC; float* GATES;
};

__device__ __forceinline__ void phase0(Ctx& F) {
    {
        LAS float* scr = (LAS float*)(F.lds + F.wave * 16384);
        constexpr int I_IN = 16 * 144, I_O = 16 * 32, I_G = 16 * 32, I_U = 4 * 32, NIT = I_IN + I_O + I_G + I_U;
        for (int it = F.gw; it < NIT; it += F.NGW) {
            int r = it;
            if (r < I_IN) { p0_transpose_item(F.w_in, DM, NIN, 144, F.WT_IN, scr, r, F.lane); continue; } r -= I_IN;
            if (r < I_O) { p0_transpose_item(F.w_out, DM, DM, 32, F.WT_OUT, scr, r, F.lane); continue; } r -= I_O;
            if (r < I_G) { p0_transpose_item(F.w_gate, DM, DM, 32, F.WT_GATE, scr, r, F.lane); continue; } r -= I_G;
            p0_transpose_item(F.w_up, PLE, DM, 32, F.WT_UP, scr, r, F.lane);
        }
    }
    __syncthreads();
    LAS float* Wg = (LAS float*)F.lds;
    for (int e = F.tid; e < 1024 * 8; e += 512) Wg[e] = F.w_in[(size_t)(e >> 3) * NIN + NPROJ + (e & 7)];
    __syncthreads();
    {
        f32x4 pw[4];
#pragma unroll
        for (int j = 0; j < 4; ++j) pw[j] = *((const f32x4*)F.pre_w + F.lane + 64 * j);
        f32x4 ib = *(const f32x4*)F.i_bias, fb = *(const f32x4*)F.f_bias;
        f32x4 vn[4];
        { const f32x4* xr = (const f32x4*)(F.x + (size_t)F.gw * DM) + F.lane;
#pragma unroll
          for (int j = 0; j < 4; ++j) vn[j] = xr[64 * j]; }
        for (int m = F.gw; m < MTOK; m += F.NGW) {
            f32x4 v[4];
#pragma unroll
            for (int j = 0; j < 4; ++j) v[j] = vn[j];
            if (m + F.NGW < MTOK) { const f32x4* xr = (const f32x4*)(F.x + (size_t)(m + F.NGW) * DM) + F.lane;
#pragma unroll
                for (int j = 0; j < 4; ++j) vn[j] = xr[64 * j]; }
            float s = 0.f;
#pragma unroll
            for (int j = 0; j < 4; ++j) s += (v[j].x * v[j].x + v[j].y * v[j].y) + (v[j].z * v[j].z + v[j].w * v[j].w);
            const float rstd = 1.0f / sqrtf(wave_sum(s) * (1.f / DM) + EPS);
            float g[8];
#pragma unroll
            for (int i = 0; i < 8; ++i) g[i] = 0.f;
            unsigned long long* o8 = (unsigned long long*)(F.U + (size_t)m * DM) + F.lane;
#pragma unroll
            for (int j = 0; j < 4; ++j) {
                const f32x4 u = v[j] * rstd * pw[j];
                o8[64 * j] = (unsigned long long)pk2(u.x, u.y) | ((unsigned long long)pk2(u.z, u.w) << 32);
#pragma unroll
                for (int e = 0; e < 4; ++e) { const LAS f32x4* wg = (const LAS f32x4*)(Wg + (256 * j + 4 * F.lane + e) * 8); const f32x4 a = wg[0], b = wg[1]; const float ue = u[e];
                    g[0] += ue * a.x; g[1] += ue * a.y; g[2] += ue * a.z; g[3] += ue * a.w; g[4] += ue * b.x; g[5] += ue * b.y; g[6] += ue * b.z; g[7] += ue * b.w; }
            }
#pragma unroll
            for (int i = 0; i < 8; ++i) g[i] = wave_sum(g[i]);
            if (F.lane == 0) {
                f32x4 gi, gf;
#pragma unroll
                for (int i = 0; i < 4; ++i) { gi[i] = g[i] + ib[i]; const float fp = g[4 + i] + fb[i];
                    gf[i] = fp >= 0.f ? -log1pf(expf(-fp)) : fp - log1pf(expf(fp)); }
                *(f32x4*)(F.GATES + (size_t)m * 8) = gi; *(f32x4*)(F.GATES + (size_t)m * 8 + 4) = gf;
            }
        }
    }
    for (size_t e = (size_t)(blockIdx.x * 512 + F.tid) * 8; e < (size_t)MTOK * PLE; e += (size_t)gridDim.x * 512 * 8) {
        const f32x4 a = *(const f32x4*)(F.p + e), b = *(const f32x4*)(F.p + e + 4);
        v4u o; o.x = pk2(a.x, a.y); o.y = pk2(a.z, a.w); o.z = pk2(b.x, b.y); o.w = pk2(b.z, b.w);
        *(v4u*)(F.PB + e) = o;
    }
}

__device__ __forceinline__ void phase_conv(Ctx& F) {
    const size_t NITEM = (size_t)MTOK * 128;
    for (size_t it = (size_t)blockIdx.x * 512 + F.tid; it < NITEM; it += (size_t)gridDim.x * 512) {
        const int row = (int)(it >> 7), c0 = (int)(it & 127) * 8, t = row & (SEQ - 1);
        float acc[8];
#pragma unroll
        for (int e = 0; e < 8; ++e) acc[e] = F.conv_b[c0 + e];
#pragma unroll
        for (int j = 0; j < 4; ++j) {
            if (t - 3 + j < 0) continue;
            const v4u r = *(const v4u*)(F.PROJ + (size_t)(row - 3 + j) * NPROJ + C_MLQ + c0);
            const f32x4 w0 = *(const f32x4*)(F.conv_w + j * 1024 + c0), w1 = *(const f32x4*)(F.conv_w + j * 1024 + c0 + 4);
            acc[0] += w0.x * bflo(r.x); acc[1] += w0.y * bfhi(r.x); acc[2] += w0.z * bflo(r.y); acc[3] += w0.w * bfhi(r.y);
            acc[4] += w1.x * bflo(r.z); acc[5] += w1.y * bfhi(r.z); acc[6] += w1.z * bflo(r.w); acc[7] += w1.w * bfhi(r.w);
        }
        const float sc = c0 >= 512 ? 0.08838834764831845f : 1.0f;
#pragma unroll
        for (int e = 0; e < 8; ++e) acc[e] = siluf_(acc[e]) * sc;
        v4u o; o.x = pk2(acc[0], acc[1]); o.y = pk2(acc[2], acc[3]); o.z = pk2(acc[4], acc[5]); o.w = pk2(acc[6], acc[7]);
        *(v4u*)(F.QKC + (size_t)row * 1024 + c0) = o;
    }
}

__device__ __forceinline__ void phase_norm(Ctx& F) {
    f32x4 pw[4];
#pragma unroll
    for (int j = 0; j < 2; ++j) { pw[2 * j] = *(const f32x4*)(F.post_w + 512 * j + 8 * F.lane); pw[2 * j + 1] = *(const f32x4*)(F.post_w + 512 * j + 8 * F.lane + 4); }
    v4u yn[2]; f32x4 xn[4];
#define NLOAD(m_) do { const v4u* yr_ = (const v4u*)(F.Y2 + (size_t)(m_) * DM) + F.lane; yn[0] = yr_[0]; yn[1] = yr_[64]; \
        const float* xp_ = F.x + (size_t)(m_) * DM + 8 * F.lane; xn[0] = *(const f32x4*)xp_; xn[1] = *(const f32x4*)(xp_ + 4); xn[2] = *(const f32x4*)(xp_ + 512); xn[3] = *(const f32x4*)(xp_ + 516); } while (0)
    NLOAD(F.gw);
    for (int m = F.gw; m < MTOK; m += F.NGW) {
        v4u yc[2] = {yn[0], yn[1]}; f32x4 xc[4] = {xn[0], xn[1], xn[2], xn[3]};
        if (m + F.NGW < MTOK) NLOAD(m + F.NGW);
        float y[16]; float s = 0.f;
#pragma unroll
        for (int j = 0; j < 2; ++j) { const v4u r = yc[j];
            y[8 * j + 0] = bflo(r.x); y[8 * j + 1] = bfhi(r.x); y[8 * j + 2] = bflo(r.y); y[8 * j + 3] = bfhi(r.y);
            y[8 * j + 4] = bflo(r.z); y[8 * j + 5] = bfhi(r.z); y[8 * j + 6] = bflo(r.w); y[8 * j + 7] = bfhi(r.w); }
#pragma unroll
        for (int e = 0; e < 16; ++e) s += y[e] * y[e];
        const float rstd = 1.0f / sqrtf(wave_sum(s) * (1.f / DM) + EPS);
#pragma unroll
        for (int j = 0; j < 2; ++j) {
            const int c = 512 * j + 8 * F.lane; const size_t o = (size_t)m * DM + c;
            f32x4 h0, h1;
#pragma unroll
            for (int e = 0; e < 4; ++e) { h0[e] = xc[2 * j][e] + y[8 * j + e] * rstd * pw[2 * j][e]; h1[e] = xc[2 * j + 1][e] + y[8 * j + 4 + e] * rstd * pw[2 * j + 1][e]; }
            *(f32x4*)(F.out + o) = h0; *(f32x4*)(F.out + o + 4) = h1;
            v4u hb; hb.x = pk2(h0[0], h0[1]); hb.y = pk2(h0[2], h0[3]); hb.z = pk2(h1[0], h1[1]); hb.w = pk2(h1[2], h1[3]);
            *(v4u*)(F.HB + o) = hb;
        }
    }
#undef NLOAD
}
#define XB_TMO      128
#define XB_XCNT(j)  (256  + 64 * (j))
#define XB_XSUB(j)  (1280 + 64 * (j))
#define XB_XGEN(j)  (2304 + 64 * (j))
#define XB_TOP      3328
#define XB_TOPGEN   3392
#define XCD_BAR_WORDS 3456
#define XB_SPIN_CAP (1u << 18)

__device__ __forceinline__ unsigned xb_ld(unsigned* p)              { return __hip_atomic_load(p, __ATOMIC_RELAXED, __HIP_MEMORY_SCOPE_AGENT); }
__device__ __forceinline__ unsigned xb_add(unsigned* p, unsigned v) { return __hip_atomic_fetch_add(p, v, __ATOMIC_RELAXED, __HIP_MEMORY_SCOPE_AGENT); }
__device__ __forceinline__ unsigned xb_xcc_id() { return (unsigned)__builtin_amdgcn_s_getreg((3 << 11) | 20) & 0xFu; }
#define XB_SPIN(cond, bar) do { unsigned _sp = 0; while (cond) { __builtin_amdgcn_s_sleep(1); \
    if ((++_sp & 255u) == 0u) { if (xb_ld(&(bar)[XB_TMO])) break; if (_sp > XB_SPIN_CAP) { atomicAdd(&(bar)[XB_TMO], 1u); break; } } } } while (0)

struct XcdBarrier {
    unsigned* bar; unsigned x;
    volatile LAS unsigned* st;
};

__device__ __forceinline__ XcdBarrier xcd_barrier_post(unsigned* bar, volatile LAS unsigned* st) {
    XcdBarrier b; b.bar = bar; b.x = xb_xcc_id(); b.st = st;
    if (threadIdx.x == 0) (void)xb_add(&bar[XB_XCNT(b.x)], 1u);
    return b;
}
__device__ __forceinline__ void xcd_barrier_complete(unsigned* bar, unsigned x, unsigned& nloc, unsigned& nx) {
    const unsigned G = gridDim.x * gridDim.y * gridDim.z;
    unsigned sum, cnt, mine, sp = 0u;
    for (;;) {
        sum = 0u; cnt = 0u; mine = 0u;
#pragma unroll
        for (unsigned j = 0; j < 16; ++j) { const unsigned c = xb_ld(&bar[XB_XCNT(j)]); sum += c; cnt += (c > 0u) ? 1u : 0u; mine = (j == x) ? c : mine; }
        if (sum == G) break;
        __builtin_amdgcn_s_sleep(1);
        if ((++sp & 255u) == 0u) { if (xb_ld(&bar[XB_TMO])) break; if (sp > XB_SPIN_CAP) { atomicAdd(&bar[XB_TMO], 1u); break; } }
    }
    nloc = mine > 0u ? mine : 1u; nx = cnt > 0u ? cnt : 1u;
}

__device__ __forceinline__ void xcd_barrier(const XcdBarrier& b) {
    asm volatile("s_waitcnt vmcnt(0)" ::: "memory");
    __syncthreads();
    if (threadIdx.x == 0) {
        unsigned* bar = b.bar;
        __builtin_amdgcn_s_waitcnt(0);
        unsigned nloc = b.st[0], nx = b.st[1];
        if (nloc == 0u) { xcd_barrier_complete(bar, b.x, nloc, nx); b.st[0] = nloc; b.st[1] = nx; }
        const unsigned old = xb_add(&bar[XB_XSUB(b.x)], 1u);
        const unsigned gen = old / nloc;
        if (old + 1u == (gen + 1u) * nloc) {
            __builtin_amdgcn_fence(__ATOMIC_RELEASE, "agent");
            asm volatile("s_waitcnt vmcnt(0)" ::: "memory");
            const unsigned og = xb_add(&bar[XB_TOP], 1u);
            const unsigned tg = og / nx;
            if (og + 1u == (tg + 1u) * nx) xb_add(&bar[XB_TOPGEN], 1u);
            else XB_SPIN(xb_ld(&bar[XB_TOPGEN]) == tg, bar);
            __builtin_amdgcn_fence(__ATOMIC_ACQUIRE, "agent");
            xb_add(&bar[XB_XGEN(b.x)], 1u);
            asm volatile("s_waitcnt vmcnt(0)" ::: "memory");
        } else {
            XB_SPIN(xb_ld(&bar[XB_XGEN(b.x)]) == gen, bar);
            __builtin_amdgcn_fence(__ATOMIC_ACQUIRE, "agent");
            asm volatile("s_waitcnt vmcnt(0)" ::: "memory");
        }
    }
    __syncthreads();
}

typedef short v4i16_t __attribute__((ext_vector_type(4)));
typedef float f32x2_t __attribute__((ext_vector_type(2)));
typedef __bf16 bf16x2_t __attribute__((ext_vector_type(2)));
__device__ __forceinline__ unsigned cvtpk(float lo, float hi) { f32x2_t v = {lo, hi}; bf16x2_t b = __builtin_convertvector(v, bf16x2_t); return __builtin_bit_cast(unsigned, b); }
__device__ __forceinline__ s16x4 vtr(const LAS unsigned char* p) { return __builtin_bit_cast(s16x4, __builtin_amdgcn_ds_read_tr16_b64_v4i16((LAS v4i16_t*)p)); }
__device__ __forceinline__ bf16x8 pack8(const f32x16& x, int s) {
    v4u p; p.x = cvtpk(x[8 * s + 0], x[8 * s + 1]); p.y = cvtpk(x[8 * s + 2], x[8 * s + 3]); p.z = cvtpk(x[8 * s + 4], x[8 * s + 5]); p.w = cvtpk(x[8 * s + 6], x[8 * s + 7]);
    return __builtin_bit_cast(bf16x8, p);
}
template <bool MASK> __device__ __forceinline__ void sb_half(f32x16& p, float& R, int kbase, int t, int hi) {
    float lk[16];
#pragma unroll
    for (int i = 0; i < 16; ++i) {
        const float z = p[i];
        float v = -(fmaxf(z, 0.f) + __builtin_amdgcn_logf(1.f + __builtin_amdgcn_exp2f(-fabsf(z))));
        if (MASK) { const int key = kbase + (i & 3) + 8 * (i >> 2); v = key < t ? v : 0.f; }
        lk[i] = v;
    }
#pragma unroll
    for (int g = 0; g < 4; ++g) { lk[4 * g + 2] += lk[4 * g + 3]; lk[4 * g + 1] += lk[4 * g + 2]; lk[4 * g] += lk[4 * g + 1]; }
    float Glo[4], Ghi[4];
#pragma unroll
    for (int g = 0; g < 4; ++g) { const float own = lk[4 * g], oth = __shfl_xor(own, 32); Glo[g] = hi ? oth : own; Ghi[g] = hi ? own : oth; }
    float acc = R;
#pragma unroll
    for (int g = 3; g >= 0; --g) {
        const float off1 = acc, off0 = acc + Ghi[g]; acc = off0 + Glo[g];
        const float off = hi ? off1 : off0;
#pragma unroll
        for (int e = 0; e < 4; ++e) { const int i = 4 * g + e;
            float a = __builtin_amdgcn_exp2f(p[i] + (lk[i] + off));
            if (MASK) { const int key = kbase + (i & 3) + 8 * (i >> 2); a = key < t ? a : 0.f; }
            p[i] = a; }
    }
    R = acc;
}
__device__ __forceinline__ void attn_fast(Ctx& F, unsigned* ctr) {
    constexpr int VP = 144;
    LAS unsigned char* vt = F.lds + F.wave * 16384;
    int lane_ = F.lane; asm volatile("" : "+v"(lane_));
    const int lane = lane_, r32 = lane & 31, hi = lane >> 5;
    const int i16 = lane & 15, tq = i16 >> 2, tp = i16 & 3, blk = (lane >> 4) & 1;
    const int troff = (4 * hi + tq) * VP + (16 * blk + 4 * tp) * 2;
    for (int unit = F.gw; unit < NB * 8 * (SEQ / 32); unit += F.NGW) {
        const int bh = unit >> 7, qb = unit & 127, b = bh >> 3, h = bh & 7, q0 = 32 * qb, t = q0 + r32;
        const bf16* base = F.PROJ + (size_t)b * SEQ * NPROJ + h * 64;
        bf16x8 qr[4];
        { const bf16* qp = base + (size_t)t * NPROJ + C_SBQ + 8 * hi;
#pragma unroll
          for (int d0 = 0; d0 < 4; ++d0) qr[d0] = *(const bf16x8*)(qp + 16 * d0); }
        const int kt = (q0 + 31) >> 6;
        bf16x8 kf[2][4]; v4u vr[8];
#define LOAD_KV(KF, VR, k0_) do { const bf16* kp_ = base + (size_t)((k0_) + r32) * NPROJ + C_SBK + 8 * hi; \
            _Pragma("unroll") for (int hh = 0; hh < 2; ++hh) _Pragma("unroll") for (int d0 = 0; d0 < 4; ++d0) KF[hh][d0] = *(const bf16x8*)(kp_ + (size_t)hh * 32 * NPROJ + 16 * d0); \
            const bf16* vp_ = base + (size_t)((k0_) + (lane >> 3)) * NPROJ + C_SBV + 8 * (lane & 7); \
            _Pragma("unroll") for (int i = 0; i < 8; ++i) VR[i] = *(const v4u*)(vp_ + (size_t)(8 * i) * NPROJ); } while (0)
        LOAD_KV(kf, vr, 64 * kt);
        f32x16 o[2];
#pragma unroll
        for (int i = 0; i < 16; ++i) { o[0][i] = 0.f; o[1][i] = 0.f; }
        float R = 0.f;
        for (int it = kt; it >= 0; --it) {
            const int k0 = 64 * it;
            asm volatile("" ::: "memory");
#pragma unroll
            for (int i = 0; i < 8; ++i) *(LAS v4u*)(vt + (8 * i + (lane >> 3)) * VP + 16 * (lane & 7)) = vr[i];
            asm volatile("" ::: "memory");
            bf16x8 kc[2][4];
#pragma unroll
            for (int hh = 0; hh < 2; ++hh)
#pragma unroll
                for (int d0 = 0; d0 < 4; ++d0) kc[hh][d0] = kf[hh][d0];
            if (it > 0) LOAD_KV(kf, vr, k0 - 64);
            const bool first = (it == kt);
            const bool do_hi = !first || (k0 + 32 <= q0 + 30);
            f32x16 p0, p1;
#pragma unroll
            for (int i = 0; i < 16; ++i) { p0[i] = 0.f; p1[i] = 0.f; }
#pragma unroll
            for (int d0 = 0; d0 < 4; ++d0) p0 = __builtin_amdgcn_mfma_f32_32x32x16_bf16(kc[0][d0], qr[d0], p0, 0, 0, 0);
            if (do_hi) {
#pragma unroll
                for (int d0 = 0; d0 < 4; ++d0) p1 = __builtin_amdgcn_mfma_f32_32x32x16_bf16(kc[1][d0], qr[d0], p1, 0, 0, 0);
                if (first) sb_half<true>(p1, R, k0 + 32 + 4 * hi, t, hi); else sb_half<false>(p1, R, k0 + 32 + 4 * hi, t, hi);
            }
            const bool do_lo = !(do_hi && __all(R < -151.f));
            if (do_lo) { if (first) sb_half<true>(p0, R, k0 + 4 * hi, t, hi); else sb_half<false>(p0, R, k0 + 4 * hi, t, hi); }
#pragma unroll
            for (int hh = 1; hh >= 0; --hh) {
                if (hh == 1 && !do_hi) continue;
                if (hh == 0 && !do_lo) continue;
#pragma unroll
                for (int s = 0; s < 2; ++s) {
                    const bf16x8 pa = pack8(hh ? p1 : p0, s);
#pragma unroll
                    for (int dh = 0; dh < 2; ++dh) {
                        const LAS unsigned char* vb = vt + troff + (32 * hh + 16 * s) * VP + 64 * dh;
                        const s16x4 lo = vtr(vb), hi4 = vtr(vb + 8 * VP);
                        const bf16x8 vf = {lo[0], lo[1], lo[2], lo[3], hi4[0], hi4[1], hi4[2], hi4[3]};
                        o[dh] = __builtin_amdgcn_mfma_f32_32x32x16_bf16(pa, vf, o[dh], 0, 0, 0);
                    }
                }
            }
            if (!do_lo || __all(R < -151.f)) break;
        }
#undef LOAD_KV
        asm volatile("" ::: "memory");
        LAS float* os = (LAS float*)vt;
#pragma unroll
        for (int dh = 0; dh < 2; ++dh)
#pragma unroll
            for (int i = 0; i < 16; ++i) os[((i & 3) + 8 * (i >> 2) + 4 * hi) * 65 + 32 * dh + r32] = o[dh][i];
        asm volatile("" ::: "memory");
        const int q = lane >> 1, hf = lane & 1;
        float ov[32]; float ss = 0.f;
#pragma unroll
        for (int e = 0; e < 32; ++e) { ov[e] = os[q * 65 + 32 * hf + e]; ss += ov[e] * ov[e]; }
        ss += __shfl_xor(ss, 1);
        const float rstd = 1.0f / sqrtf(ss * (1.f / 64.f) + EPS);
        const size_t row = (size_t)b * SEQ + q0 + q;
        const int c0 = h * 64 + 32 * hf;
#pragma unroll
        for (int c = 0; c < 4; ++c) {
            const v4u zr = *(const v4u*)(F.PROJ + row * NPROJ + C_SBZ + c0 + 8 * c);
            const f32x4 w0 = *(const f32x4*)(F.sb_w + c0 + 8 * c), w1 = *(const f32x4*)(F.sb_w + c0 + 8 * c + 4);
            v4u w;
            w.x = pk2(ov[8 * c + 0] * rstd * w0.x * siluf_(bflo(zr.x)), ov[8 * c + 1] * rstd * w0.y * siluf_(bfhi(zr.x)));
            w.y = pk2(ov[8 * c + 2] * rstd * w0.z * siluf_(bflo(zr.y)), ov[8 * c + 3] * rstd * w0.w * siluf_(bfhi(zr.y)));
            w.z = pk2(ov[8 * c + 4] * rstd * w1.x * siluf_(bflo(zr.z)), ov[8 * c + 5] * rstd * w1.y * siluf_(bfhi(zr.z)));
            w.w = pk2(ov[8 * c + 6] * rstd * w1.z * siluf_(bflo(zr.w)), ov[8 * c + 7] * rstd * w1.w * siluf_(bfhi(zr.w)));
            *(v4u*)(F.Y + row * DM + c0 + 8 * c) = w;
        }
        asm volatile("" ::: "memory");
    }
}
constexpr int SL_N = 16384, SL_SC = 16512, SL_STRIDE = 16640;
__device__ __forceinline__ v4u scale8(v4u r, float s) {
    v4u o; o.x = cvtpk(bflo(r.x) * s, bfhi(r.x) * s); o.y = cvtpk(bflo(r.y) * s, bfhi(r.y) * s); o.z = cvtpk(bflo(r.z) * s, bfhi(r.z) * s); o.w = cvtpk(bflo(r.w) * s, bfhi(r.w) * s); return o;
}
template <int PASS> __device__ __forceinline__ void mlstm_fast(Ctx& F, float* SLOC) {
    constexpr int PT = 272, SP = 144, HP = 129;
    constexpr int L_Q = 0, L_K = 17408, L_V = 34816, L_VW = 52224, L_S = 69632, L_H = 78848, L_SC = 111872;
    constexpr int L_RAWQ = L_S, L_RAWK = L_S + 17408;
    constexpr int L_HALO = L_SC + 1024, L_CW = L_HALO + 3072;
    static_assert(L_RAWK + 17408 <= L_SC && L_CW + 5120 <= 131072, "mLSTM LDS map");
    LAS unsigned char* L = F.lds;
    LAS float* su = (LAS float*)(L + L_SC); LAS float* sM = su + 64; LAS float* sb = su + 128; LAS bf16* swb = (LAS bf16*)(su + 192);
    LAS float* Hs = (LAS float*)(L + L_H);
    const int nunits = PASS == 1 ? NB * 4 * 7 : NB * 4 * 8;
    for (int unit = blockIdx.x; unit < nunits; unit += gridDim.x) {
        int tid_ = F.tid; asm volatile("" : "+v"(tid_));
        const int tid = tid_, lane = tid & 63, w = __builtin_amdgcn_readfirstlane(tid >> 6), fr = lane & 15, fq = lane >> 4, tq = fr >> 2, tp = fr & 3;
        const int srow = tid >> 3, sc8 = tid & 7, v0 = 16 * w;
        int bh, seg; if (PASS == 1) { bh = unit / 7; seg = unit % 7; } else { bh = unit >> 3; seg = unit & 7; }
        const int b = bh >> 2, h = bh & 3;
        const size_t row0 = (size_t)b * SEQ + (size_t)seg * 512;
        f32x4 X[8], Xn[8];
#pragma unroll
        for (int t = 0; t < 8; ++t) { X[t] = (f32x4){0.f, 0.f, 0.f, 0.f}; Xn[t] = (f32x4){0.f, 0.f, 0.f, 0.f}; }
        float m_prev = PASS == 1 ? -1e30f : 0.f, bsum = 0.f;
        if (PASS == 2) {
            for (int j = 0; j < seg; ++j) {
                const float* S = SLOC + (size_t)(bh * 7 + j) * SL_STRIDE;
                const float mloc = S[SL_SC], Bs = S[SL_SC + 1];
                const float m_new = fmaxf(Bs + m_prev, mloc), fa = __expf(Bs + m_prev - m_new), fg = __expf(mloc - m_new);
#pragma unroll
                for (int t = 0; t < 8; ++t) { const f32x4 cl = *(const f32x4*)(S + (size_t)(t * 512 + tid) * 4); X[t] = X[t] * fa + cl * fg;
                    const f32x4 nl = *(const f32x4*)(S + SL_N + 16 * t + 4 * fq); Xn[t] = Xn[t] * fa + nl * fg; }
                m_prev = m_new;
            }
        }
        __syncthreads();
        { int tu = tid; asm volatile("" : "+v"(tu));
          LAS float* cw = (LAS float*)(L + L_CW);
          for (int e = tu; e < 1280; e += 512) { float val;
              if (e < 1024) { const int tn = e >> 9, j = (e >> 7) & 3, cch = e & 127; val = F.conv_w[j * 1024 + tn * 512 + h * 128 + cch]; }
              else { const int tn = (e - 1024) >> 7, cch = e & 127; val = F.conv_b[tn * 512 + h * 128 + cch]; }
              cw[e] = val; }
          if (tu < 96) { const int tn = tu >= 48 ? 1 : 0, r = (tu - 48 * tn) >> 4, c16 = tu & 15; v4u hv = (v4u){0u, 0u, 0u, 0u};
              if (seg > 0) hv = *(const v4u*)(F.PROJ + (row0 - 3 + r) * NPROJ + (tn ? C_MLK : C_MLQ) + h * 128 + 8 * c16);
              *(LAS v4u*)(L + L_HALO + (tn * 3 + r) * 256 + 16 * c16) = hv; } }
        v4u pq0, pq1, pk0, pk1, pv0, pv1; float pig, plf;
#define MPREF(c_) do { const size_t rg_ = row0 + (size_t)(c_) * 64 + srow; \
            const bf16* qk_ = F.PROJ + rg_ * NPROJ + C_MLQ + h * 128 + 8 * sc8; const bf16* vv_ = F.PROJ + rg_ * NPROJ + C_MLV + h * 128 + 8 * sc8; \
            if (PASS == 2) { pq0 = *(const v4u*)(qk_); pq1 = *(const v4u*)(qk_ + 64); } \
            pk0 = *(const v4u*)(qk_ + 512); pk1 = *(const v4u*)(qk_ + 512 + 64); pv0 = *(const v4u*)(vv_); pv1 = *(const v4u*)(vv_ + 64); \
            const float* gg_ = F.GATES + (row0 + (size_t)(c_) * 64 + lane) * 8; pig = gg_[h]; plf = gg_[4 + h]; } while (0)
        MPREF(0);
        for (int c = 0; c < 8; ++c) {
            const size_t rowc = row0 + (size_t)c * 64;
            __syncthreads();
            float bc = plf;
#pragma unroll
            for (int o = 1; o < 64; o <<= 1) { const float t_ = __shfl_up(bc, o); if (lane >= o) bc += t_; }
            const float u = pig - bc; float pm = u;
#pragma unroll
            for (int o = 1; o < 64; o <<= 1) { const float t_ = __shfl_up(pm, o); if (lane >= o) pm = fmaxf(pm, t_); }
            const float Mv = fmaxf(m_prev, pm), M63 = __shfl(Mv, 63), blast = __shfl(bc, 63);
            const float wgt = __expf(u - M63);
            if (w == 0) { su[lane] = u; sM[lane] = Mv; sb[lane] = bc; swb[lane] = (bf16)(cvtpk(wgt, 0.f) & 0xffffu); }
            const float wrow = __shfl(wgt, srow);
            *(LAS v4u*)(L + L_RAWK + srow * PT + 16 * sc8) = pk0; *(LAS v4u*)(L + L_RAWK + srow * PT + 16 * (sc8 + 8)) = pk1;
            *(LAS v4u*)(L + L_VW + srow * PT + 16 * sc8) = scale8(pv0, wrow); *(LAS v4u*)(L + L_VW + srow * PT + 16 * (sc8 + 8)) = scale8(pv1, wrow);
            if (PASS == 2) {
                *(LAS v4u*)(L + L_RAWQ + srow * PT + 16 * sc8) = pq0; *(LAS v4u*)(L + L_RAWQ + srow * PT + 16 * (sc8 + 8)) = pq1;
                *(LAS v4u*)(L + L_V + srow * PT + 16 * sc8) = pv0; *(LAS v4u*)(L + L_V + srow * PT + 16 * (sc8 + 8)) = pv1;
            }
            __syncthreads();
            { const int cgp = tid & 31, tn = cgp >> 4, c16 = cgp & 15, rg4 = tid >> 5;
              if (PASS == 2 || tn == 1) {
                  const LAS unsigned char* rawb = L + (tn ? L_RAWK : L_RAWQ) + 16 * c16;
                  const LAS unsigned char* halob = L + L_HALO + ((c & 1) * 6 + tn * 3) * 256 + 16 * c16;
#pragma unroll 1
                  for (int hf = 0; hf < 2; ++hf) {
                      v2u rw[7];
#pragma unroll
                      for (int i = 0; i < 7; ++i) { const int rr = 4 * rg4 - 3 + i; rw[i] = *(const LAS v2u*)((rr >= 0 ? rawb + rr * PT : halob + (3 + rr) * 256) + 8 * hf); }
                      const LAS float* cw = (const LAS float*)(L + L_CW) + tn * 512 + 8 * c16 + 4 * hf;
                      const f32x4 b0 = *(const LAS f32x4*)((const LAS float*)(L + L_CW) + 1024 + tn * 128 + 8 * c16 + 4 * hf);
                      f32x4 w0[4];
#pragma unroll
                      for (int j = 0; j < 4; ++j) w0[j] = *(const LAS f32x4*)(cw + j * 128);
                      const float sc = tn ? 0.08838834764831845f : 1.0f;
#pragma unroll
                      for (int o = 0; o < 4; ++o) {
                          f32x4 a0 = b0;
#pragma unroll
                          for (int j = 0; j < 4; ++j) { const v2u r = rw[o + j];
                              a0[0] += w0[j][0] * bflo(r.x); a0[1] += w0[j][1] * bfhi(r.x); a0[2] += w0[j][2] * bflo(r.y); a0[3] += w0[j][3] * bfhi(r.y); }
                          v2u ov; ov.x = cvtpk(siluf_(a0[0]) * sc, siluf_(a0[1]) * sc); ov.y = cvtpk(siluf_(a0[2]) * sc, siluf_(a0[3]) * sc);
                          *(LAS v2u*)(L + (tn ? L_K : L_Q) + (4 * rg4 + o) * PT + 16 * c16 + 8 * hf) = ov;
                      }
                      if (rg4 == 15) {
#pragma unroll
                          for (int r = 0; r < 3; ++r) *(LAS v2u*)(L + L_HALO + (((c + 1) & 1) * 6 + tn * 3 + r) * 256 + 16 * c16 + 8 * hf) = rw[4 + r];
                      }
                  }
              } }
            __syncthreads();
            if (PASS == 2) {
                const int lt = w & 3, sp = w >> 2;
#pragma unroll
                for (int si = 0; si < 2; ++si) {
                    const int st = 2 * sp + si;
                    f32x4 acc = (f32x4){0.f, 0.f, 0.f, 0.f};
                    if (st <= lt) {
#pragma unroll
                        for (int ks = 0; ks < 4; ++ks) {
                            const bf16x8 ak = *(const LAS bf16x8*)(L + L_K + (16 * st + fr) * PT + (32 * ks + 8 * fq) * 2);
                            const bf16x8 bq = *(const LAS bf16x8*)(L + L_Q + (16 * lt + fr) * PT + (32 * ks + 8 * fq) * 2);
                            acc = __builtin_amdgcn_mfma_f32_16x16x32_bf16(ak, bq, acc, 0, 0, 0);
                        }
                        const f32x4 us = *(const LAS f32x4*)(su + 16 * st + 4 * fq); const float Ml = sM[16 * lt + fr];
                        const int l = 16 * lt + fr, s0 = 16 * st + 4 * fq;
#pragma unroll
                        for (int j = 0; j < 4; ++j) acc[j] = (s0 + j <= l) ? acc[j] * __expf(us[j] - Ml) : 0.f;
                    }
                    v2u pw; pw.x = cvtpk(acc[0], acc[1]); pw.y = cvtpk(acc[2], acc[3]);
                    *(LAS v2u*)(L + L_S + (16 * lt + fr) * SP + (16 * st + 4 * fq) * 2) = pw;
                }
                __syncthreads();
                f32x4 num[4], den[4];
#pragma unroll
                for (int i = 0; i < 4; ++i) { num[i] = (f32x4){0.f, 0.f, 0.f, 0.f}; den[i] = (f32x4){0.f, 0.f, 0.f, 0.f}; }
#pragma unroll
                for (int kk = 0; kk < 4; ++kk) {
                    v4u bsw, bnw;
                    bsw.x = cvtpk(X[2 * kk][0], X[2 * kk][1]); bsw.y = cvtpk(X[2 * kk][2], X[2 * kk][3]); bsw.z = cvtpk(X[2 * kk + 1][0], X[2 * kk + 1][1]); bsw.w = cvtpk(X[2 * kk + 1][2], X[2 * kk + 1][3]);
                    bnw.x = cvtpk(Xn[2 * kk][0], Xn[2 * kk][1]); bnw.y = cvtpk(Xn[2 * kk][2], Xn[2 * kk][3]); bnw.z = cvtpk(Xn[2 * kk + 1][0], Xn[2 * kk + 1][1]); bnw.w = cvtpk(Xn[2 * kk + 1][2], Xn[2 * kk + 1][3]);
                    const bf16x8 bs = __builtin_bit_cast(bf16x8, bsw), bn = __builtin_bit_cast(bf16x8, bnw);
#pragma unroll
                    for (int i = 0; i < 4; ++i) {
                        const LAS unsigned char* qa = L + L_Q + (16 * i + fr) * PT + (32 * kk + 4 * fq) * 2;
                        const v2u lo = *(const LAS v2u*)qa, hi = *(const LAS v2u*)(qa + 32);
                        const v4u aw = {lo.x, lo.y, hi.x, hi.y}; const bf16x8 aq = __builtin_bit_cast(bf16x8, aw);
                        num[i] = __builtin_amdgcn_mfma_f32_16x16x32_bf16(aq, bs, num[i], 0, 0, 0);
                        den[i] = __builtin_amdgcn_mfma_f32_16x16x32_bf16(aq, bn, den[i], 0, 0, 0);
                    }
                    __builtin_amdgcn_sched_barrier(0);
                }
#pragma unroll
                for (int i = 0; i < 4; ++i) { const f32x4 Ml = *(const LAS f32x4*)(sM + 16 * i + 4 * fq);
#pragma unroll
                    for (int j = 0; j < 4; ++j) { const float cs = __expf(m_prev - Ml[j]); num[i][j] *= cs; den[i][j] *= cs; } }
                const v4u onesw = {0x3f803f80u, 0x3f803f80u, 0x3f803f80u, 0x3f803f80u}; const bf16x8 ones = __builtin_bit_cast(bf16x8, onesw);
#pragma unroll
                for (int ks = 0; ks < 2; ++ks) {
                    const LAS unsigned char* vb = L + L_V + (32 * ks + 8 * fq + tq) * PT + (v0 + 4 * tp) * 2;
                    const s16x4 lo = vtr(vb), hi4 = vtr(vb + 4 * PT);
                    const bf16x8 bv = {lo[0], lo[1], lo[2], lo[3], hi4[0], hi4[1], hi4[2], hi4[3]};
#pragma unroll
                    for (int i = 0; i < 4; ++i) {
                        if (32 * ks > 16 * i + 15) continue;
                        const bf16x8 as = *(const LAS bf16x8*)(L + L_S + (16 * i + fr) * SP + (32 * ks + 8 * fq) * 2);
                        num[i] = __builtin_amdgcn_mfma_f32_16x16x32_bf16(as, bv, num[i], 0, 0, 0);
                        den[i] = __builtin_amdgcn_mfma_f32_16x16x32_bf16(as, ones, den[i], 0, 0, 0);
                    }
                }
#pragma unroll
                for (int i = 0; i < 4; ++i) { const f32x4 Ml = *(const LAS f32x4*)(sM + 16 * i + 4 * fq), bl = *(const LAS f32x4*)(sb + 16 * i + 4 * fq);
#pragma unroll
                    for (int j = 0; j < 4; ++j) Hs[(16 * i + 4 * fq + j) * HP + v0 + fr] = num[i][j] / fmaxf(fabsf(den[i][j]), __expf(-(bl[j] + Ml[j]))); }
            }
            if (c + 1 < 8) MPREF(c + 1);
            {
                const float a = __expf(m_prev - M63);
#pragma unroll
                for (int t = 0; t < 8; ++t) { X[t] *= a; Xn[t] *= a; }
#pragma unroll
                for (int ks = 0; ks < 2; ++ks) {
                    const LAS unsigned char* vb = L + L_VW + (32 * ks + 8 * fq + tq) * PT + (v0 + 4 * tp) * 2;
                    const s16x4 lo = vtr(vb), hi4 = vtr(vb + 4 * PT);
                    const bf16x8 bv = {lo[0], lo[1], lo[2], lo[3], hi4[0], hi4[1], hi4[2], hi4[3]};
                    const bf16x8 bw = *(const LAS bf16x8*)(swb + 32 * ks + 8 * fq);
#pragma unroll
                    for (int t = 0; t < 8; ++t) {
                        const LAS unsigned char* kb = L + L_K + (32 * ks + 8 * fq + tq) * PT + (16 * t + 4 * tp) * 2;
                        const s16x4 klo = vtr(kb), khi = vtr(kb + 4 * PT);
                        const bf16x8 ak = {klo[0], klo[1], klo[2], klo[3], khi[0], khi[1], khi[2], khi[3]};
                        X[t] = __builtin_amdgcn_mfma_f32_16x16x32_bf16(ak, bv, X[t], 0, 0, 0);
                        Xn[t] = __builtin_amdgcn_mfma_f32_16x16x32_bf16(ak, bw, Xn[t], 0, 0, 0);
                        if (t & 1) __builtin_amdgcn_sched_barrier(0);
                    }
                }
                m_prev = blast + M63; bsum += blast;
            }
            if (PASS == 2) {
                v4u po0, po1, pz0, pz1;
                { const bf16* oz = F.PROJ + (rowc + srow) * NPROJ + h * 128 + 16 * sc8;
                  po0 = *(const v4u*)(oz + C_MLO); po1 = *(const v4u*)(oz + C_MLO + 8); pz0 = *(const v4u*)(oz + C_MLZ); pz1 = *(const v4u*)(oz + C_MLZ + 8); }
                __syncthreads();
                const unsigned ow[8] = {po0.x, po0.y, po0.z, po0.w, po1.x, po1.y, po1.z, po1.w}, zw[8] = {pz0.x, pz0.y, pz0.z, pz0.w, pz1.x, pz1.y, pz1.z, pz1.w};
                float yv[16]; float ss = 0.f;
#pragma unroll
                for (int e = 0; e < 8; ++e) { const float h0 = Hs[srow * HP + 16 * sc8 + 2 * e], h1 = Hs[srow * HP + 16 * sc8 + 2 * e + 1];
                    yv[2 * e] = sigmoidf_(bflo(ow[e])) * h0; yv[2 * e + 1] = sigmoidf_(bfhi(ow[e])) * h1; ss += yv[2 * e] * yv[2 * e] + yv[2 * e + 1] * yv[2 * e + 1]; }
                ss += __shfl_xor(ss, 1); ss += __shfl_xor(ss, 2); ss += __shfl_xor(ss, 4);
                const float rstd = 1.0f / sqrtf(ss * (1.f / 128.f) + EPS);
                const float* nw = F.ml_w + h * 128 + 16 * sc8;
                unsigned outw[8];
#pragma unroll
                for (int e = 0; e < 8; ++e) outw[e] = pk2(yv[2 * e] * rstd * nw[2 * e] * siluf_(bflo(zw[e])), yv[2 * e + 1] * rstd * nw[2 * e + 1] * siluf_(bfhi(zw[e])));
                bf16* yp = F.Y + (rowc + srow) * DM + 512 + h * 128 + 16 * sc8;
                *(v4u*)yp = (v4u){outw[0], outw[1], outw[2], outw[3]}; *(v4u*)(yp + 8) = (v4u){outw[4], outw[5], outw[6], outw[7]};
            }
        }
#undef MPREF
        if (PASS == 1) {
            float* S = SLOC + (size_t)(bh * 7 + seg) * SL_STRIDE;
#pragma unroll
            for (int t = 0; t < 8; ++t) { *(f32x4*)(S + (size_t)(t * 512 + tid) * 4) = X[t]; if (w == 0 && fr == 0) *(f32x4*)(S + SL_N + 16 * t + 4 * fq) = Xn[t]; }
            if (tid == 0) { S[SL_SC] = m_prev; S[SL_SC + 1] = bsum; }
        }
        __syncthreads();
    }
}
#define MIXERS(F) do { attn_fast(F, nullptr); mlstm_fast<1>(F, (float*)(args.ws + WS_PB)); GRID_SEAM(); mlstm_fast<2>(F, (float*)(args.ws + WS_PB)); } while (0)
#define GRID_SEAM() xcd_barrier(xbar)
#define GRID_SEAM_() xcd_barrier(xbar)
#ifndef REP_SYNC
#define REP_SYNC 0
#endif
#ifndef REP_P0
#define REP_P0 1
#endif
#ifndef REP_P1
#define REP_P1 1
#endif
#ifndef REP_P3
#define REP_P3 1
#endif
__global__ void __launch_bounds__(512, 2) fwd_kernel(Args args) {
    extern __shared__ __attribute__((aligned(16))) unsigned char lds_raw[];
    cg::grid_group grid = cg::this_grid();
    Ctx F;
    F.lds = (LAS unsigned char*)lds_raw;
    F.tid = threadIdx.x; F.lane = F.tid & 63; F.wave = __builtin_amdgcn_readfirstlane(F.tid >> 6);
    F.gw = blockIdx.x * 8 + F.wave; F.NGW = gridDim.x * 8;
    F.x = args.in[0]; F.p = args.in[1]; F.pre_w = args.in[2]; F.w_in = args.in[3]; F.conv_w = args.in[4]; F.conv_b = args.in[5]; F.i_bias = args.in[6]; F.f_bias = args.in[7];
    F.sb_w = args.in[8]; F.ml_w = args.in[9]; F.w_out = args.in[10]; F.post_w = args.in[11]; F.w_up = args.in[12]; F.w_gate = args.in[13]; F.b_gate = args.in[14];
    F.out = args.out; unsigned char* ws = args.ws;
    F.WT_IN = (bf16*)(ws + WS_WIN); F.WT_OUT = (bf16*)(ws + WS_WOUT); F.WT_GATE = (bf16*)(ws + WS_WGATE); F.WT_UP = (bf16*)(ws + WS_WUP); F.GATES = (float*)(ws + WS_GATES);
    F.U = (bf16*)(ws + WS_U); F.Y = F.U; F.HB = F.U; F.PROJ = (bf16*)(ws + WS_PROJ); F.Y2 = F.PROJ; F.PU = (bf16*)(ws + WS_PU); F.PB = (bf16*)(ws + WS_PB); F.QKC = (bf16*)(ws + WS_QKC);

    volatile LAS unsigned* bar_st = (volatile LAS unsigned*)(F.lds + 131072 + 512);
    if (F.tid < 2) bar_st[F.tid] = 0u;
    __syncthreads();
    unsigned* bar_words = (unsigned*)args.ws;
    if (args.ws == nullptr) grid.sync();
    const XcdBarrier xbar = xcd_barrier_post(bar_words, bar_st);
    for (int rep_ = 0; rep_ < REP_P0; ++rep_) phase0(F);
    GRID_SEAM_();

    for (int rep_ = 0; rep_ < REP_SYNC; ++rep_) GRID_SEAM();
    for (int rep_ = 0; rep_ < REP_P1; ++rep_) {
        pg8::Gemm g{F.U, F.WT_IN, MTOK, NPROJ, DM}; pg8::StaticOrder S; S.init(MTOK, NPROJ, gridDim.x, blockIdx.x);
        pg8::EpiBf16<0> E{F.PROJ, NPROJ, nullptr, 512, 512, 0.125f * 1.4426950408889634f};
        pg8::gemm_phase<pg8::EpiBf16<0>, pg8::StaticOrder, true, true>(F.lds, g, S, E);
        pg8::Gemm g2{F.PB, F.WT_UP, MTOK, DM, PLE}; pg8::StaticOrder S2; S2.init(MTOK, DM, gridDim.x, blockIdx.x);
        pg8::EpiBf16<0> E2{F.PU, DM, nullptr, 0, 0, 1.f};
        pg8::gemm_phase<pg8::EpiBf16<0>, pg8::StaticOrder, true, true>(F.lds, g2, S2, E2);
    }
    GRID_SEAM();
    MIXERS(F);
    GRID_SEAM();
    for (int rep_ = 0; rep_ < REP_P3; ++rep_) {
        pg8::Gemm g{F.Y, F.WT_OUT, MTOK, DM, DM}; pg8::StaticOrder S; S.init(MTOK, DM, gridDim.x, blockIdx.x);
        pg8::EpiBf16<0> E{F.Y2, DM, nullptr, 0, 0, 1.f};
        pg8::gemm_phase<pg8::EpiBf16<0>, pg8::StaticOrder, true, true>(F.lds, g, S, E);
    }
    GRID_SEAM();
    for (int rep_ = 0; rep_ < REP_P0; ++rep_) phase_norm(F);
    GRID_SEAM();
    {
        pg8::Gemm g{F.HB, F.WT_GATE, MTOK, DM, DM}; pg8::StaticOrder S; S.init(MTOK, DM, gridDim.x, blockIdx.x);
        EpiGate E{F.out, F.PU, F.b_gate};
        pg8::gemm_phase<EpiGate, pg8::StaticOrder, true, true>(F.lds, g, S, E);
    }
}

extern "C" void kernel_launch(void* const* d_in, const int* in_sizes, int n_in, void* d_out, int out_size, void* d_ws, size_t ws_size, hipStream_t stream) {
    static int grid = 0;
    if (grid == 0) {
        if (n_in != 15 || out_size != MTOK * DM || ws_size < WS_END) { fprintf(stderr, "kernel_launch: unexpected shapes (n_in %d out %d ws %zu)\n", n_in, out_size, ws_size); grid = -1; return; }
        int dev = 0, cus = 0, per_cu = 0;
        (void)hipGetDevice(&dev); (void)hipDeviceGetAttribute(&cus, hipDeviceAttributeMultiprocessorCount, dev);
        if (hipFuncSetAttribute((const void*)fwd_kernel, hipFuncAttributeMaxDynamicSharedMemorySize, LDS_BYTES) != hipSuccess) { fprintf(stderr, "kernel_launch: hipFuncSetAttribute failed\n"); grid = -1; return; }
        if (hipOccupancyMaxActiveBlocksPerMultiprocessor(&per_cu, (const void*)fwd_kernel, 512, LDS_BYTES) != hipSuccess || per_cu < 1) { fprintf(stderr, "kernel_launch: occupancy query says %d\n", per_cu); per_cu = 1; }
        (void)hipGetLastError();
        grid = cus * 1;
        if (grid <= 0) grid = 256;
    }
    if (grid < 0) return;
    Args a{};
    for (int i = 0; i < 15; ++i) a.in[i] = (const float*)d_in[i];
    a.out = (float*)d_out; a.ws = (unsigned char*)d_ws;
    if (hipMemsetAsync(d_ws, 0, 32768, stream) != hipSuccess) { fprintf(stderr, "kernel_launch: memset of the control words failed\n"); return; }
    void* kargs[] = {&a};
    hipError_t e = hipLaunchCooperativeKernel((const void*)fwd_kernel, dim3(grid), dim3(512), kargs, LDS_BYTES, stream);
    if (e != hipSuccess) fprintf(stderr, "kernel_launch: cooperative launch failed: %s (grid %d)\n", hipGetErrorString(e), grid);
}
```

```cpp
#include <hip/hip_runtime.h>
#include <hip/hip_cooperative_groups.h>
#include <cstdio>
#include <cstdint>
namespace cg = cooperative_groups;

namespace pg8 {
#define PG8_LAS __attribute__((address_space(3)))
typedef unsigned short bf16_t;
typedef short bf16x8 __attribute__((ext_vector_type(8)));
typedef float f32x4 __attribute__((ext_vector_type(4)));
typedef unsigned u32x4 __attribute__((ext_vector_type(4)));
constexpr int BM = 256, BK = 64, HALF = 128, HTB = HALF * BK * 2  , STAGE_BYTES = 8 * HTB, NXCD = 8, WGM = 8;

__host__ __device__ __forceinline__ int lds_byte(int r, int c) { const int st = (r >> 4) * 2 + (c >> 5), rr = r & 15, cc = c & 31, ob = rr * 64 + cc * 2; return st * 1024 + (ob ^ (((ob >> 9) & 1) << 5)); }
__host__ __device__ __forceinline__ void stage_rc(int b, int& R, int& C) { const int st = b / 1024, sb = b % 1024, swz = sb ^ (((sb >> 9) & 1) << 5); R = (st >> 1) * 16 + swz / 64; C = (st & 1) * 32 + (swz % 64) / 2; }
__host__ __device__ __forceinline__ int perm32(int rho) { const int n = rho >> 4, i = rho & 15; return 8 * (i >> 2) + 4 * n + (i & 3); }

struct Unit { int pm, pn; };
struct Gemm { const bf16_t* A; const bf16_t* Bt; int M, N, K; };

struct StaticOrder {
    int nM, nN, nwg, G, c;
    __host__ __device__ void init(int M, int N, int G_, int c_) { nM = M / BM; nN = N / BM; nwg = nM * nN; G = G_; c = c_; }
    __host__ __device__ bool next(int i, Unit& u) const {
        const long L = (long)i * G + c; if (L >= nwg) return false;
        int wgid = (int)L; { const int q = nwg / NXCD, r = nwg % NXCD, xcd = wgid % NXCD, off = wgid / NXCD; wgid = (xcd < r ? xcd * (q + 1) : r * (q + 1) + (xcd - r) * q) + off; }
        const int nig = WGM * nN, gid = wgid / nig, fm = gid * WGM, gsz = (nM - fm) < WGM ? (nM - fm) : WGM;
        u.pm = fm + ((wgid % nig) % gsz); u.pn = (wgid % nig) / gsz; return true;
    }
    __device__ __forceinline__ void a_ready(const Unit&) const {}
    __device__ __forceinline__ void done(const Unit&) const {}
};

__device__ __forceinline__ unsigned cvt_pk_bf16(float lo, float hi) { unsigned r; asm volatile("v_cvt_pk_bf16_f32 %0, %1, %2" : "=v"(r) : "v"(lo), "v"(hi)); return r; }
typedef float f32x2 __attribute__((ext_vector_type(2)));
__device__ __forceinline__ f32x2 gelu_pk(f32x2 v) {
    const f32x2 av = __builtin_elementwise_abs(v), d = av * 0.2316418882f + 1.0f;
    f32x2 t; t.x = __builtin_amdgcn_rcpf(d.x); t.y = __builtin_amdgcn_rcpf(d.y);
    f32x2 q = t * 0.5307027145f + (-0.7265760135f); q = q * t + 0.7107068705f; q = q * t + (-0.142248368f); q = q * t + 0.127414796f; q = q * t;
    const f32x2 s = (v * v) * (-0.72134752044f);
    f32x2 e; e.x = __builtin_amdgcn_exp2f(s.x); e.y = __builtin_amdgcn_exp2f(s.y);
    const f32x2 m = v * (q * e), r = v - m;
    f32x2 o; o.x = v.x < 0.f ? m.x : r.x; o.y = v.y < 0.f ? m.y : r.y; return o;
}

template <int ACT  > struct EpiBf16 {
    static constexpr bool PERM = true, AFTER_DRAIN = false; static_assert(ACT == 0 || ACT == 1, "EpiBf16: ACT is 0 (none) or 1 (gelu_pk)");
    bf16_t* O; int ldc; const float* bias; int split_cols; size_t split_stride; float scale0; int nt;
    __device__ __forceinline__ void operator()(const f32x4 (&acc)[2][2][4][2], const Unit& u, int wr, int wc, int fr, int fq) const {
        const int row0 = u.pm * BM + wr * 64 + fr; int colt = u.pn * BM; bf16_t* base = O;
        float sc = 1.f; if (split_cols) { const int t = colt / split_cols; base += (size_t)t * split_stride; colt -= t * split_cols; if (t == 0) sc = scale0; }
        const int col0 = colt + wc * 32 + 8 * fq, bcol0 = u.pn * BM + wc * 32 + 8 * fq;
        f32x4 bv[2][2];
#pragma unroll
        for (int bj = 0; bj < 2; ++bj)
#pragma unroll
            for (int n = 0; n < 2; ++n) bv[bj][n] = bias ? *(const f32x4*)(bias + bcol0 + bj * HALF + 4 * n) : (f32x4){0.f, 0.f, 0.f, 0.f};
#pragma unroll
        for (int ai = 0; ai < 2; ++ai)
#pragma unroll
            for (int m = 0; m < 4; ++m) { bf16_t* rowp = base + (size_t)(row0 + ai * HALF + m * 16) * ldc + col0;
#pragma unroll
                for (int bj = 0; bj < 2; ++bj) { f32x4 v0 = acc[ai][bj][m][0] + bv[bj][0], v1 = acc[ai][bj][m][1] + bv[bj][1];
                    if (ACT == 1) { f32x2 a = gelu_pk((f32x2){v0[0], v0[1]}), b = gelu_pk((f32x2){v0[2], v0[3]}), c = gelu_pk((f32x2){v1[0], v1[1]}), d = gelu_pk((f32x2){v1[2], v1[3]});
                        v0 = (f32x4){a.x, a.y, b.x, b.y}; v1 = (f32x4){c.x, c.y, d.x, d.y}; }
                    v0 = v0 * sc; v1 = v1 * sc; u32x4 w; w.x = cvt_pk_bf16(v0[0], v0[1]); w.y = cvt_pk_bf16(v0[2], v0[3]); w.z = cvt_pk_bf16(v1[0], v1[1]); w.w = cvt_pk_bf16(v1[2], v1[3]);
                    if (nt) __builtin_nontemporal_store(w, (u32x4*)(rowp + bj * HALF)); else *(u32x4*)(rowp + bj * HALF) = w; } }
    }
};

template <class Epi, class Sched, bool ALIGN_EPI = false, bool SP2 = false>
__device__ __forceinline__ void gemm_phase(PG8_LAS unsigned char* lds, const Gemm g, const Sched& S, const Epi& E) {
    int tid_ = threadIdx.x; asm volatile("" : "+v"(tid_));
    const int tid = tid_, wid = __builtin_amdgcn_readfirstlane(tid >> 6), lane = tid & 63, wr = wid >> 2, wc = wid & 3, fr = lane & 15, fq = lane >> 4;
    const int K = g.K, nt = K / BK;
    unsigned voffA[2], voffB[2];
#pragma unroll
    for (int i = 0; i < 2; ++i) { int R, C; stage_rc(tid * 16 + i * 8192, R, C); const int Rb = Epi::PERM ? ((R & ~31) + perm32(R & 31)) : R;
        voffA[i] = (unsigned)(R * K + C) * 2u; voffB[i] = (unsigned)(Rb * K + C) * 2u; }
    const size_t kstep = (size_t)(BK * 2);
    const size_t hstep = (size_t)HALF * K * 2;
    const size_t tstep = 2 * hstep;
    const unsigned ldsw = (unsigned)wid * 1024u;
    const int aoff = lds_byte(wr * 64 + fr, fq * 8), boff = lds_byte(wc * 32 + fr, fq * 8);
#define PG8_SA(b, h) (((b) * 2 + (h)) * HTB)
#define PG8_SB(b, h) ((4 + (b) * 2 + (h)) * HTB)
#define PG8_STAGE(bufoff, gbase, voff) do { _Pragma("unroll") for (int _i = 0; _i < 2; ++_i) \
        __builtin_amdgcn_global_load_lds((const unsigned*)((const char*)(gbase) + (voff)[_i]), (PG8_LAS unsigned*)(lds + (bufoff) + ldsw + _i * 8192), 16, 0, 0); } while (0)
#define PG8_LDA(dst, b, h) do { _Pragma("unroll") for (int m = 0; m < 4; ++m) _Pragma("unroll") for (int k = 0; k < 2; ++k) dst[m][k] = *(const PG8_LAS bf16x8*)(lds + PG8_SA(b, h) + aoff + m * 2048 + k * 1024); } while (0)
#define PG8_LDB(dst, b, h) do { _Pragma("unroll") for (int n = 0; n < 2; ++n) _Pragma("unroll") for (int k = 0; k < 2; ++k) dst[n][k] = *(const PG8_LAS bf16x8*)(lds + PG8_SB(b, h) + boff + n * 2048 + k * 1024); } while (0)
#define PG8_MMA(ai, bj, At, Bt) do { __builtin_amdgcn_s_setprio(1); _Pragma("unroll") for (int m = 0; m < 4; ++m) _Pragma("unroll") for (int n = 0; n < 2; ++n) _Pragma("unroll") for (int k = 0; k < 2; ++k) \
        acc[ai][bj][m][n] = __builtin_amdgcn_mfma_f32_16x16x32_bf16(Bt[n][k], At[m][k], acc[ai][bj][m][n], 0, 0, 0); __builtin_amdgcn_s_setprio(0); } while (0)
#define PG8_WAIT_V(n) asm volatile("s_waitcnt vmcnt(" #n ")" ::: "memory")
#define PG8_WAIT_L(n) asm volatile("s_waitcnt lgkmcnt(" #n ")" ::: "memory")
#define PG8_BAR __builtin_amdgcn_s_barrier()
#define PG8_SCHED __builtin_amdgcn_sched_barrier(0)
    Unit cur, nxt; int ui = 0;
    if (!S.next(0, cur)) return;
    f32x4 acc[2][2][4][2];
#pragma unroll
    for (int a = 0; a < 2; ++a)
#pragma unroll
        for (int b = 0; b < 2; ++b)
#pragma unroll
            for (int m = 0; m < 4; ++m)
#pragma unroll
                for (int n = 0; n < 2; ++n) acc[a][b][m][n] = (f32x4){0.f, 0.f, 0.f, 0.f};
    bf16x8 At[4][2], B0[2][2], B1[2][2];
    const char* cA = (const char*)g.A + (size_t)cur.pm * tstep; const char* cB = (const char*)g.Bt + (size_t)cur.pn * tstep;
    S.a_ready(cur);
    if constexpr (SP2) {
        PG8_STAGE(PG8_SB(0, 0), cB, voffB); PG8_STAGE(PG8_SB(0, 1), cB + hstep, voffB); PG8_STAGE(PG8_SA(0, 0), cA, voffA); PG8_STAGE(PG8_SA(0, 1), cA + hstep, voffA);
        if (wr == 1) PG8_BAR;
        PG8_WAIT_V(2); PG8_BAR;
        PG8_STAGE(PG8_SB(1, 0), cB + kstep, voffB); PG8_STAGE(PG8_SA(1, 0), cA + kstep, voffA); PG8_STAGE(PG8_SB(1, 1), cB + hstep + kstep, voffB);
        PG8_WAIT_V(6); PG8_BAR;
    } else {
        PG8_STAGE(PG8_SB(0, 0), cB, voffB); PG8_STAGE(PG8_SA(0, 0), cA, voffA); PG8_STAGE(PG8_SB(0, 1), cB + hstep, voffB); PG8_STAGE(PG8_SA(0, 1), cA + hstep, voffA);
        if (wr == 1) PG8_BAR;
        PG8_WAIT_V(4); PG8_BAR;
        PG8_STAGE(PG8_SB(1, 0), cB + kstep, voffB); PG8_STAGE(PG8_SA(1, 0), cA + kstep, voffA); PG8_STAGE(PG8_SB(1, 1), cB + hstep + kstep, voffB);
        PG8_WAIT_V(6); PG8_BAR;
    }
    for (;;) {
        const bool has_next = S.next(ui + 1, nxt);
        const char* nA = has_next ? (const char*)g.A + (size_t)nxt.pm * tstep : cA; const char* nB = has_next ? (const char*)g.Bt + (size_t)nxt.pn * tstep : cB;
        for (int t = 0; t < nt; t += 2) {
            const bool last = (t == nt - 2);
            const char* a1 = cA + (size_t)(t + 1) * kstep;
            const char* a2 = last ? nA : cA + (size_t)(t + 2) * kstep; const char* b2 = last ? nB : cB + (size_t)(t + 2) * kstep;
            const char* a3 = a2 + kstep; const char* b3 = b2 + kstep;
            if (last && has_next) S.a_ready(nxt);
            if constexpr (SP2) {
            PG8_LDB(B0, 0, 0); PG8_LDB(B1, 0, 1); PG8_SCHED; PG8_LDA(At, 0, 0); PG8_STAGE(PG8_SA(1, 1), a1 + hstep, voffA);
            PG8_WAIT_V(8); PG8_WAIT_L(0); PG8_BAR; PG8_MMA(0, 0, At, B0); PG8_MMA(0, 1, At, B1); PG8_BAR; PG8_SCHED;
            PG8_LDA(At, 0, 1); PG8_STAGE(PG8_SB(0, 0), b2, voffB); PG8_STAGE(PG8_SB(0, 1), b2 + hstep, voffB); PG8_STAGE(PG8_SA(0, 0), a2, voffA);
            PG8_WAIT_V(8); PG8_WAIT_L(0); PG8_BAR; PG8_MMA(1, 0, At, B0); PG8_MMA(1, 1, At, B1); PG8_BAR; PG8_SCHED;
            PG8_LDB(B0, 1, 0); PG8_LDB(B1, 1, 1); PG8_SCHED; PG8_LDA(At, 1, 0); PG8_STAGE(PG8_SA(0, 1), a2 + hstep, voffA);
            PG8_WAIT_V(8); PG8_WAIT_L(0); PG8_BAR; PG8_MMA(0, 0, At, B0); PG8_MMA(0, 1, At, B1); PG8_BAR; PG8_SCHED;
            PG8_LDA(At, 1, 1); PG8_STAGE(PG8_SB(1, 0), b3, voffB); PG8_STAGE(PG8_SB(1, 1), b3 + hstep, voffB); PG8_STAGE(PG8_SA(1, 0), a3, voffA);
            PG8_WAIT_V(8); PG8_WAIT_L(0); PG8_BAR; PG8_MMA(1, 0, At, B0); PG8_MMA(1, 1, At, B1); PG8_BAR; PG8_SCHED;
            } else {
            PG8_LDB(B0, 0, 0); PG8_SCHED; PG8_LDA(At, 0, 0); PG8_STAGE(PG8_SA(1, 1), a1 + hstep, voffA);
            PG8_WAIT_L(8); PG8_BAR; PG8_WAIT_L(0); PG8_MMA(0, 0, At, B0); PG8_BAR; PG8_SCHED;
            PG8_LDB(B1, 0, 1); PG8_STAGE(PG8_SB(0, 0), b2, voffB);
            PG8_BAR; PG8_WAIT_L(0); PG8_MMA(0, 1, At, B1); PG8_BAR;
            PG8_LDA(At, 0, 1); PG8_STAGE(PG8_SA(0, 0), a2, voffA);
            PG8_BAR; PG8_WAIT_L(0); PG8_MMA(1, 0, At, B0); PG8_BAR; PG8_SCHED;
            PG8_STAGE(PG8_SB(0, 1), b2 + hstep, voffB);
            PG8_WAIT_V(6); PG8_BAR; PG8_MMA(1, 1, At, B1); PG8_BAR;
            PG8_LDB(B0, 1, 0); PG8_SCHED; PG8_LDA(At, 1, 0); PG8_STAGE(PG8_SA(0, 1), a2 + hstep, voffA);
            PG8_WAIT_L(8); PG8_BAR; PG8_WAIT_L(0); PG8_MMA(0, 0, At, B0); PG8_BAR; PG8_SCHED;
            PG8_LDB(B1, 1, 1); PG8_STAGE(PG8_SB(1, 0), b3, voffB);
            PG8_BAR; PG8_WAIT_L(0); PG8_MMA(0, 1, At, B1); PG8_BAR;
            PG8_LDA(At, 1, 1); PG8_STAGE(PG8_SA(1, 0), a3, voffA);
            PG8_BAR; PG8_WAIT_L(0); PG8_MMA(1, 0, At, B0); PG8_BAR; PG8_SCHED;
            PG8_STAGE(PG8_SB(1, 1), b3 + hstep, voffB);
            PG8_WAIT_V(6); PG8_BAR; PG8_MMA(1, 1, At, B1); PG8_BAR;
            }
        }
        if constexpr (ALIGN_EPI) { if (wr == 0) PG8_BAR; }
        if constexpr (!Epi::AFTER_DRAIN) { E(acc, cur, wr, wc, fr, fq); S.done(cur); }
        if (!has_next) break;
#pragma unroll
        for (int a = 0; a < 2; ++a)
#pragma unroll
            for (int b = 0; b < 2; ++b)
#pragma unroll
                for (int m = 0; m < 4; ++m)
#pragma unroll
                    for (int n = 0; n < 2; ++n) acc[a][b][m][n] = (f32x4){0.f, 0.f, 0.f, 0.f};
        cur = nxt; cA = nA; cB = nB; ++ui;
        if constexpr (ALIGN_EPI) { if (wr == 1) PG8_BAR; }
    }
    PG8_WAIT_V(0);
    if constexpr (!ALIGN_EPI) { if (wr == 0) PG8_BAR; }
    PG8_BAR;
    if constexpr (Epi::AFTER_DRAIN) { E.fused(acc, cur, wr, wc, fr, fq, lds, wid, lane); S.done(cur); }
#undef PG8_SA
#undef PG8_SB
#undef PG8_STAGE
#undef PG8_LDA
#undef PG8_LDB
#undef PG8_MMA
#undef PG8_WAIT_V
#undef PG8_WAIT_L
#undef PG8_BAR
#undef PG8_SCHED
}
}
#define LAS __attribute__((address_space(3)))
typedef unsigned short bf16;
typedef unsigned v4u __attribute__((ext_vector_type(4)));
typedef unsigned v2u __attribute__((ext_vector_type(2)));
typedef float f32x4 __attribute__((ext_vector_type(4)));
typedef short bf16x8 __attribute__((ext_vector_type(8)));
typedef short s16x4 __attribute__((ext_vector_type(4)));
typedef float f32x16 __attribute__((ext_vector_type(16)));
constexpr int DM = 1024, NB = 8, SEQ = 4096, MTOK = NB * SEQ, NIN = 4616, NPROJ = 4608, PLE = 256;
constexpr int C_SBQ = 0, C_SBK = 512, C_SBV = 1024, C_SBZ = 1536, C_MLQ = 2048, C_MLK = 2560, C_MLV = 3072, C_MLO = 3584, C_MLZ = 4096;
constexpr float EPS = 1e-6f;
constexpr size_t MiB = 1u << 20;
constexpr size_t WS_WIN = 1 * MiB, WS_WOUT = 10 * MiB, WS_WGATE = 12 * MiB, WS_WUP = 14 * MiB, WS_GATES = 15 * MiB;
constexpr size_t WS_U = 16 * MiB;
constexpr size_t WS_PROJ = 80 * MiB;
constexpr size_t WS_PU = 368 * MiB, WS_PB = 432 * MiB, WS_QKC = 448 * MiB, WS_END = 512 * MiB;
constexpr int LDS_BYTES = 147456;

__device__ __forceinline__ unsigned f2bf(float f) { unsigned u = __builtin_bit_cast(unsigned, f); return (u + 0x7fffu + ((u >> 16) & 1u)) >> 16; }
__device__ __forceinline__ unsigned pk2(float lo, float hi) { return f2bf(lo) | (f2bf(hi) << 16); }
__device__ __forceinline__ float bflo(unsigned w) { return __builtin_bit_cast(float, w << 16); }
__device__ __forceinline__ float bfhi(unsigned w) { return __builtin_bit_cast(float, w & 0xffff0000u); }
__device__ __forceinline__ float bf1(bf16 v) { return __builtin_bit_cast(float, ((unsigned)v) << 16); }
__device__ __forceinline__ float wave_sum(float v) {
#pragma unroll
    for (int o = 1; o < 64; o <<= 1) v += __shfl_xor(v, o);
    return v;
}
__device__ __forceinline__ float sigmoidf_(float x) { return __builtin_amdgcn_rcpf(1.f + __expf(-x)); }
__device__ __forceinline__ float siluf_(float x) { return x * __builtin_amdgcn_rcpf(1.f + __expf(-x)); }
#define LDS_WAIT() asm volatile("s_waitcnt lgkmcnt(0)" ::: "memory")
#define LDS_BARRIER() do { asm volatile("s_waitcnt lgkmcnt(0)" ::: "memory"); __builtin_amdgcn_s_barrier(); asm volatile("" ::: "memory"); } while (0)

__device__ __forceinline__ void p0_transpose_item(const float* W, int K, int pitch, int nblk, bf16* WT, LAS float* scr, int item, int lane) {
    const int kb = item / nblk, nb = item % nblk, k0 = 64 * kb, n0 = 32 * nb;
    float tv[32];
#pragma unroll
    for (int i = 0; i < 32; ++i) tv[i] = __builtin_nontemporal_load(W + (size_t)(k0 + 2 * i + (lane >> 5)) * pitch + n0 + (lane & 31));
#pragma unroll
    for (int i = 0; i < 32; ++i) scr[(2 * i + (lane >> 5)) * 33 + (lane & 31)] = tv[i];
    LDS_WAIT(); asm volatile("" ::: "memory");
    const int c = lane & 7;
#pragma unroll
    for (int j = 0; j < 4; ++j) { const int n = (lane >> 3) + 8 * j; const LAS float* s = scr + (8 * c) * 33 + n;
        v4u o; o.x = pk2(s[0 * 33], s[1 * 33]); o.y = pk2(s[2 * 33], s[3 * 33]); o.z = pk2(s[4 * 33], s[5 * 33]); o.w = pk2(s[6 * 33], s[7 * 33]);
        *(v4u*)(WT + (size_t)(n0 + n) * K + k0 + 8 * c) = o; }
    LDS_WAIT(); asm volatile("" ::: "memory");
}

struct EpiGate {
    static constexpr bool PERM = true, AFTER_DRAIN = false;
    float* out; const bf16* pu; const float* bias; const bf16* hb;
    __device__ __forceinline__ void operator()(const pg8::f32x4 (&acc)[2][2][4][2], const pg8::Unit& u, int wr, int wc, int fr, int fq) const {
        const int row0 = u.pm * 256 + wr * 64 + fr, col0 = u.pn * 256 + wc * 32 + 8 * fq;
        f32x4 bv[2][2];
#pragma unroll
        for (int bj = 0; bj < 2; ++bj) { bv[bj][0] = *(const f32x4*)(bias + col0 + bj * 128); bv[bj][1] = *(const f32x4*)(bias + col0 + bj * 128 + 4); }
#pragma unroll
        for (int ai = 0; ai < 2; ++ai)
#pragma unroll
            for (int mp = 0; mp < 2; ++mp) {
                v4u hw[2][2], pw[2][2];
#pragma unroll
                for (int mm = 0; mm < 2; ++mm) { const size_t ro = (size_t)(row0 + ai * 128 + (2 * mp + mm) * 16) * DM;
#pragma unroll
                    for (int bj = 0; bj < 2; ++bj) { const int c = col0 + bj * 128; hw[mm][bj] = *(const v4u*)(hb + ro + c); pw[mm][bj] = *(const v4u*)(pu + ro + c); } }
#pragma unroll
                for (int mm = 0; mm < 2; ++mm) { const int m = 2 * mp + mm; const size_t ro = (size_t)(row0 + ai * 128 + m * 16) * DM;
#pragma unroll
                    for (int bj = 0; bj < 2; ++bj) { const int c = col0 + bj * 128;
                        const f32x4 v0 = acc[ai][bj][m][0] + bv[bj][0], v1 = acc[ai][bj][m][1] + bv[bj][1];
                        const v4u h = hw[mm][bj], q = pw[mm][bj];
                        f32x4 o0, o1;
                        o0[0] = bflo(h.x) + sigmoidf_(v0[0]) * bflo(q.x); o0[1] = bfhi(h.x) + sigmoidf_(v0[1]) * bfhi(q.x);
                        o0[2] = bflo(h.y) + sigmoidf_(v0[2]) * bflo(q.y); o0[3] = bfhi(h.y) + sigmoidf_(v0[3]) * bfhi(q.y);
                        o1[0] = bflo(h.z) + sigmoidf_(v1[0]) * bflo(q.z); o1[1] = bfhi(h.z) + sigmoidf_(v1[1]) * bfhi(q.z);
                        o1[2] = bflo(h.w) + sigmoidf_(v1[2]) * bflo(q.w); o1[3] = bfhi(h.w) + sigmoidf_(v1[3]) * bfhi(q.w);
                        __builtin_nontemporal_store(o0, (f32x4*)(out + ro + c)); __builtin_nontemporal_store(o1, (f32x4*)(out + ro + c + 4)); } }
            }
    }
};

constexpr size_t SLAB = (size_t)MTOK * 512;
__device__ __forceinline__ size_t sb_off(int T, int b, int h) { return (size_t)T * SLAB + (size_t)((b * 8 + h) * SEQ) * 64; }
__device__ __forceinline__ size_t ml_off(int T, int b, int h) { return (size_t)T * SLAB + (size_t)((b * 4 + h) * SEQ) * 128; }
struct EpiProj {
    static constexpr bool PERM = true, AFTER_DRAIN = false;
    bf16* O; float scale0;
    __device__ __forceinline__ void operator()(const pg8::f32x4 (&acc)[2][2][4][2], const pg8::Unit& u, int wr, int wc, int fr, int fq) const {
        const int row0 = u.pm * 256 + wr * 64 + fr, colt = u.pn * 256, T = colt >> 9;
        const float sc = T == 0 ? scale0 : 1.f;
#pragma unroll
        for (int bj = 0; bj < 2; ++bj) {
            const int cin = (colt + bj * 128 + wc * 32 + 8 * fq) & 511;
            const int HDl = T < 4 ? 6 : 7, h = cin >> HDl, cc = cin & ((1 << HDl) - 1), Hn = T < 4 ? 8 : 4;
#pragma unroll
            for (int ai = 0; ai < 2; ++ai)
#pragma unroll
                for (int m = 0; m < 4; ++m) { const int row = row0 + ai * 128 + m * 16, b = row >> 12, t = row & (SEQ - 1);
                    bf16* dst = O + (size_t)T * SLAB + (((size_t)(b * Hn + h) * SEQ + t) << HDl) + cc;
                    const pg8::f32x4 v0 = acc[ai][bj][m][0] * sc, v1 = acc[ai][bj][m][1] * sc;
                    v4u w; w.x = pg8::cvt_pk_bf16(v0[0], v0[1]); w.y = pg8::cvt_pk_bf16(v0[2], v0[3]); w.z = pg8::cvt_pk_bf16(v1[0], v1[1]); w.w = pg8::cvt_pk_bf16(v1[2], v1[3]);
                    __builtin_nontemporal_store(w, (v4u*)dst); }
        }
    }
};

struct ProjOrder : pg8::StaticOrder {
    __host__ __device__ bool next(int i, pg8::Unit& u) const {
        if (!pg8::StaticOrder::next(i, u)) return false;
        const int p = u.pn;
        u.pn = p < 2 ? 8 + p : (p < 6 ? 12 + p : (p < 10 ? 4 + p : p - 10));
        return true;
    }
};

__device__ __forceinline__ int xcd_vblk() { return (gridDim.x & 7) == 0 ? (int)(blockIdx.x & 7) * (int)(gridDim.x >> 3) + (int)(blockIdx.x >> 3) : (int)blockIdx.x; }

struct Args { const float* in[15]; float* out; unsigned char* ws; };
struct Ctx {
    LAS unsigned char* lds; int tid, lane, wave, gw, NGW;
    const float *x, *p, *pre_w, *w_in, *conv_w, *conv_b, *i_bias, *f_bias, *sb_w, *ml_w, *w_out, *post_w, *w_up, *w_gate, *b_gate;
    float* out; bf16 *WT_IN, *WT_OUT, *WT_GATE, *WT_UP, *U, *Y, *HB, *PROJ, *Y2, *PU, *PB, *QKC; float* GATES;
};

#ifdef PROBE_SUB
__device__ unsigned long long g_sub_ts[8];
#define SUBSTAMP(i) do { if (blockIdx.x == 0 && threadIdx.x == 0) g_sub_ts[i] = __builtin_amdgcn_s_memrealtime(); } while (0)
#else
#define SUBSTAMP(i) do { } while (0)
#endif
__device__ __forceinline__ void phase0(Ctx& F) {
    SUBSTAMP(3);
    LAS float* Wg = (LAS float*)F.lds;
    for (int e = F.tid; e < 1024 * 8; e += 512) Wg[e] = F.w_in[(size_t)(e >> 3) * NIN + NPROJ + (e & 7)];
    __syncthreads();
    SUBSTAMP(0);
    if (F.wave < 6) {
        f32x4 wga[16], wgb[16];
#pragma unroll
        for (int j = 0; j < 4; ++j)
#pragma unroll
            for (int e = 0; e < 4; ++e) { const LAS f32x4* wp = (const LAS f32x4*)(Wg + (512 * (j >> 1) + 8 * F.lane + 4 * (j & 1) + e) * 8); wga[4 * j + e] = wp[0]; wgb[4 * j + e] = wp[1]; }
        f32x4 pw[4];
#pragma unroll
        for (int j = 0; j < 4; ++j) pw[j] = *(const f32x4*)(F.pre_w + 512 * (j >> 1) + 8 * F.lane + 4 * (j & 1));
        const f32x4 ib = *(const f32x4*)F.i_bias, fb = *(const f32x4*)F.f_bias;
        f32x4 vn[4];
        const int nrw = (int)gridDim.x * 6, rwi = xcd_vblk() * 6 + F.wave;
        const int mbeg = (int)(((long)rwi * MTOK) / nrw), mend = (int)(((long)(rwi + 1) * MTOK) / nrw);
        { const float* xr = F.x + (size_t)mbeg * DM + 8 * F.lane;
#pragma unroll
          for (int j = 0; j < 4; ++j) vn[j] = __builtin_nontemporal_load((const f32x4*)(xr + 512 * (j >> 1) + 4 * (j & 1))); }
        const bool up32 = (F.lane & 32) != 0, up16 = (F.lane & 16) != 0, up8 = (F.lane & 8) != 0;
        const int gq = F.lane >> 3; const float bsel = gq < 4 ? ib[gq & 3] : fb[gq & 3];
        for (int m = mbeg; m < mend; ++m) {
            f32x4 v[4];
#pragma unroll
            for (int j = 0; j < 4; ++j) v[j] = vn[j];
            { const float* xr = F.x + (size_t)(m + 1 < mend ? m + 1 : m) * DM + 8 * F.lane;
#pragma unroll
                for (int j = 0; j < 4; ++j) vn[j] = __builtin_nontemporal_load((const f32x4*)(xr + 512 * (j >> 1) + 4 * (j & 1))); }
            __builtin_amdgcn_sched_barrier(0);
            float s = 0.f;
#pragma unroll
            for (int j = 0; j < 4; ++j) s += (v[j].x * v[j].x + v[j].y * v[j].y) + (v[j].z * v[j].z + v[j].w * v[j].w);
            f32x4 ga = (f32x4){0.f, 0.f, 0.f, 0.f}, gb = (f32x4){0.f, 0.f, 0.f, 0.f};
#pragma unroll
            for (int j = 0; j < 4; ++j) { const f32x4 xw = v[j] * pw[j];
#pragma unroll
                for (int e = 0; e < 4; ++e) { ga += wga[4 * j + e] * xw[e]; gb += wgb[4 * j + e] * xw[e]; } }
            s = wave_sum(s);
            const float rstd = 1.0f / sqrtf(s * (1.f / DM) + EPS);
            f32x4 g4;
#pragma unroll
            for (int i = 0; i < 4; ++i) { const float keep = up32 ? gb[i] : ga[i], send = up32 ? ga[i] : gb[i]; g4[i] = keep + __shfl_xor(send, 32); }
            const float k0 = up16 ? g4[2] : g4[0], s0 = up16 ? g4[0] : g4[2], k1 = up16 ? g4[3] : g4[1], s1 = up16 ? g4[1] : g4[3];
            const float g2a = k0 + __shfl_xor(s0, 16), g2b = k1 + __shfl_xor(s1, 16);
            const float kk = up8 ? g2b : g2a, sd = up8 ? g2a : g2b; float g1 = kk + __shfl_xor(sd, 8);
            g1 += __shfl_xor(g1, 4); g1 += __shfl_xor(g1, 2); g1 += __shfl_xor(g1, 1);
#pragma unroll
            for (int jj = 0; jj < 2; ++jj) { const f32x4 u0 = v[2 * jj] * rstd * pw[2 * jj], u1 = v[2 * jj + 1] * rstd * pw[2 * jj + 1];
                v4u o; o.x = pk2(u0.x, u0.y); o.y = pk2(u0.z, u0.w); o.z = pk2(u1.x, u1.y); o.w = pk2(u1.z, u1.w);
                *(v4u*)(F.U + (size_t)m * DM + 512 * jj + 8 * F.lane) = o; }
            const float pre = g1 * rstd + bsel;
            const float lsg = fminf(pre, 0.f) - 0.6931471805599453f * __builtin_amdgcn_logf(1.f + __builtin_amdgcn_exp2f(-fabsf(pre) * 1.4426950408889634f));
            if ((F.lane & 7) == 0) F.GATES[(size_t)m * 8 + gq] = gq < 4 ? pre : lsg;
        }
    } else {
        const int ow = (int)blockIdx.x * 2 + (F.wave - 6), now = (int)gridDim.x * 2;
        LAS float* scr = (LAS float*)(F.lds + F.wave * 16384);
        constexpr int I_IN = 16 * 144, I_O = 16 * 32, I_G = 16 * 32, I_U = 4 * 32, NIT = I_IN + I_O + I_G + I_U;
        for (int it = ow; it < NIT; it += now) {
            int r = it;
            if (r < I_IN) { p0_transpose_item(F.w_in, DM, NIN, 144, F.WT_IN, scr, r, F.lane); continue; } r -= I_IN;
            if (r < I_O) { p0_transpose_item(F.w_out, DM, DM, 32, F.WT_OUT, scr, r, F.lane); continue; } r -= I_O;
            if (r < I_G) { p0_transpose_item(F.w_gate, DM, DM, 32, F.WT_GATE, scr, r, F.lane); continue; } r -= I_G;
            p0_transpose_item(F.w_up, PLE, DM, 32, F.WT_UP, scr, r, F.lane);
        }
        const size_t NT8 = (size_t)MTOK * PLE / 8, stride = (size_t)now * 64;
        for (size_t i0 = (size_t)ow * 64 + F.lane; i0 < NT8; i0 += 4 * stride) {
            f32x4 a[4], b[4];
#pragma unroll
            for (int k = 0; k < 4; ++k) { const size_t i = i0 + k * stride; if (i < NT8) { a[k] = __builtin_nontemporal_load((const f32x4*)(F.p + i * 8)); b[k] = __builtin_nontemporal_load((const f32x4*)(F.p + i * 8 + 4)); } }
#pragma unroll
            for (int k = 0; k < 4; ++k) { const size_t i = i0 + k * stride; if (i < NT8) { v4u o; o.x = pk2(a[k].x, a[k].y); o.y = pk2(a[k].z, a[k].w); o.z = pk2(b[k].x, b[k].y); o.w = pk2(b[k].z, b[k].w); *(v4u*)(F.PB + i * 8) = o; } }
        }
    }
    SUBSTAMP(1);
    SUBSTAMP(2);
}

__device__ __forceinline__ void phase_conv(Ctx& F) {
    const size_t NITEM = (size_t)MTOK * 128;
    for (size_t it = (size_t)blockIdx.x * 512 + F.tid; it < NITEM; it += (size_t)gridDim.x * 512) {
        const int row = (int)(it >> 7), c0 = (int)(it & 127) * 8, t = row & (SEQ - 1);
        float acc[8];
#pragma unroll
        for (int e = 0; e < 8; ++e) acc[e] = F.conv_b[c0 + e];
#pragma unroll
        for (int j = 0; j < 4; ++j) {
            if (t - 3 + j < 0) continue;
            const v4u r = *(const v4u*)(F.PROJ + (size_t)(row - 3 + j) * NPROJ + C_MLQ + c0);
            const f32x4 w0 = *(const f32x4*)(F.conv_w + j * 1024 + c0), w1 = *(const f32x4*)(F.conv_w + j * 1024 + c0 + 4);
            acc[0] += w0.x * bflo(r.x); acc[1] += w0.y * bfhi(r.x); acc[2] += w0.z * bflo(r.y); acc[3] += w0.w * bfhi(r.y);
            acc[4] += w1.x * bflo(r.z); acc[5] += w1.y * bfhi(r.z); acc[6] += w1.z * bflo(r.w); acc[7] += w1.w * bfhi(r.w);
        }
        const float sc = c0 >= 512 ? 0.08838834764831845f : 1.0f;
#pragma unroll
        for (int e = 0; e < 8; ++e) acc[e] = siluf_(acc[e]) * sc;
        v4u o; o.x = pk2(acc[0], acc[1]); o.y = pk2(acc[2], acc[3]); o.z = pk2(acc[4], acc[5]); o.w = pk2(acc[6], acc[7]);
        *(v4u*)(F.QKC + (size_t)row * 1024 + c0) = o;
    }
}

__device__ __forceinline__ void phase_norm(Ctx& F) {
    f32x4 pw[4];
#pragma unroll
    for (int j = 0; j < 2; ++j) { pw[2 * j] = *(const f32x4*)(F.post_w + 512 * j + 8 * F.lane); pw[2 * j + 1] = *(const f32x4*)(F.post_w + 512 * j + 8 * F.lane + 4); }
    v4u yn[2]; f32x4 xn[4];
#define NLOAD(m_) do { const v4u* yr_ = (const v4u*)(F.Y2 + (size_t)(m_) * DM) + F.lane; yn[0] = yr_[0]; yn[1] = yr_[64]; \
        const float* xp_ = F.x + (size_t)(m_) * DM + 8 * F.lane; xn[0] = __builtin_nontemporal_load((const f32x4*)xp_); xn[1] = __builtin_nontemporal_load((const f32x4*)(xp_ + 4)); xn[2] = __builtin_nontemporal_load((const f32x4*)(xp_ + 512)); xn[3] = __builtin_nontemporal_load((const f32x4*)(xp_ + 516)); } while (0)
    const int RPW4 = MTOK / F.NGW, m0 = (xcd_vblk() * 8 + F.wave) * RPW4, m1 = m0 + RPW4;
    NLOAD(m0);
    for (int m = m0; m < m1; ++m) {
        v4u yc[2] = {yn[0], yn[1]}; f32x4 xc[4] = {xn[0], xn[1], xn[2], xn[3]};
        NLOAD(m + 1 < m1 ? m + 1 : m);
        __builtin_amdgcn_sched_barrier(0);
        float y[16]; float s = 0.f;
#pragma unroll
        for (int j = 0; j < 2; ++j) { const v4u r = yc[j];
            y[8 * j + 0] = bflo(r.x); y[8 * j + 1] = bfhi(r.x); y[8 * j + 2] = bflo(r.y); y[8 * j + 3] = bfhi(r.y);
            y[8 * j + 4] = bflo(r.z); y[8 * j + 5] = bfhi(r.z); y[8 * j + 6] = bflo(r.w); y[8 * j + 7] = bfhi(r.w); }
#pragma unroll
        for (int e = 0; e < 16; ++e) s += y[e] * y[e];
        const float rstd = 1.0f / sqrtf(wave_sum(s) * (1.f / DM) + EPS);
#pragma unroll
        for (int j = 0; j < 2; ++j) {
            const int c = 512 * j + 8 * F.lane; const size_t o = (size_t)m * DM + c;
            f32x4 h0, h1;
#pragma unroll
            for (int e = 0; e < 4; ++e) { h0[e] = xc[2 * j][e] + y[8 * j + e] * rstd * pw[2 * j][e]; h1[e] = xc[2 * j + 1][e] + y[8 * j + 4 + e] * rstd * pw[2 * j + 1][e]; }
            v4u hb; hb.x = pk2(h0[0], h0[1]); hb.y = pk2(h0[2], h0[3]); hb.z = pk2(h1[0], h1[1]); hb.w = pk2(h1[2], h1[3]);
            *(v4u*)(F.HB + o) = hb;
        }
    }
#undef NLOAD
}
#define XB_TMO      128
#define XB_XCNT(j)  (256  + 64 * (j))
#define XB_XSUB(j)  (1280 + 64 * (j))
#define XB_XGEN(j)  (2304 + 64 * (j))
#define XB_TOP      3328
#define XB_TOPGEN   3392
#define XCD_BAR_WORDS 3456
#define XB_SPIN_CAP (1u << 18)

__device__ __forceinline__ unsigned xb_ld(unsigned* p)              { return __hip_atomic_load(p, __ATOMIC_RELAXED, __HIP_MEMORY_SCOPE_AGENT); }
__device__ __forceinline__ unsigned xb_add(unsigned* p, unsigned v) { return __hip_atomic_fetch_add(p, v, __ATOMIC_RELAXED, __HIP_MEMORY_SCOPE_AGENT); }
__device__ __forceinline__ unsigned xb_xcc_id() { return (unsigned)__builtin_amdgcn_s_getreg((3 << 11) | 20) & 0xFu; }
#define XB_SPIN(cond, bar) do { unsigned _sp = 0; while (cond) { __builtin_amdgcn_s_sleep(1); \
    if ((++_sp & 255u) == 0u) { if (xb_ld(&(bar)[XB_TMO])) break; if (_sp > XB_SPIN_CAP) { atomicAdd(&(bar)[XB_TMO], 1u); break; } } } } while (0)

struct XcdBarrier {
    unsigned* bar; unsigned x;
    volatile LAS unsigned* st;
};

__device__ __forceinline__ XcdBarrier xcd_barrier_post(unsigned* bar, volatile LAS unsigned* st) {
    XcdBarrier b; b.bar = bar; b.x = xb_xcc_id(); b.st = st;
    if (threadIdx.x == 0) (void)xb_add(&bar[XB_XCNT(b.x)], 1u);
    return b;
}
__device__ __forceinline__ void xcd_barrier_complete(unsigned* bar, unsigned x, unsigned& nloc, unsigned& nx) {
    const unsigned G = gridDim.x * gridDim.y * gridDim.z;
    unsigned sum, cnt, mine, sp = 0u;
    for (;;) {
        sum = 0u; cnt = 0u; mine = 0u;
#pragma unroll
        for (unsigned j = 0; j < 16; ++j) { const unsigned c = xb_ld(&bar[XB_XCNT(j)]); sum += c; cnt += (c > 0u) ? 1u : 0u; mine = (j == x) ? c : mine; }
        if (sum == G) break;
        __builtin_amdgcn_s_sleep(1);
        if ((++sp & 255u) == 0u) { if (xb_ld(&bar[XB_TMO])) break; if (sp > XB_SPIN_CAP) { atomicAdd(&bar[XB_TMO], 1u); break; } }
    }
    nloc = mine > 0u ? mine : 1u; nx = cnt > 0u ? cnt : 1u;
}

__device__ __forceinline__ void xcd_barrier(const XcdBarrier& b) {
    asm volatile("s_waitcnt vmcnt(0)" ::: "memory");
    __syncthreads();
    if (threadIdx.x == 0) {
        unsigned* bar = b.bar;
        __builtin_amdgcn_s_waitcnt(0);
        unsigned nloc = b.st[0], nx = b.st[1];
        if (nloc == 0u) { xcd_barrier_complete(bar, b.x, nloc, nx); b.st[0] = nloc; b.st[1] = nx; }
        const unsigned old = xb_add(&bar[XB_XSUB(b.x)], 1u);
        const unsigned gen = old / nloc;
        if (old + 1u == (gen + 1u) * nloc) {
            __builtin_amdgcn_fence(__ATOMIC_RELEASE, "agent");
            asm volatile("s_waitcnt vmcnt(0)" ::: "memory");
            const unsigned og = xb_add(&bar[XB_TOP], 1u);
            const unsigned tg = og / nx;
            if (og + 1u == (tg + 1u) * nx) xb_add(&bar[XB_TOPGEN], 1u);
            else XB_SPIN(xb_ld(&bar[XB_TOPGEN]) == tg, bar);
            __builtin_amdgcn_fence(__ATOMIC_ACQUIRE, "agent");
            xb_add(&bar[XB_XGEN(b.x)], 1u);
            asm volatile("s_waitcnt vmcnt(0)" ::: "memory");
        } else {
            XB_SPIN(xb_ld(&bar[XB_XGEN(b.x)]) == gen, bar);
            __builtin_amdgcn_fence(__ATOMIC_ACQUIRE, "agent");
            asm volatile("s_waitcnt vmcnt(0)" ::: "memory");
        }
    }
    __syncthreads();
}

typedef short v4i16_t __attribute__((ext_vector_type(4)));
typedef float f32x2_t __attribute__((ext_vector_type(2)));
typedef __bf16 bf16x2_t __attribute__((ext_vector_type(2)));
__device__ __forceinline__ unsigned cvtpk(float lo, float hi) { f32x2_t v = {lo, hi}; bf16x2_t b = __builtin_convertvector(v, bf16x2_t); return __builtin_bit_cast(unsigned, b); }
__device__ __forceinline__ s16x4 vtr(const LAS unsigned char* p) { return __builtin_bit_cast(s16x4, __builtin_amdgcn_ds_read_tr16_b64_v4i16((LAS v4i16_t*)p)); }
__device__ __forceinline__ bf16x8 pack8(const f32x16& x, int s) {
    v4u p; p.x = cvtpk(x[8 * s + 0], x[8 * s + 1]); p.y = cvtpk(x[8 * s + 2], x[8 * s + 3]); p.z = cvtpk(x[8 * s + 4], x[8 * s + 5]); p.w = cvtpk(x[8 * s + 6], x[8 * s + 7]);
    return __builtin_bit_cast(bf16x8, p);
}
template <bool MASK> __device__ __forceinline__ void sb_half(f32x16& p, float& R, int kbase, int t, int hi) {
    float lk[16];
#pragma unroll
    for (int i = 0; i < 16; ++i) {
        const float z = p[i];
        float v = -(fmaxf(z, 0.f) + __builtin_amdgcn_logf(1.f + __builtin_amdgcn_exp2f(-fabsf(z))));
        if (MASK) { const int key = kbase + (i & 3) + 8 * (i >> 2); v = key < t ? v : 0.f; }
        lk[i] = v;
    }
#pragma unroll
    for (int g = 0; g < 4; ++g) { lk[4 * g + 2] += lk[4 * g + 3]; lk[4 * g + 1] += lk[4 * g + 2]; lk[4 * g] += lk[4 * g + 1]; }
    float Glo[4], Ghi[4];
#pragma unroll
    for (int g = 0; g < 4; ++g) {
        const unsigned xb = __float_as_uint(lk[4 * g]); const auto rr = __builtin_amdgcn_permlane32_swap(xb, xb, false, false);
        Glo[g] = __uint_as_float(rr[0]); Ghi[g] = __uint_as_float(rr[1]); }
    float acc = R;
#pragma unroll
    for (int g = 3; g >= 0; --g) {
        const float off1 = acc, off0 = acc + Ghi[g]; acc = off0 + Glo[g];
        const float off = hi ? off1 : off0;
#pragma unroll
        for (int e = 0; e < 4; ++e) { const int i = 4 * g + e;
            float a = __builtin_amdgcn_exp2f(p[i] + (lk[i] + off));
            if (MASK) { const int key = kbase + (i & 3) + 8 * (i >> 2); a = key < t ? a : 0.f; }
            p[i] = a; }
    }
    R = acc;
}
__device__ __forceinline__ void attn_fast(Ctx& F, unsigned* ctr) {
    constexpr int VP = 144;
    LAS unsigned char* vt = F.lds + F.wave * 16384;
    int lane_ = F.lane; asm volatile("" : "+v"(lane_));
    const int lane = lane_, r32 = lane & 31, hi = lane >> 5;
    const int i16 = lane & 15, tq = i16 >> 2, tp = i16 & 3, blk = (lane >> 4) & 1;
    const int troff = (4 * hi + tq) * VP + (16 * blk + 4 * tp) * 2;
    const int vblk = (gridDim.x & 7) == 0 ? (int)(blockIdx.x & 7) * (int)(gridDim.x >> 3) + (int)(blockIdx.x >> 3) : (int)blockIdx.x;
    constexpr int NU = NB * 8 * (SEQ / 32);
#define LOAD_KV(KF, VR, KB_, VB_, k0_) do { const bf16* kp_ = (KB_) + (size_t)((k0_) + r32) * 64 + 8 * hi; \
            _Pragma("unroll") for (int hh = 0; hh < 2; ++hh) _Pragma("unroll") for (int d0 = 0; d0 < 4; ++d0) KF[hh][d0] = *(const bf16x8*)(kp_ + hh * 32 * 64 + 16 * d0); \
            const bf16* vp_ = (VB_) + (size_t)(k0_) * 64 + 8 * lane; \
            _Pragma("unroll") for (int i = 0; i < 8; ++i) VR[i] = *(const v4u*)(vp_ + 512 * i); } while (0)
#define LOAD_Q(QB_, t_) do { const bf16* qp_ = (QB_) + (size_t)(t_) * 64 + 8 * hi; _Pragma("unroll") for (int d0 = 0; d0 < 4; ++d0) qr[d0] = *(const bf16x8*)(qp_ + 16 * d0); } while (0)
    bf16x8 qr[4]; bf16x8 kf[2][4]; v4u vr[8];
    int unit = vblk * 8 + F.wave;
    if (unit < NU) {
        const int bh = unit >> 7, qb = unit & 127, b = bh >> 3, h = bh & 7, q0 = 32 * qb;
        LOAD_Q(F.PROJ + sb_off(0, b, h), q0 + r32);
        LOAD_KV(kf, vr, F.PROJ + sb_off(1, b, h), F.PROJ + sb_off(2, b, h), 64 * ((q0 + 31) >> 6));
    }
    while (unit < NU) {
        const int bh = unit >> 7, qb = unit & 127, b = bh >> 3, h = bh & 7, q0 = 32 * qb, t = q0 + r32;
        const bf16* kbase = F.PROJ + sb_off(1, b, h); const bf16* vbase = F.PROJ + sb_off(2, b, h); const bf16* zbase = F.PROJ + sb_off(3, b, h);
        const int kt = (q0 + 31) >> 6;
        f32x16 o[2];
#pragma unroll
        for (int i = 0; i < 16; ++i) { o[0][i] = 0.f; o[1][i] = 0.f; }
        float R = 0.f;
        for (int it = kt; it >= 0; --it) {
            const int k0 = 64 * it;
            asm volatile("" ::: "memory");
#pragma unroll
            for (int i = 0; i < 8; ++i) *(LAS v4u*)(vt + (8 * i + (lane >> 3)) * VP + 16 * (lane & 7)) = vr[i];
            asm volatile("" ::: "memory");
            bf16x8 kc[2][4];
#pragma unroll
            for (int hh = 0; hh < 2; ++hh)
#pragma unroll
                for (int d0 = 0; d0 < 4; ++d0) kc[hh][d0] = kf[hh][d0];
            if (it > 0) LOAD_KV(kf, vr, kbase, vbase, k0 - 64);
            const bool first = (it == kt);
            const bool do_hi = !first || (k0 + 32 <= q0 + 30);
            f32x16 p0, p1;
#pragma unroll
            for (int i = 0; i < 16; ++i) { p0[i] = 0.f; p1[i] = 0.f; }
#pragma unroll
            for (int d0 = 0; d0 < 4; ++d0) p0 = __builtin_amdgcn_mfma_f32_32x32x16_bf16(kc[0][d0], qr[d0], p0, 0, 0, 0);
            if (do_hi) {
#pragma unroll
                for (int d0 = 0; d0 < 4; ++d0) p1 = __builtin_amdgcn_mfma_f32_32x32x16_bf16(kc[1][d0], qr[d0], p1, 0, 0, 0);
                if (first) sb_half<true>(p1, R, k0 + 32 + 4 * hi, t, hi); else sb_half<false>(p1, R, k0 + 32 + 4 * hi, t, hi);
            }
            const bool do_lo = !(do_hi && __all(R < -151.f));
            if (do_lo) { if (first) sb_half<true>(p0, R, k0 + 4 * hi, t, hi); else sb_half<false>(p0, R, k0 + 4 * hi, t, hi); }
#pragma unroll
            for (int hh = 1; hh >= 0; --hh) {
                if (hh == 1 && !do_hi) continue;
                if (hh == 0 && !do_lo) continue;
#pragma unroll
                for (int s = 0; s < 2; ++s) {
                    const bf16x8 pa = pack8(hh ? p1 : p0, s);
#pragma unroll
                    for (int dh = 0; dh < 2; ++dh) {
                        const LAS unsigned char* vb = vt + troff + (32 * hh + 16 * s) * VP + 64 * dh;
                        const s16x4 lo = vtr(vb), hi4 = vtr(vb + 8 * VP);
                        const bf16x8 vf = {lo[0], lo[1], lo[2], lo[3], hi4[0], hi4[1], hi4[2], hi4[3]};
                        o[dh] = __builtin_amdgcn_mfma_f32_32x32x16_bf16(pa, vf, o[dh], 0, 0, 0);
                    }
                }
            }
            if (!do_lo || __all(R < -151.f)) break;
        }
        asm volatile("" ::: "memory");
        LAS float* os = (LAS float*)vt;
#pragma unroll
        for (int dh = 0; dh < 2; ++dh)
#pragma unroll
            for (int i = 0; i < 16; ++i) os[((i & 3) + 8 * (i >> 2) + 4 * hi) * 65 + 32 * dh + r32] = o[dh][i];
        asm volatile("" ::: "memory");
        const int q = lane >> 1, hf = lane & 1;
        v4u zr4[4];
#pragma unroll
        for (int c = 0; c < 4; ++c) zr4[c] = *(const v4u*)(zbase + (size_t)(q0 + q) * 64 + 32 * hf + 8 * c);
        const int nunit = unit + F.NGW;
        if (nunit < NU) {
            const int nbh = nunit >> 7, nqb = nunit & 127, nb = nbh >> 3, nh = nbh & 7, nq0 = 32 * nqb;
            LOAD_Q(F.PROJ + sb_off(0, nb, nh), nq0 + r32);
            LOAD_KV(kf, vr, F.PROJ + sb_off(1, nb, nh), F.PROJ + sb_off(2, nb, nh), 64 * ((nq0 + 31) >> 6));
        }
        float ov[32]; float ss = 0.f;
#pragma unroll
        for (int e = 0; e < 32; ++e) { ov[e] = os[q * 65 + 32 * hf + e]; ss += ov[e] * ov[e]; }
        ss += __shfl_xor(ss, 1);
        const float rstd = 1.0f / sqrtf(ss * (1.f / 64.f) + EPS);
        const size_t row = (size_t)b * SEQ + q0 + q;
        const int c0 = h * 64 + 32 * hf;
#pragma unroll
        for (int c = 0; c < 4; ++c) {
            const v4u zr = zr4[c];
            const f32x4 w0 = *(const f32x4*)(F.sb_w + c0 + 8 * c), w1 = *(const f32x4*)(F.sb_w + c0 + 8 * c + 4);
            v4u w;
            w.x = pk2(ov[8 * c + 0] * rstd * w0.x * siluf_(bflo(zr.x)), ov[8 * c + 1] * rstd * w0.y * siluf_(bfhi(zr.x)));
            w.y = pk2(ov[8 * c + 2] * rstd * w0.z * siluf_(bflo(zr.y)), ov[8 * c + 3] * rstd * w0.w * siluf_(bfhi(zr.y)));
            w.z = pk2(ov[8 * c + 4] * rstd * w1.x * siluf_(bflo(zr.z)), ov[8 * c + 5] * rstd * w1.y * siluf_(bfhi(zr.z)));
            w.w = pk2(ov[8 * c + 6] * rstd * w1.z * siluf_(bflo(zr.w)), ov[8 * c + 7] * rstd * w1.w * siluf_(bfhi(zr.w)));
            *(v4u*)(F.Y + row * DM + c0 + 8 * c) = w;
        }
        asm volatile("" ::: "memory");
        unit = nunit;
    }
#undef LOAD_KV
#undef LOAD_Q
}
__device__ __forceinline__ void attn32k(Ctx& F) {
    constexpr int VP = 144;
    LAS unsigned char* vt = F.lds + F.wave * 16384;
    int lane_ = F.lane; asm volatile("" : "+v"(lane_));
    const int lane = lane_, r32 = lane & 31, hi = lane >> 5;
    const int i16 = lane & 15, tq = i16 >> 2, tp = i16 & 3, blk = (lane >> 4) & 1;
    const int troff = (4 * hi + tq) * VP + (16 * blk + 4 * tp) * 2;
    const int vblk = (gridDim.x & 7) == 0 ? (int)(blockIdx.x & 7) * (int)(gridDim.x >> 3) + (int)(blockIdx.x >> 3) : (int)blockIdx.x;
    constexpr int NU = NB * 8 * (SEQ / 32);
#define A32_LOAD(KF, VR, s_) do { const bf16* kp_ = kbase + (size_t)(32 * (s_)) * 64 + 8 * lane; \
        _Pragma("unroll") for (int i = 0; i < 4; ++i) KF[i] = *(const bf16x8*)(kp_ + 512 * i);     \
        const bf16* vp_ = vbase + (size_t)(32 * (s_)) * 64 + 8 * lane; \
        _Pragma("unroll") for (int i = 0; i < 4; ++i) VR[i] = *(const v4u*)(vp_ + 512 * i); } while (0)
#define A32_STEP(KF, VR, s_, MASKED) do { \
        asm volatile("" ::: "memory"); \
        _Pragma("unroll") for (int i = 0; i < 4; ++i) { *(LAS v4u*)(vt + (8 * i + (lane >> 3)) * VP + 16 * (lane & 7)) = VR[i]; \
            *(LAS bf16x8*)(vt + 4608 + (8 * i + (lane >> 3)) * VP + 16 * (lane & 7)) = KF[i]; } \
        asm volatile("" ::: "memory"); \
        f32x16 p; _Pragma("unroll") for (int i = 0; i < 16; ++i) p[i] = 0.f; \
        _Pragma("unroll") for (int d0 = 0; d0 < 4; ++d0) { const bf16x8 kfr = *(const LAS bf16x8*)(vt + 4608 + r32 * VP + 32 * d0 + 16 * hi); \
            p = __builtin_amdgcn_mfma_f32_32x32x16_bf16(kfr, qr[d0], p, 0, 0, 0); } \
        asm volatile("" ::: "memory"); \
        A32_LOAD(KF, VR, ((s_) >= 2 ? (s_) - 2 : 0));     \
        if (MASKED) sb_half<true>(p, R, 32 * (s_) + 4 * hi, t, hi); else sb_half<false>(p, R, 32 * (s_) + 4 * hi, t, hi); \
        _Pragma("unroll") for (int ks = 0; ks < 2; ++ks) { const bf16x8 pa = pack8(p, ks); \
            _Pragma("unroll") for (int dh = 0; dh < 2; ++dh) { const LAS unsigned char* vb = vt + troff + (16 * ks) * VP + 64 * dh; \
                const s16x4 lo = vtr(vb), hi4 = vtr(vb + 8 * VP); const bf16x8 vf = {lo[0], lo[1], lo[2], lo[3], hi4[0], hi4[1], hi4[2], hi4[3]}; \
                o[dh] = __builtin_amdgcn_mfma_f32_32x32x16_bf16(pa, vf, o[dh], 0, 0, 0); } } } while (0)
    const bool aligned = gridDim.x == 256;
    const int ubase = aligned ? (vblk >> 5) * 1024 + (vblk & 31) * 8 + F.wave : vblk * 8 + F.wave, ustep = aligned ? 256 : F.NGW, uend = aligned ? (vblk >> 5) * 1024 + 1024 : NU;
    for (int unit = ubase; unit < uend; unit += ustep) {
        const int bh = unit >> 7, qb = unit & 127, b = bh >> 3, h = bh & 7, q0 = 32 * qb, t = q0 + r32;
        const bf16* qbase = F.PROJ + sb_off(0, b, h); const bf16* kbase = F.PROJ + sb_off(1, b, h); const bf16* vbase = F.PROJ + sb_off(2, b, h); const bf16* zbase = F.PROJ + sb_off(3, b, h);
        bf16x8 qr[4], kfA[4], kfB[4]; v4u vrA[4], vrB[4];
        { const bf16* qp = qbase + (size_t)t * 64 + 8 * hi;
#pragma unroll
          for (int d0 = 0; d0 < 4; ++d0) qr[d0] = *(const bf16x8*)(qp + 16 * d0); }
        A32_LOAD(kfA, vrA, qb);
        A32_LOAD(kfB, vrB, (qb >= 1 ? qb - 1 : 0));
        f32x16 o[2];
#pragma unroll
        for (int i = 0; i < 16; ++i) { o[0][i] = 0.f; o[1][i] = 0.f; }
        float R = 0.f;
        A32_STEP(kfA, vrA, qb, true);
        for (int s = qb - 1; s >= 0; s -= 2) {
            if (__all(R < -151.f)) break;
            A32_STEP(kfB, vrB, s, false);
            if (s == 0 || __all(R < -151.f)) break;
            A32_STEP(kfA, vrA, s - 1, false);
        }
        asm volatile("" ::: "memory");
        LAS float* os = (LAS float*)vt;
#pragma unroll
        for (int dh = 0; dh < 2; ++dh)
#pragma unroll
            for (int i = 0; i < 16; ++i) os[((i & 3) + 8 * (i >> 2) + 4 * hi) * 65 + 32 * dh + r32] = o[dh][i];
        asm volatile("" ::: "memory");
        const int q = lane >> 1, hf = lane & 1;
        float ov[32]; float ss = 0.f;
#pragma unroll
        for (int e = 0; e < 32; ++e) { ov[e] = os[q * 65 + 32 * hf + e]; ss += ov[e] * ov[e]; }
        ss += __shfl_xor(ss, 1);
        const float rstd = 1.0f / sqrtf(ss * (1.f / 64.f) + EPS);
        const size_t row = (size_t)b * SEQ + q0 + q;
        const int c0 = h * 64 + 32 * hf;
#pragma unroll
        for (int c = 0; c < 4; ++c) {
            const v4u zr = *(const v4u*)(zbase + (size_t)(q0 + q) * 64 + 32 * hf + 8 * c);
            const f32x4 w0 = *(const f32x4*)(F.sb_w + c0 + 8 * c), w1 = *(const f32x4*)(F.sb_w + c0 + 8 * c + 4);
            v4u w;
            w.x = pk2(ov[8 * c + 0] * rstd * w0.x * siluf_(bflo(zr.x)), ov[8 * c + 1] * rstd * w0.y * siluf_(bfhi(zr.x)));
            w.y = pk2(ov[8 * c + 2] * rstd * w0.z * siluf_(bflo(zr.y)), ov[8 * c + 3] * rstd * w0.w * siluf_(bfhi(zr.y)));
            w.z = pk2(ov[8 * c + 4] * rstd * w1.x * siluf_(bflo(zr.z)), ov[8 * c + 5] * rstd * w1.y * siluf_(bfhi(zr.z)));
            w.w = pk2(ov[8 * c + 6] * rstd * w1.z * siluf_(bflo(zr.w)), ov[8 * c + 7] * rstd * w1.w * siluf_(bfhi(zr.w)));
            *(v4u*)(F.Y + row * DM + c0 + 8 * c) = w;
        }
        asm volatile("" ::: "memory");
    }
#undef A32_LOAD
#undef A32_STEP
}
constexpr int SL_N = 16384, SL_SC = 16512, SL_STRIDE = 16640;
__device__ __forceinline__ v4u scale8(v4u r, float s) {
    v4u o; o.x = cvtpk(bflo(r.x) * s, bfhi(r.x) * s); o.y = cvtpk(bflo(r.y) * s, bfhi(r.y) * s); o.z = cvtpk(bflo(r.z) * s, bfhi(r.z) * s); o.w = cvtpk(bflo(r.w) * s, bfhi(r.w) * s); return o;
}
template <int PASS> __device__ __forceinline__ void mlstm_fast(Ctx& F, float* SLOC) {
    constexpr int PT = 272, SP = 144, HP = 129;
    constexpr int L_Q = 0, L_K = 17408, L_V = 34816, L_VW = 52224, L_S = 69632, L_H = 78848, L_SC = 111872;
    constexpr int L_RAWQ = L_S, L_RAWK = L_S + 17408;
    constexpr int L_HALO = L_SC + 1024, L_CW = L_HALO + 3072;
    static_assert(L_RAWK + 17408 <= L_SC && L_CW + 5120 + 6144 <= 131072, "mLSTM LDS map");
    LAS unsigned char* L = F.lds;
    LAS float* su = (LAS float*)(L + L_SC); LAS float* sM = su + 64; LAS float* sb = su + 128; LAS bf16* swb = (LAS bf16*)(su + 192);
    LAS float* Hs = (LAS float*)(L + L_H);
    const int nunits = PASS == 1 ? NB * 4 * 7 : NB * 4 * 8;
    for (int unit = xcd_vblk(); unit < nunits; unit += gridDim.x) {
        int tid_ = F.tid; asm volatile("" : "+v"(tid_));
        const int tid = tid_, lane = tid & 63, w = __builtin_amdgcn_readfirstlane(tid >> 6), fr = lane & 15, fq = lane >> 4, tq = fr >> 2, tp = fr & 3;
        const int srow = tid >> 3, sc8 = tid & 7, v0 = 16 * w;
        int bh, seg; if (PASS == 1) { bh = unit / 7; seg = unit % 7; } else { bh = unit >> 3; seg = unit & 7; }
        const int b = bh >> 2, h = bh & 3;
        const size_t row0 = (size_t)b * SEQ + (size_t)seg * 512;
        f32x4 X[8], Xn[8];
#pragma unroll
        for (int t = 0; t < 8; ++t) { X[t] = (f32x4){0.f, 0.f, 0.f, 0.f}; Xn[t] = (f32x4){0.f, 0.f, 0.f, 0.f}; }
        float m_prev = PASS == 1 ? -1e30f : 0.f, bsum = 0.f;
        if (PASS == 2) {
            for (int j = 0; j < seg; ++j) {
                const float* S = SLOC + (size_t)(bh * 7 + j) * SL_STRIDE;
                const float mloc = S[SL_SC], Bs = S[SL_SC + 1];
                const float m_new = fmaxf(Bs + m_prev, mloc), fa = __expf(Bs + m_prev - m_new), fg = __expf(mloc - m_new);
#pragma unroll
                for (int t = 0; t < 8; ++t) { const f32x4 cl = *(const f32x4*)(S + (size_t)(t * 512 + tid) * 4); X[t] = X[t] * fa + cl * fg;
                    const f32x4 nl = *(const f32x4*)(S + SL_N + 16 * t + 4 * fq); Xn[t] = Xn[t] * fa + nl * fg; }
                m_prev = m_new;
            }
        }
        LDS_BARRIER();
        { LAS float* gsc = (LAS float*)(L + L_CW + 5120);
          const float* gg = F.GATES + (row0 + tid) * 8; const float ig0 = gg[h]; float bc0 = gg[4 + h];
#pragma unroll
          for (int o = 1; o < 64; o <<= 1) { const float t_ = __shfl_up(bc0, o); if (lane >= o) bc0 += t_; }
          const float u0 = ig0 - bc0; float pm0 = u0;
#pragma unroll
          for (int o = 1; o < 64; o <<= 1) { const float t_ = __shfl_up(pm0, o); if (lane >= o) pm0 = fmaxf(pm0, t_); }
          gsc[tid] = bc0; gsc[512 + tid] = u0; gsc[1024 + tid] = pm0; }
        { int tu = tid; asm volatile("" : "+v"(tu));
          LAS float* cw = (LAS float*)(L + L_CW);
          for (int e = tu; e < 1280; e += 512) { float val;
              if (e < 1024) { const int tn = e >> 9, j = (e >> 7) & 3, cch = e & 127; val = F.conv_w[j * 1024 + tn * 512 + h * 128 + cch]; }
              else { const int tn = (e - 1024) >> 7, cch = e & 127; val = F.conv_b[tn * 512 + h * 128 + cch]; }
              cw[e] = val; }
          if (tu < 96) { const int tn = tu >= 48 ? 1 : 0, r = (tu - 48 * tn) >> 4, c16 = tu & 15; v4u hv = (v4u){0u, 0u, 0u, 0u};
              if (seg > 0) hv = *(const v4u*)(F.PROJ + ml_off(tn ? 5 : 4, b, h) + (size_t)(seg * 512 - 3 + r) * 128 + 8 * c16);
              *(LAS v4u*)(L + L_HALO + (tn * 3 + r) * 256 + 16 * c16) = hv; } }
        v4u pq0, pq1, pk0, pk1, pv0, pv1;
#define MPREF(c_) do { const size_t tl_ = (size_t)(seg * 512 + (c_) * 64 + srow) * 128 + 8 * sc8; \
            if (PASS == 2) { const bf16* q_ = F.PROJ + ml_off(4, b, h) + tl_; pq0 = *(const v4u*)(q_); pq1 = *(const v4u*)(q_ + 64); } \
            { const bf16* k_ = F.PROJ + ml_off(5, b, h) + tl_; const bf16* vv_ = F.PROJ + ml_off(6, b, h) + tl_; \
              pk0 = *(const v4u*)(k_); pk1 = *(const v4u*)(k_ + 64); pv0 = *(const v4u*)(vv_); pv1 = *(const v4u*)(vv_ + 64); } \
            } while (0)
        MPREF(0);
        for (int c = 0; c < 8; ++c) {
            const size_t rowc = row0 + (size_t)c * 64;
            LDS_BARRIER();
            const LAS float* gsc = (const LAS float*)(L + L_CW + 5120);
            const float bc = gsc[c * 64 + lane], u = gsc[512 + c * 64 + lane], pm = gsc[1024 + c * 64 + lane];
            const float Mv = fmaxf(m_prev, pm), M63 = __shfl(Mv, 63), blast = __shfl(bc, 63);
            const float wgt = __expf(u - M63);
            if (w == 0) { su[lane] = u; sM[lane] = Mv; sb[lane] = bc; swb[lane] = (bf16)(cvtpk(wgt, 0.f) & 0xffffu); }
            const float wrow = __shfl(wgt, srow);
            *(LAS v4u*)(L + L_RAWK + srow * PT + 16 * sc8) = pk0; *(LAS v4u*)(L + L_RAWK + srow * PT + 16 * (sc8 + 8)) = pk1;
            *(LAS v4u*)(L + L_VW + srow * PT + 16 * sc8) = scale8(pv0, wrow); *(LAS v4u*)(L + L_VW + srow * PT + 16 * (sc8 + 8)) = scale8(pv1, wrow);
            if (PASS == 2) {
                *(LAS v4u*)(L + L_RAWQ + srow * PT + 16 * sc8) = pq0; *(LAS v4u*)(L + L_RAWQ + srow * PT + 16 * (sc8 + 8)) = pq1;
                *(LAS v4u*)(L + L_V + srow * PT + 16 * sc8) = pv0; *(LAS v4u*)(L + L_V + srow * PT + 16 * (sc8 + 8)) = pv1;
            }
            LDS_BARRIER();
            { const int cgp = tid & 31, tn = cgp >> 4, c16 = cgp & 15, rg4 = tid >> 5;
              if (PASS == 2 || tn == 1) {
                  const LAS unsigned char* rawb = L + (tn ? L_RAWK : L_RAWQ) + 16 * c16;
                  const LAS unsigned char* halob = L + L_HALO + ((c & 1) * 6 + tn * 3) * 256 + 16 * c16;
#pragma unroll 1
                  for (int hf = 0; hf < 2; ++hf) {
                      v2u rw[7];
#pragma unroll
                      for (int i = 0; i < 7; ++i) { const int rr = 4 * rg4 - 3 + i; rw[i] = *(const LAS v2u*)((rr >= 0 ? rawb + rr * PT : halob + (3 + rr) * 256) + 8 * hf); }
                      const LAS float* cw = (const LAS float*)(L + L_CW) + tn * 512 + 8 * c16 + 4 * hf;
                      const f32x4 b0 = *(const LAS f32x4*)((const LAS float*)(L + L_CW) + 1024 + tn * 128 + 8 * c16 + 4 * hf);
                      f32x4 w0[4];
#pragma unroll
                      for (int j = 0; j < 4; ++j) w0[j] = *(const LAS f32x4*)(cw + j * 128);
                      const float sc = tn ? 0.08838834764831845f : 1.0f;
#pragma unroll
                      for (int o = 0; o < 4; ++o) {
                          f32x4 a0 = b0;
#pragma unroll
                          for (int j = 0; j < 4; ++j) { const v2u r = rw[o + j];
                              a0[0] += w0[j][0] * bflo(r.x); a0[1] += w0[j][1] * bfhi(r.x); a0[2] += w0[j][2] * bflo(r.y); a0[3] += w0[j][3] * bfhi(r.y); }
                          v2u ov; ov.x = cvtpk(siluf_(a0[0]) * sc, siluf_(a0[1]) * sc); ov.y = cvtpk(siluf_(a0[2]) * sc, siluf_(a0[3]) * sc);
                          *(LAS v2u*)(L + (tn ? L_K : L_Q) + (4 * rg4 + o) * PT + 16 * c16 + 8 * hf) = ov;
                      }
                      if (rg4 == 15) {
#pragma unroll
                          for (int r = 0; r < 3; ++r) *(LAS v2u*)(L + L_HALO + (((c + 1) & 1) * 6 + tn * 3 + r) * 256 + 16 * c16 + 8 * hf) = rw[4 + r];
                      }
                  }
              } }
            MPREF(c + 1 < 8 ? c + 1 : 7); __builtin_amdgcn_sched_barrier(0);
            v4u po0, po1, pz0, pz1;
            if (PASS == 2) { const size_t tl = (size_t)(seg * 512 + c * 64 + srow) * 128 + 16 * sc8;
                const bf16* op = F.PROJ + ml_off(7, b, h) + tl; const bf16* zp = F.PROJ + ml_off(8, b, h) + tl;
                po0 = *(const v4u*)(op); po1 = *(const v4u*)(op + 8); pz0 = *(const v4u*)(zp); pz1 = *(const v4u*)(zp + 8); }
            LDS_BARRIER();
            if (PASS == 2) {
                const int lt = w & 3, sp = w >> 2;
#pragma unroll
                for (int si = 0; si < 2; ++si) {
                    const int st = 2 * sp + si;
                    f32x4 acc = (f32x4){0.f, 0.f, 0.f, 0.f};
                    if (st <= lt) {
#pragma unroll
                        for (int ks = 0; ks < 4; ++ks) {
                            const bf16x8 ak = *(const LAS bf16x8*)(L + L_K + (16 * st + fr) * PT + (32 * ks + 8 * fq) * 2);
                            const bf16x8 bq = *(const LAS bf16x8*)(L + L_Q + (16 * lt + fr) * PT + (32 * ks + 8 * fq) * 2);
                            acc = __builtin_amdgcn_mfma_f32_16x16x32_bf16(ak, bq, acc, 0, 0, 0);
                        }
                        const f32x4 us = *(const LAS f32x4*)(su + 16 * st + 4 * fq); const float Ml = sM[16 * lt + fr];
                        const int l = 16 * lt + fr, s0 = 16 * st + 4 * fq;
#pragma unroll
                        for (int j = 0; j < 4; ++j) acc[j] = (s0 + j <= l) ? acc[j] * __expf(us[j] - Ml) : 0.f;
                    }
                    v2u pw; pw.x = cvtpk(acc[0], acc[1]); pw.y = cvtpk(acc[2], acc[3]);
                    *(LAS v2u*)(L + L_S + (16 * lt + fr) * SP + (16 * st + 4 * fq) * 2) = pw;
                }
                LDS_BARRIER();
                f32x4 num[4], den[4];
#pragma unroll
                for (int i = 0; i < 4; ++i) { num[i] = (f32x4){0.f, 0.f, 0.f, 0.f}; den[i] = (f32x4){0.f, 0.f, 0.f, 0.f}; }
#pragma unroll
                for (int kk = 0; kk < 4; ++kk) {
                    v4u bsw, bnw;
                    bsw.x = cvtpk(X[2 * kk][0], X[2 * kk][1]); bsw.y = cvtpk(X[2 * kk][2], X[2 * kk][3]); bsw.z = cvtpk(X[2 * kk + 1][0], X[2 * kk + 1][1]); bsw.w = cvtpk(X[2 * kk + 1][2], X[2 * kk + 1][3]);
                    bnw.x = cvtpk(Xn[2 * kk][0], Xn[2 * kk][1]); bnw.y = cvtpk(Xn[2 * kk][2], Xn[2 * kk][3]); bnw.z = cvtpk(Xn[2 * kk + 1][0], Xn[2 * kk + 1][1]); bnw.w = cvtpk(Xn[2 * kk + 1][2], Xn[2 * kk + 1][3]);
                    const bf16x8 bs = __builtin_bit_cast(bf16x8, bsw), bn = __builtin_bit_cast(bf16x8, bnw);
#pragma unroll
                    for (int i = 0; i < 4; ++i) {
                        const LAS unsigned char* qa = L + L_Q + (16 * i + fr) * PT + (32 * kk + 4 * fq) * 2;
                        const v2u lo = *(const LAS v2u*)qa, hi = *(const LAS v2u*)(qa + 32);
                        const v4u aw = {lo.x, lo.y, hi.x, hi.y}; const bf16x8 aq = __builtin_bit_cast(bf16x8, aw);
                        num[i] = __builtin_amdgcn_mfma_f32_16x16x32_bf16(aq, bs, num[i], 0, 0, 0);
                        den[i] = __builtin_amdgcn_mfma_f32_16x16x32_bf16(aq, bn, den[i], 0, 0, 0);
                    }
                    __builtin_amdgcn_sched_barrier(0);
                }
#pragma unroll
                for (int i = 0; i < 4; ++i) { const f32x4 Ml = *(const LAS f32x4*)(sM + 16 * i + 4 * fq);
#pragma unroll
                    for (int j = 0; j < 4; ++j) { const float cs = __expf(m_prev - Ml[j]); num[i][j] *= cs; den[i][j] *= cs; } }
                const v4u onesw = {0x3f803f80u, 0x3f803f80u, 0x3f803f80u, 0x3f803f80u}; const bf16x8 ones = __builtin_bit_cast(bf16x8, onesw);
#pragma unroll
                for (int ks = 0; ks < 2; ++ks) {
                    const LAS unsigned char* vb = L + L_V + (32 * ks + 8 * fq + tq) * PT + (v0 + 4 * tp) * 2;
                    const s16x4 lo = vtr(vb), hi4 = vtr(vb + 4 * PT);
                    const bf16x8 bv = {lo[0], lo[1], lo[2], lo[3], hi4[0], hi4[1], hi4[2], hi4[3]};
#pragma unroll
                    for (int i = 0; i < 4; ++i) {
                        if (32 * ks > 16 * i + 15) continue;
                        const bf16x8 as = *(const LAS bf16x8*)(L + L_S + (16 * i + fr) * SP + (32 * ks + 8 * fq) * 2);
                        num[i] = __builtin_amdgcn_mfma_f32_16x16x32_bf16(as, bv, num[i], 0, 0, 0);
                        den[i] = __builtin_amdgcn_mfma_f32_16x16x32_bf16(as, ones, den[i], 0, 0, 0);
                    }
                }
#pragma unroll
                for (int i = 0; i < 4; ++i) { const f32x4 Ml = *(const LAS f32x4*)(sM + 16 * i + 4 * fq), bl = *(const LAS f32x4*)(sb + 16 * i + 4 * fq);
#pragma unroll
                    for (int j = 0; j < 4; ++j) Hs[(16 * i + 4 * fq + j) * HP + v0 + fr] = num[i][j] * __builtin_amdgcn_rcpf(fmaxf(fabsf(den[i][j]), __expf(-(bl[j] + Ml[j])))); }
            }
            {
                const float a = __expf(m_prev - M63);
#pragma unroll
                for (int t = 0; t < 8; ++t) { X[t] *= a; Xn[t] *= a; }
#pragma unroll
                for (int ks = 0; ks < 2; ++ks) {
                    const LAS unsigned char* vb = L + L_VW + (32 * ks + 8 * fq + tq) * PT + (v0 + 4 * tp) * 2;
                    const s16x4 lo = vtr(vb), hi4 = vtr(vb + 4 * PT);
                    const bf16x8 bv = {lo[0], lo[1], lo[2], lo[3], hi4[0], hi4[1], hi4[2], hi4[3]};
                    const bf16x8 bw = *(const LAS bf16x8*)(swb + 32 * ks + 8 * fq);
#pragma unroll
                    for (int t = 0; t < 8; ++t) {
                        const LAS unsigned char* kb = L + L_K + (32 * ks + 8 * fq + tq) * PT + (16 * t + 4 * tp) * 2;
                        const s16x4 klo = vtr(kb), khi = vtr(kb + 4 * PT);
                        const bf16x8 ak = {klo[0], klo[1], klo[2], klo[3], khi[0], khi[1], khi[2], khi[3]};
                        X[t] = __builtin_amdgcn_mfma_f32_16x16x32_bf16(ak, bv, X[t], 0, 0, 0);
                        Xn[t] = __builtin_amdgcn_mfma_f32_16x16x32_bf16(ak, bw, Xn[t], 0, 0, 0);
                        if (t & 1) __builtin_amdgcn_sched_barrier(0);
                    }
                }
                m_prev = blast + M63; bsum += blast;
            }
            if (PASS == 2) {
                LDS_BARRIER();
                const unsigned ow[8] = {po0.x, po0.y, po0.z, po0.w, po1.x, po1.y, po1.z, po1.w}, zw[8] = {pz0.x, pz0.y, pz0.z, pz0.w, pz1.x, pz1.y, pz1.z, pz1.w};
                float yv[16]; float ss = 0.f;
#pragma unroll
                for (int e = 0; e < 8; ++e) { const float h0 = Hs[srow * HP + 16 * sc8 + 2 * e], h1 = Hs[srow * HP + 16 * sc8 + 2 * e + 1];
                    yv[2 * e] = sigmoidf_(bflo(ow[e])) * h0; yv[2 * e + 1] = sigmoidf_(bfhi(ow[e])) * h1; ss += yv[2 * e] * yv[2 * e] + yv[2 * e + 1] * yv[2 * e + 1]; }
                ss += __shfl_xor(ss, 1); ss += __shfl_xor(ss, 2); ss += __shfl_xor(ss, 4);
                const float rstd = 1.0f / sqrtf(ss * (1.f / 128.f) + EPS);
                const float* nw = F.ml_w + h * 128 + 16 * sc8;
                unsigned outw[8];
#pragma unroll
                for (int e = 0; e < 8; ++e) outw[e] = pk2(yv[2 * e] * rstd * nw[2 * e] * siluf_(bflo(zw[e])), yv[2 * e + 1] * rstd * nw[2 * e + 1] * siluf_(bfhi(zw[e])));
                bf16* yp = F.Y + (rowc + srow) * DM + 512 + h * 128 + 16 * sc8;
                *(v4u*)yp = (v4u){outw[0], outw[1], outw[2], outw[3]}; *(v4u*)(yp + 8) = (v4u){outw[4], outw[5], outw[6], outw[7]};
            }
        }
#undef MPREF
        if (PASS == 1) {
            float* S = SLOC + (size_t)(bh * 7 + seg) * SL_STRIDE;
#pragma unroll
            for (int t = 0; t < 8; ++t) { *(f32x4*)(S + (size_t)(t * 512 + tid) * 4) = X[t]; if (w == 0 && fr == 0) *(f32x4*)(S + SL_N + 16 * t + 4 * fq) = Xn[t]; }
            if (tid == 0) { S[SL_SC] = m_prev; S[SL_SC + 1] = bsum; }
        }
        LDS_BARRIER();
    }
}
__device__ __forceinline__ void mlstm_pass1(Ctx& F, float* SLOC) {
    constexpr int PT = 272;
    constexpr int L_KB = 0, L_VB = 2 * 17408, L_W = 4 * 17408, L_WB = L_W + 2048, L_RED = L_WB + 1024;
    LAS unsigned char* L = F.lds;
    LAS float* sw = (LAS float*)(L + L_W); LAS bf16* swb = (LAS bf16*)(L + L_WB); LAS float* red = (LAS float*)(L + L_RED);
    for (int vu = xcd_vblk(); vu < NB * 32; vu += gridDim.x) {
        if ((vu & 31) >= 28) continue;
        const int unit = (vu >> 5) * 28 + (vu & 31);
        int tid_ = F.tid; asm volatile("" : "+v"(tid_));
        const int tid = tid_, lane = tid & 63, w = __builtin_amdgcn_readfirstlane(tid >> 6), fr = lane & 15, fq = lane >> 4, tq = fr >> 2, tp = fr & 3;
        const int srow = tid >> 3, sc8 = tid & 7, v0 = 16 * w, c16 = tid & 15, rg2 = tid >> 4;
        const int bh = unit / 7, seg = unit % 7, b = bh >> 2, h = bh & 3;
        const size_t row0 = (size_t)b * SEQ + (size_t)seg * 512;
        LDS_BARRIER();
        float bc, u;
        { const float* gg = F.GATES + (row0 + tid) * 8; const float ig = gg[h]; bc = gg[4 + h];
#pragma unroll
          for (int o = 1; o < 64; o <<= 1) { const float t_ = __shfl_up(bc, o); if (lane >= o) bc += t_; }
          if (lane == 63) red[w] = bc;
          LDS_BARRIER();
          float off = 0.f;
#pragma unroll
          for (int i = 0; i < 8; ++i) off += (i < w) ? red[i] : 0.f;
          bc += off; u = ig - bc;
          float mx = u;
#pragma unroll
          for (int o = 1; o < 64; o <<= 1) mx = fmaxf(mx, __shfl_xor(mx, o));
          if (lane == 0) red[8 + w] = mx;
          if (tid == 511) red[16] = bc;
          LDS_BARRIER();
          float umax = red[8];
#pragma unroll
          for (int i = 1; i < 8; ++i) umax = fmaxf(umax, red[8 + i]);
          const float wgt = __expf(u - umax);
          sw[tid] = wgt; swb[tid] = (bf16)(cvtpk(wgt, 0.f) & 0xffffu);
          if (tid == 0) { float* S = SLOC + (size_t)(bh * 7 + seg) * SL_STRIDE; S[SL_SC] = red[16] + umax; S[SL_SC + 1] = red[16]; }
        }
        f32x4 cwa[4], cwb[4], cba, cbb;
        { const float* cw = F.conv_w + 512 + h * 128 + 8 * c16;
#pragma unroll
          for (int j = 0; j < 4; ++j) { cwa[j] = *(const f32x4*)(cw + j * 1024); cwb[j] = *(const f32x4*)(cw + j * 1024 + 4); }
          cba = *(const f32x4*)(F.conv_b + 512 + h * 128 + 8 * c16); cbb = *(const f32x4*)(F.conv_b + 512 + h * 128 + 8 * c16 + 4); }
        f32x4 X[8], Xn[8];
#pragma unroll
        for (int t = 0; t < 8; ++t) { X[t] = (f32x4){0.f, 0.f, 0.f, 0.f}; Xn[t] = (f32x4){0.f, 0.f, 0.f, 0.f}; }
        v4u rk[5], pv0, pv1;
#define P1PREF(c_) do { const long tb_ = (long)(seg * 512 + (c_) * 64 + 2 * rg2 - 3); \
            _Pragma("unroll") for (int i = 0; i < 5; ++i) { const long tr_ = tb_ + i; const v4u ld_ = *(const v4u*)(F.PROJ + ml_off(5, b, h) + (size_t)(tr_ < 0 ? 0 : tr_) * 128 + 8 * c16); \
                rk[i].x = tr_ < 0 ? 0u : ld_.x; rk[i].y = tr_ < 0 ? 0u : ld_.y; rk[i].z = tr_ < 0 ? 0u : ld_.z; rk[i].w = tr_ < 0 ? 0u : ld_.w; }     \
            const bf16* vv_ = F.PROJ + ml_off(6, b, h) + (size_t)(seg * 512 + (c_) * 64 + srow) * 128 + 8 * sc8; pv0 = *(const v4u*)vv_; pv1 = *(const v4u*)(vv_ + 64); } while (0)
        P1PREF(0);
        LDS_BARRIER();
        for (int c = 0; c < 8; ++c) {
            LAS unsigned char* KB = L + L_KB + (c & 1) * 17408; LAS unsigned char* VB = L + L_VB + (c & 1) * 17408;
#pragma unroll
            for (int o = 0; o < 2; ++o) {
                f32x4 a0 = cba, a1 = cbb;
#pragma unroll
                for (int j = 0; j < 4; ++j) { const v4u r = rk[o + j];
                    a0[0] += cwa[j][0] * bflo(r.x); a0[1] += cwa[j][1] * bfhi(r.x); a0[2] += cwa[j][2] * bflo(r.y); a0[3] += cwa[j][3] * bfhi(r.y);
                    a1[0] += cwb[j][0] * bflo(r.z); a1[1] += cwb[j][1] * bfhi(r.z); a1[2] += cwb[j][2] * bflo(r.w); a1[3] += cwb[j][3] * bfhi(r.w); }
                const float sc = 0.08838834764831845f;
                v4u ov; ov.x = cvtpk(siluf_(a0[0]) * sc, siluf_(a0[1]) * sc); ov.y = cvtpk(siluf_(a0[2]) * sc, siluf_(a0[3]) * sc);
                ov.z = cvtpk(siluf_(a1[0]) * sc, siluf_(a1[1]) * sc); ov.w = cvtpk(siluf_(a1[2]) * sc, siluf_(a1[3]) * sc);
                *(LAS v4u*)(KB + (2 * rg2 + o) * PT + 16 * c16) = ov;
            }
            { const float wrow = sw[c * 64 + srow];
              *(LAS v4u*)(VB + srow * PT + 16 * sc8) = scale8(pv0, wrow); *(LAS v4u*)(VB + srow * PT + 16 * (sc8 + 8)) = scale8(pv1, wrow); }
            P1PREF(c + 1 < 8 ? c + 1 : 7); __builtin_amdgcn_sched_barrier(0);
            LDS_BARRIER();
#pragma unroll
            for (int ks = 0; ks < 2; ++ks) {
                const LAS unsigned char* vb = VB + (32 * ks + 8 * fq + tq) * PT + (v0 + 4 * tp) * 2;
                const s16x4 lo = vtr(vb), hi4 = vtr(vb + 4 * PT);
                const bf16x8 bv = {lo[0], lo[1], lo[2], lo[3], hi4[0], hi4[1], hi4[2], hi4[3]};
                const bf16x8 bw = *(const LAS bf16x8*)(swb + c * 64 + 32 * ks + 8 * fq);
#pragma unroll
                for (int t = 0; t < 8; ++t) {
                    const LAS unsigned char* kb = KB + (32 * ks + 8 * fq + tq) * PT + (16 * t + 4 * tp) * 2;
                    const s16x4 klo = vtr(kb), khi = vtr(kb + 4 * PT);
                    const bf16x8 ak = {klo[0], klo[1], klo[2], klo[3], khi[0], khi[1], khi[2], khi[3]};
                    X[t] = __builtin_amdgcn_mfma_f32_16x16x32_bf16(ak, bv, X[t], 0, 0, 0);
                    Xn[t] = __builtin_amdgcn_mfma_f32_16x16x32_bf16(ak, bw, Xn[t], 0, 0, 0);
                }
            }
        }
#undef P1PREF
        { float* S = SLOC + (size_t)(bh * 7 + seg) * SL_STRIDE;
#pragma unroll
          for (int t = 0; t < 8; ++t) { *(f32x4*)(S + (size_t)(t * 512 + tid) * 4) = X[t]; if (w == 0 && fr == 0) *(f32x4*)(S + SL_N + 16 * t + 4 * fq) = Xn[t]; } }
        LDS_BARRIER();
    }
}
#ifdef PROBE_SUB
#define SUB40(i) do { if (blockIdx.x == 40 && threadIdx.x == 0) g_sub_ts[i] = __builtin_amdgcn_s_memrealtime(); } while (0)
#else
#define SUB40(i) do { } while (0)
#endif
#define MIXERS(F) do { SUB40(4); attn32k(F); SUB40(5); mlstm_pass1(F, (float*)(args.ws + WS_PB)); SUB40(6); GRID_SEAM(); TSTAMP(3); SUB40(7); mlstm_fast<2>(F, (float*)(args.ws + WS_PB)); } while (0)
#ifdef PROBE_PH
#ifndef PROBE_PH_END
#define PROBE_PH_END (PROBE_PH + 1)
#endif
#define TSTAMP(i) do { ts_[i] = __builtin_amdgcn_s_memrealtime(); } while (0)
#define TSPIN() do { if (blockIdx.x == 0 && F.tid == 0) { const unsigned long long dt_ = ts_[PROBE_PH_END] - ts_[PROBE_PH], t0_ = __builtin_amdgcn_s_memrealtime(); \
    while (__builtin_amdgcn_s_memrealtime() - t0_ < dt_) __builtin_amdgcn_s_sleep(8); } } while (0)
#elif defined(PROBE_SUB)
#define TSTAMP(i) do { } while (0)
#define TSPIN() do { if (blockIdx.x == 0 && F.tid == 0) { const unsigned long long dt_ = g_sub_ts[PROBE_SUB_B] - g_sub_ts[PROBE_SUB_A], t0_ = __builtin_amdgcn_s_memrealtime(); \
    while (__builtin_amdgcn_s_memrealtime() - t0_ < dt_) __builtin_amdgcn_s_sleep(8); } } while (0)
#else
#define TSTAMP(i) do { } while (0)
#define TSPIN() do { } while (0)
#endif
#define GRID_SEAM() xcd_barrier(xbar)
#define GRID_SEAM_() xcd_barrier(xbar)
#ifndef REP_SYNC
#define REP_SYNC 0
#endif
#ifndef REP_P0
#define REP_P0 1
#endif
#ifndef REP_P1
#define REP_P1 1
#endif
#ifndef REP_P3
#define REP_P3 1
#endif
__global__ void __launch_bounds__(512, 2) fwd_kernel(Args args) {
    extern __shared__ __attribute__((aligned(16))) unsigned char lds_raw[];
    cg::grid_group grid = cg::this_grid();
    Ctx F;
#ifdef PROBE_PH
    unsigned long long ts_[8];
#endif
    F.lds = (LAS unsigned char*)lds_raw;
    F.tid = threadIdx.x; F.lane = F.tid & 63; F.wave = __builtin_amdgcn_readfirstlane(F.tid >> 6);
    F.gw = blockIdx.x * 8 + F.wave; F.NGW = gridDim.x * 8;
    F.x = args.in[0]; F.p = args.in[1]; F.pre_w = args.in[2]; F.w_in = args.in[3]; F.conv_w = args.in[4]; F.conv_b = args.in[5]; F.i_bias = args.in[6]; F.f_bias = args.in[7];
    F.sb_w = args.in[8]; F.ml_w = args.in[9]; F.w_out = args.in[10]; F.post_w = args.in[11]; F.w_up = args.in[12]; F.w_gate = args.in[13]; F.b_gate = args.in[14];
    F.out = args.out; unsigned char* ws = args.ws;
    F.WT_IN = (bf16*)(ws + WS_WIN); F.WT_OUT = (bf16*)(ws + WS_WOUT); F.WT_GATE = (bf16*)(ws + WS_WGATE); F.WT_UP = (bf16*)(ws + WS_WUP); F.GATES = (float*)(ws + WS_GATES);
    F.U = (bf16*)(ws + WS_U); F.Y = F.U; F.HB = F.U; F.PROJ = (bf16*)(ws + WS_PROJ); F.Y2 = F.PROJ; F.PU = (bf16*)(ws + WS_PU); F.PB = (bf16*)(ws + WS_PB); F.QKC = (bf16*)(ws + WS_QKC);

    volatile LAS unsigned* bar_st = (volatile LAS unsigned*)(F.lds + 131072 + 512);
    if (F.tid < 2) bar_st[F.tid] = 0u;
    __syncthreads();
    unsigned* bar_words = (unsigned*)args.ws;
    if (args.ws == nullptr) grid.sync();
    const XcdBarrier xbar = xcd_barrier_post(bar_words, bar_st);
    TSTAMP(0);
    for (int rep_ = 0; rep_ < REP_P0; ++rep_) phase0(F);
    GRID_SEAM_();
    TSTAMP(1);

    for (int rep_ = 0; rep_ < REP_SYNC; ++rep_) GRID_SEAM();
    for (int rep_ = 0; rep_ < REP_P1; ++rep_) {
        pg8::Gemm g{F.U, F.WT_IN, MTOK, NPROJ, DM}; ProjOrder S; S.init(MTOK, NPROJ, gridDim.x, blockIdx.x);
        EpiProj E{F.PROJ, 0.125f * 1.4426950408889634f};
        pg8::gemm_phase<EpiProj, ProjOrder, true, true>(F.lds, g, S, E);
        pg8::Gemm g2{F.PB, F.WT_UP, MTOK, DM, PLE}; pg8::StaticOrder S2; S2.init(MTOK, DM, gridDim.x, blockIdx.x);
        pg8::EpiBf16<0> E2{F.PU, DM, nullptr, 0, 0, 1.f, 1};
        pg8::gemm_phase<pg8::EpiBf16<0>, pg8::StaticOrder, true, true>(F.lds, g2, S2, E2);
    }
    GRID_SEAM();
    TSTAMP(2);
    MIXERS(F);
    GRID_SEAM();
    TSTAMP(4);
    for (int rep_ = 0; rep_ < REP_P3; ++rep_) {
        pg8::Gemm g{F.Y, F.WT_OUT, MTOK, DM, DM}; pg8::StaticOrder S; S.init(MTOK, DM, gridDim.x, blockIdx.x);
        pg8::EpiBf16<0> E{F.Y2, DM, nullptr, 0, 0, 1.f};
        pg8::gemm_phase<pg8::EpiBf16<0>, pg8::StaticOrder, true, true>(F.lds, g, S, E);
    }
    GRID_SEAM();
    TSTAMP(5);
    for (int rep_ = 0; rep_ < REP_P0; ++rep_) phase_norm(F);
    GRID_SEAM();
    TSTAMP(6);
    {
        pg8::Gemm g{F.HB, F.WT_GATE, MTOK, DM, DM}; pg8::StaticOrder S; S.init(MTOK, DM, gridDim.x, blockIdx.x);
        EpiGate E{F.out, F.PU, F.b_gate, F.HB};
        pg8::gemm_phase<EpiGate, pg8::StaticOrder, true, true>(F.lds, g, S, E);
    }
    TSTAMP(7);
    TSPIN();
}

extern "C" void kernel_launch(void* const* d_in, const int* in_sizes, int n_in, void* d_out, int out_size, void* d_ws, size_t ws_size, hipStream_t stream) {
    static int grid = 0;
    if (grid == 0) {
        if (n_in != 15 || out_size != MTOK * DM || ws_size < WS_END) { fprintf(stderr, "kernel_launch: unexpected shapes (n_in %d out %d ws %zu)\n", n_in, out_size, ws_size); grid = -1; return; }
        int dev = 0, cus = 0, per_cu = 0;
        (void)hipGetDevice(&dev); (void)hipDeviceGetAttribute(&cus, hipDeviceAttributeMultiprocessorCount, dev);
        if (hipFuncSetAttribute((const void*)fwd_kernel, hipFuncAttributeMaxDynamicSharedMemorySize, LDS_BYTES) != hipSuccess) { fprintf(stderr, "kernel_launch: hipFuncSetAttribute failed\n"); grid = -1; return; }
        if (hipOccupancyMaxActiveBlocksPerMultiprocessor(&per_cu, (const void*)fwd_kernel, 512, LDS_BYTES) != hipSuccess || per_cu < 1) { fprintf(stderr, "kernel_launch: occupancy query says %d\n", per_cu); per_cu = 1; }
        (void)hipGetLastError();
        grid = cus * 1;
        if (grid <= 0) grid = 256;
    }
    if (grid < 0) return;
    Args a{};
    for (int i = 0; i < 15; ++i) a.in[i] = (const float*)d_in[i];
    a.out = (float*)d_out; a.ws = (unsigned char*)d_ws;
    if (hipMemsetAsync(d_ws, 0, 14336, stream) != hipSuccess) { fprintf(stderr, "kernel_launch: memset of the control words failed\n"); return; }
    void* kargs[] = {&a};
    hipError_t e = hipLaunchCooperativeKernel((const void*)fwd_kernel, dim3(grid), dim3(512), kargs, LDS_BYTES, stream);
    if (e != hipSuccess) fprintf(stderr, "kernel_launch: cooperative launch failed: %s (grid %d)\n", hipGetErrorString(e), grid);
}
```

```cpp
#include <hip/hip_runtime.h>
#include <hip/hip_cooperative_groups.h>
#include <cstdio>
#include <cstdint>
namespace cg = cooperative_groups;

namespace pg8 {
#define PG8_LAS __attribute__((address_space(3)))
typedef unsigned short bf16_t;
typedef short bf16x8 __attribute__((ext_vector_type(8)));
typedef float f32x4 __attribute__((ext_vector_type(4)));
typedef unsigned u32x4 __attribute__((ext_vector_type(4)));
constexpr int BM = 256, BK = 64, HALF = 128, HTB = HALF * BK * 2  , STAGE_BYTES = 8 * HTB, NXCD = 8, WGM = 8;

__host__ __device__ __forceinline__ int lds_byte(int r, int c) { const int st = (r >> 4) * 2 + (c >> 5), rr = r & 15, cc = c & 31, ob = rr * 64 + cc * 2; return st * 1024 + (ob ^ (((ob >> 9) & 1) << 5)); }
__host__ __device__ __forceinline__ void stage_rc(int b, int& R, int& C) { const int st = b / 1024, sb = b % 1024, swz = sb ^ (((sb >> 9) & 1) << 5); R = (st >> 1) * 16 + swz / 64; C = (st & 1) * 32 + (swz % 64) / 2; }
__host__ __device__ __forceinline__ int perm32(int rho) { const int n = rho >> 4, i = rho & 15; return 8 * (i >> 2) + 4 * n + (i & 3); }

struct Unit { int pm, pn; };
struct Gemm { const bf16_t* A; const bf16_t* Bt; int M, N, K; };

struct StaticOrder {
    int nM, nN, nwg, G, c;
    __host__ __device__ void init(int M, int N, int G_, int c_) { nM = M / BM; nN = N / BM; nwg = nM * nN; G = G_; c = c_; }
    __host__ __device__ bool next(int i, Unit& u) const {
        const long L = (long)i * G + c; if (L >= nwg) return false;
        int wgid = (int)L; { const int q = nwg / NXCD, r = nwg % NXCD, xcd = wgid % NXCD, off = wgid / NXCD; wgid = (xcd < r ? xcd * (q + 1) : r * (q + 1) + (xcd - r) * q) + off; }
        const int nig = WGM * nN, gid = wgid / nig, fm = gid * WGM, gsz = (nM - fm) < WGM ? (nM - fm) : WGM;
        u.pm = fm + ((wgid % nig) % gsz); u.pn = (wgid % nig) / gsz; return true;
    }
    __device__ __forceinline__ void a_ready(const Unit&) const {}
    __device__ __forceinline__ void done(const Unit&) const {}
};

__device__ __forceinline__ unsigned cvt_pk_bf16(float lo, float hi) { unsigned r; asm volatile("v_cvt_pk_bf16_f32 %0, %1, %2" : "=v"(r) : "v"(lo), "v"(hi)); return r; }
typedef float f32x2 __attribute__((ext_vector_type(2)));
__device__ __forceinline__ f32x2 gelu_pk(f32x2 v) {
    const f32x2 av = __builtin_elementwise_abs(v), d = av * 0.2316418882f + 1.0f;
    f32x2 t; t.x = __builtin_amdgcn_rcpf(d.x); t.y = __builtin_amdgcn_rcpf(d.y);
    f32x2 q = t * 0.5307027145f + (-0.7265760135f); q = q * t + 0.7107068705f; q = q * t + (-0.142248368f); q = q * t + 0.127414796f; q = q * t;
    const f32x2 s = (v * v) * (-0.72134752044f);
    f32x2 e; e.x = __builtin_amdgcn_exp2f(s.x); e.y = __builtin_amdgcn_exp2f(s.y);
    const f32x2 m = v * (q * e), r = v - m;
    f32x2 o; o.x = v.x < 0.f ? m.x : r.x; o.y = v.y < 0.f ? m.y : r.y; return o;
}

template <int ACT  > struct EpiBf16 {
    static constexpr bool PERM = true, AFTER_DRAIN = false; static_assert(ACT == 0 || ACT == 1, "EpiBf16: ACT is 0 (none) or 1 (gelu_pk)");
    bf16_t* O; int ldc; const float* bias; int split_cols; size_t split_stride; float scale0; int nt;
    __device__ __forceinline__ void operator()(const f32x4 (&acc)[2][2][4][2], const Unit& u, int wr, int wc, int fr, int fq) const {
        const int row0 = u.pm * BM + wr * 64 + fr; int colt = u.pn * BM; bf16_t* base = O;
        float sc = 1.f; if (split_cols) { const int t = colt / split_cols; base += (size_t)t * split_stride; colt -= t * split_cols; if (t == 0) sc = scale0; }
        const int col0 = colt + wc * 32 + 8 * fq, bcol0 = u.pn * BM + wc * 32 + 8 * fq;
        f32x4 bv[2][2];
#pragma unroll
        for (int bj = 0; bj < 2; ++bj)
#pragma unroll
            for (int n = 0; n < 2; ++n) bv[bj][n] = bias ? *(const f32x4*)(bias + bcol0 + bj * HALF + 4 * n) : (f32x4){0.f, 0.f, 0.f, 0.f};
#pragma unroll
        for (int ai = 0; ai < 2; ++ai)
#pragma unroll
            for (int m = 0; m < 4; ++m) { bf16_t* rowp = base + (size_t)(row0 + ai * HALF + m * 16) * ldc + col0;
#pragma unroll
                for (int bj = 0; bj < 2; ++bj) { f32x4 v0 = acc[ai][bj][m][0] + bv[bj][0], v1 = acc[ai][bj][m][1] + bv[bj][1];
                    if (ACT == 1) { f32x2 a = gelu_pk((f32x2){v0[0], v0[1]}), b = gelu_pk((f32x2){v0[2], v0[3]}), c = gelu_pk((f32x2){v1[0], v1[1]}), d = gelu_pk((f32x2){v1[2], v1[3]});
                        v0 = (f32x4){a.x, a.y, b.x, b.y}; v1 = (f32x4){c.x, c.y, d.x, d.y}; }
                    v0 = v0 * sc; v1 = v1 * sc; u32x4 w; w.x = cvt_pk_bf16(v0[0], v0[1]); w.y = cvt_pk_bf16(v0[2], v0[3]); w.z = cvt_pk_bf16(v1[0], v1[1]); w.w = cvt_pk_bf16(v1[2], v1[3]);
                    if (nt) __builtin_nontemporal_store(w, (u32x4*)(rowp + bj * HALF)); else *(u32x4*)(rowp + bj * HALF) = w; } }
    }
};

template <class Epi, class Sched, bool ALIGN_EPI = false, bool SP2 = false>
__device__ __forceinline__ void gemm_phase(PG8_LAS unsigned char* lds, const Gemm g, const Sched& S, const Epi& E) {
    int tid_ = threadIdx.x; asm volatile("" : "+v"(tid_));
    const int tid = tid_, wid = __builtin_amdgcn_readfirstlane(tid >> 6), lane = tid & 63, wr = wid >> 2, wc = wid & 3, fr = lane & 15, fq = lane >> 4;
    const int K = g.K, nt = K / BK;
    unsigned voffA[2], voffB[2];
#pragma unroll
    for (int i = 0; i < 2; ++i) { int R, C; stage_rc(tid * 16 + i * 8192, R, C); const int Rb = Epi::PERM ? ((R & ~31) + perm32(R & 31)) : R;
        voffA[i] = (unsigned)(R * K + C) * 2u; voffB[i] = (unsigned)(Rb * K + C) * 2u; }
    const size_t kstep = (size_t)(BK * 2);
    const size_t hstep = (size_t)HALF * K * 2;
    const size_t tstep = 2 * hstep;
    const unsigned ldsw = (unsigned)wid * 1024u;
    const int aoff = lds_byte(wr * 64 + fr, fq * 8), boff = lds_byte(wc * 32 + fr, fq * 8);
#define PG8_SA(b, h) (((b) * 2 + (h)) * HTB)
#define PG8_SB(b, h) ((4 + (b) * 2 + (h)) * HTB)
#define PG8_STAGE(bufoff, gbase, voff) do { _Pragma("unroll") for (int _i = 0; _i < 2; ++_i) \
        __builtin_amdgcn_global_load_lds((const unsigned*)((const char*)(gbase) + (voff)[_i]), (PG8_LAS unsigned*)(lds + (bufoff) + ldsw + _i * 8192), 16, 0, 0); } while (0)
#define PG8_LDA(dst, b, h) do { _Pragma("unroll") for (int m = 0; m < 4; ++m) _Pragma("unroll") for (int k = 0; k < 2; ++k) dst[m][k] = *(const PG8_LAS bf16x8*)(lds + PG8_SA(b, h) + aoff + m * 2048 + k * 1024); } while (0)
#define PG8_LDB(dst, b, h) do { _Pragma("unroll") for (int n = 0; n < 2; ++n) _Pragma("unroll") for (int k = 0; k < 2; ++k) dst[n][k] = *(const PG8_LAS bf16x8*)(lds + PG8_SB(b, h) + boff + n * 2048 + k * 1024); } while (0)
#define PG8_MMA(ai, bj, At, Bt) do { __builtin_amdgcn_s_setprio(1); _Pragma("unroll") for (int m = 0; m < 4; ++m) _Pragma("unroll") for (int n = 0; n < 2; ++n) _Pragma("unroll") for (int k = 0; k < 2; ++k) \
        acc[ai][bj][m][n] = __builtin_amdgcn_mfma_f32_16x16x32_bf16(Bt[n][k], At[m][k], acc[ai][bj][m][n], 0, 0, 0); __builtin_amdgcn_s_setprio(0); } while (0)
#define PG8_WAIT_V(n) asm volatile("s_waitcnt vmcnt(" #n ")" ::: "memory")
#define PG8_WAIT_L(n) asm volatile("s_waitcnt lgkmcnt(" #n ")" ::: "memory")
#define PG8_BAR __builtin_amdgcn_s_barrier()
#define PG8_SCHED __builtin_amdgcn_sched_barrier(0)
    Unit cur, nxt; int ui = 0;
    if (!S.next(0, cur)) return;
    f32x4 acc[2][2][4][2];
#pragma unroll
    for (int a = 0; a < 2; ++a)
#pragma unroll
        for (int b = 0; b < 2; ++b)
#pragma unroll
            for (int m = 0; m < 4; ++m)
#pragma unroll
                for (int n = 0; n < 2; ++n) acc[a][b][m][n] = (f32x4){0.f, 0.f, 0.f, 0.f};
    bf16x8 At[4][2], B0[2][2], B1[2][2];
    const char* cA = (const char*)g.A + (size_t)cur.pm * tstep; const char* cB = (const char*)g.Bt + (size_t)cur.pn * tstep;
    S.a_ready(cur);
    if constexpr (SP2) {
        PG8_STAGE(PG8_SB(0, 0), cB, voffB); PG8_STAGE(PG8_SB(0, 1), cB + hstep, voffB); PG8_STAGE(PG8_SA(0, 0), cA, voffA); PG8_STAGE(PG8_SA(0, 1), cA + hstep, voffA);
        if (wr == 1) PG8_BAR;
        PG8_WAIT_V(2); PG8_BAR;
        PG8_STAGE(PG8_SB(1, 0), cB + kstep, voffB); PG8_STAGE(PG8_SA(1, 0), cA + kstep, voffA); PG8_STAGE(PG8_SB(1, 1), cB + hstep + kstep, voffB);
        PG8_WAIT_V(6); PG8_BAR;
    } else {
        PG8_STAGE(PG8_SB(0, 0), cB, voffB); PG8_STAGE(PG8_SA(0, 0), cA, voffA); PG8_STAGE(PG8_SB(0, 1), cB + hstep, voffB); PG8_STAGE(PG8_SA(0, 1), cA + hstep, voffA);
        if (wr == 1) PG8_BAR;
        PG8_WAIT_V(4); PG8_BAR;
        PG8_STAGE(PG8_SB(1, 0), cB + kstep, voffB); PG8_STAGE(PG8_SA(1, 0), cA + kstep, voffA); PG8_STAGE(PG8_SB(1, 1), cB + hstep + kstep, voffB);
        PG8_WAIT_V(6); PG8_BAR;
    }
    for (;;) {
        const bool has_next = S.next(ui + 1, nxt);
        const char* nA = has_next ? (const char*)g.A + (size_t)nxt.pm * tstep : cA; const char* nB = has_next ? (const char*)g.Bt + (size_t)nxt.pn * tstep : cB;
        for (int t = 0; t < nt; t += 2) {
            const bool last = (t == nt - 2);
            const char* a1 = cA + (size_t)(t + 1) * kstep;
            const char* a2 = last ? nA : cA + (size_t)(t + 2) * kstep; const char* b2 = last ? nB : cB + (size_t)(t + 2) * kstep;
            const char* a3 = a2 + kstep; const char* b3 = b2 + kstep;
            if (last && has_next) S.a_ready(nxt);
            if constexpr (SP2) {
            PG8_LDB(B0, 0, 0); PG8_LDB(B1, 0, 1); PG8_SCHED; PG8_LDA(At, 0, 0); PG8_STAGE(PG8_SA(1, 1), a1 + hstep, voffA);
            PG8_WAIT_V(8); PG8_WAIT_L(0); PG8_BAR; PG8_MMA(0, 0, At, B0); PG8_MMA(0, 1, At, B1); PG8_BAR; PG8_SCHED;
            PG8_LDA(At, 0, 1); PG8_STAGE(PG8_SB(0, 0), b2, voffB); PG8_STAGE(PG8_SB(0, 1), b2 + hstep, voffB); PG8_STAGE(PG8_SA(0, 0), a2, voffA);
            PG8_WAIT_V(8); PG8_WAIT_L(0); PG8_BAR; PG8_MMA(1, 0, At, B0); PG8_MMA(1, 1, At, B1); PG8_BAR; PG8_SCHED;
            PG8_LDB(B0, 1, 0); PG8_LDB(B1, 1, 1); PG8_SCHED; PG8_LDA(At, 1, 0); PG8_STAGE(PG8_SA(0, 1), a2 + hstep, voffA);
            PG8_WAIT_V(8); PG8_WAIT_L(0); PG8_BAR; PG8_MMA(0, 0, At, B0); PG8_MMA(0, 1, At, B1); PG8_BAR; PG8_SCHED;
            PG8_LDA(At, 1, 1); PG8_STAGE(PG8_SB(1, 0), b3, voffB); PG8_STAGE(PG8_SB(1, 1), b3 + hstep, voffB); PG8_STAGE(PG8_SA(1, 0), a3, voffA);
            PG8_WAIT_V(8); PG8_WAIT_L(0); PG8_BAR; PG8_MMA(1, 0, At, B0); PG8_MMA(1, 1, At, B1); PG8_BAR; PG8_SCHED;
            } else {
            PG8_LDB(B0, 0, 0); PG8_SCHED; PG8_LDA(At, 0, 0); PG8_STAGE(PG8_SA(1, 1), a1 + hstep, voffA);
            PG8_WAIT_L(8); PG8_BAR; PG8_WAIT_L(0); PG8_MMA(0, 0, At, B0); PG8_BAR; PG8_SCHED;
            PG8_LDB(B1, 0, 1); PG8_STAGE(PG8_SB(0, 0), b2, voffB);
            PG8_BAR; PG8_WAIT_L(0); PG8_MMA(0, 1, At, B1); PG8_BAR;
            PG8_LDA(At, 0, 1); PG8_STAGE(PG8_SA(0, 0), a2, voffA);
            PG8_BAR; PG8_WAIT_L(0); PG8_MMA(1, 0, At, B0); PG8_BAR; PG8_SCHED;
            PG8_STAGE(PG8_SB(0, 1), b2 + hstep, voffB);
            PG8_WAIT_V(6); PG8_BAR; PG8_MMA(1, 1, At, B1); PG8_BAR;
            PG8_LDB(B0, 1, 0); PG8_SCHED; PG8_LDA(At, 1, 0); PG8_STAGE(PG8_SA(0, 1), a2 + hstep, voffA);
            PG8_WAIT_L(8); PG8_BAR; PG8_WAIT_L(0); PG8_MMA(0, 0, At, B0); PG8_BAR; PG8_SCHED;
            PG8_LDB(B1, 1, 1); PG8_STAGE(PG8_SB(1, 0), b3, voffB);
            PG8_BAR; PG8_WAIT_L(0); PG8_MMA(0, 1, At, B1); PG8_BAR;
            PG8_LDA(At, 1, 1); PG8_STAGE(PG8_SA(1, 0), a3, voffA);
            PG8_BAR; PG8_WAIT_L(0); PG8_MMA(1, 0, At, B0); PG8_BAR; PG8_SCHED;
            PG8_STAGE(PG8_SB(1, 1), b3 + hstep, voffB);
            PG8_WAIT_V(6); PG8_BAR; PG8_MMA(1, 1, At, B1); PG8_BAR;
            }
        }
        if constexpr (ALIGN_EPI) { if (wr == 0) PG8_BAR; }
        if constexpr (!Epi::AFTER_DRAIN) { E(acc, cur, wr, wc, fr, fq); S.done(cur); }
        if (!has_next) break;
#pragma unroll
        for (int a = 0; a < 2; ++a)
#pragma unroll
            for (int b = 0; b < 2; ++b)
#pragma unroll
                for (int m = 0; m < 4; ++m)
#pragma unroll
                    for (int n = 0; n < 2; ++n) acc[a][b][m][n] = (f32x4){0.f, 0.f, 0.f, 0.f};
        cur = nxt; cA = nA; cB = nB; ++ui;
        if constexpr (ALIGN_EPI) { if (wr == 1) PG8_BAR; }
    }
    PG8_WAIT_V(0);
    if constexpr (!ALIGN_EPI) { if (wr == 0) PG8_BAR; }
    PG8_BAR;
    if constexpr (Epi::AFTER_DRAIN) { E.fused(acc, cur, wr, wc, fr, fq, lds, wid, lane); S.done(cur); }
#undef PG8_SA
#undef PG8_SB
#undef PG8_STAGE
#undef PG8_LDA
#undef PG8_LDB
#undef PG8_MMA
#undef PG8_WAIT_V
#undef PG8_WAIT_L
#undef PG8_BAR
#undef PG8_SCHED
}
}
#define LAS __attribute__((address_space(3)))
typedef unsigned short bf16;
typedef unsigned v4u __attribute__((ext_vector_type(4)));
typedef unsigned v2u __attribute__((ext_vector_type(2)));
typedef float f32x4 __attribute__((ext_vector_type(4)));
typedef short bf16x8 __attribute__((ext_vector_type(8)));
typedef short s16x4 __attribute__((ext_vector_type(4)));
typedef float f32x16 __attribute__((ext_vector_type(16)));
constexpr int DM = 1024, NB = 8, SEQ = 4096, MTOK = NB * SEQ, NIN = 4616, NPROJ = 4608, PLE = 256;
constexpr int C_SBQ = 0, C_SBK = 512, C_SBV = 1024, C_SBZ = 1536, C_MLQ = 2048, C_MLK = 2560, C_MLV = 3072, C_MLO = 3584, C_MLZ = 4096;
constexpr float EPS = 1e-6f;
constexpr size_t MiB = 1u << 20;
constexpr size_t WS_WIN = 1 * MiB, WS_WOUT = 10 * MiB, WS_WGATE = 12 * MiB, WS_WUP = 14 * MiB, WS_GATES = 15 * MiB;
constexpr size_t WS_U = 16 * MiB;
constexpr size_t WS_PROJ = 80 * MiB;
constexpr size_t WS_PU = 368 * MiB, WS_PB = 432 * MiB, WS_QKC = 448 * MiB, WS_END = 512 * MiB;
constexpr int LDS_BYTES = 147456;

__device__ __forceinline__ unsigned f2bf(float f) { unsigned u = __builtin_bit_cast(unsigned, f); return (u + 0x7fffu + ((u >> 16) & 1u)) >> 16; }
__device__ __forceinline__ unsigned pk2(float lo, float hi) { return f2bf(lo) | (f2bf(hi) << 16); }
__device__ __forceinline__ float bflo(unsigned w) { return __builtin_bit_cast(float, w << 16); }
__device__ __forceinline__ float bfhi(unsigned w) { return __builtin_bit_cast(float, w & 0xffff0000u); }
__device__ __forceinline__ float bf1(bf16 v) { return __builtin_bit_cast(float, ((unsigned)v) << 16); }
__device__ __forceinline__ float wave_sum(float v) {
#pragma unroll
    for (int o = 1; o < 64; o <<= 1) v += __shfl_xor(v, o);
    return v;
}
__device__ __forceinline__ float sigmoidf_(float x) { return __builtin_amdgcn_rcpf(1.f + __expf(-x)); }
__device__ __forceinline__ float siluf_(float x) { return x * __builtin_amdgcn_rcpf(1.f + __expf(-x)); }
#define LDS_WAIT() asm volatile("s_waitcnt lgkmcnt(0)" ::: "memory")
#define LDS_BARRIER() do { asm volatile("s_waitcnt lgkmcnt(0)" ::: "memory"); __builtin_amdgcn_s_barrier(); asm volatile("" ::: "memory"); } while (0)

__device__ __forceinline__ void p0_transpose_item(const float* W, int K, int pitch, int nblk, bf16* WT, LAS float* scr, int item, int lane) {
    const int kb = item / nblk, nb = item % nblk, k0 = 64 * kb, n0 = 32 * nb;
    float tv[32];
#pragma unroll
    for (int i = 0; i < 32; ++i) tv[i] = __builtin_nontemporal_load(W + (size_t)(k0 + 2 * i + (lane >> 5)) * pitch + n0 + (lane & 31));
#pragma unroll
    for (int i = 0; i < 32; ++i) scr[(2 * i + (lane >> 5)) * 33 + (lane & 31)] = tv[i];
    LDS_WAIT(); asm volatile("" ::: "memory");
    const int c = lane & 7;
#pragma unroll
    for (int j = 0; j < 4; ++j) { const int n = (lane >> 3) + 8 * j; const LAS float* s = scr + (8 * c) * 33 + n;
        v4u o; o.x = pk2(s[0 * 33], s[1 * 33]); o.y = pk2(s[2 * 33], s[3 * 33]); o.z = pk2(s[4 * 33], s[5 * 33]); o.w = pk2(s[6 * 33], s[7 * 33]);
        *(v4u*)(WT + (size_t)(n0 + n) * K + k0 + 8 * c) = o; }
    LDS_WAIT(); asm volatile("" ::: "memory");
}

struct EpiGate {
    static constexpr bool PERM = true, AFTER_DRAIN = false;
    float* out; const bf16* pu; const float* bias; const bf16* hb;
    __device__ __forceinline__ void operator()(const pg8::f32x4 (&acc)[2][2][4][2], const pg8::Unit& u, int wr, int wc, int fr, int fq) const {
        const int row0 = u.pm * 256 + wr * 64 + fr, col0 = u.pn * 256 + wc * 32 + 8 * fq;
        f32x4 bv[2][2];
#pragma unroll
        for (int bj = 0; bj < 2; ++bj) { bv[bj][0] = *(const f32x4*)(bias + col0 + bj * 128); bv[bj][1] = *(const f32x4*)(bias + col0 + bj * 128 + 4); }
#pragma unroll
        for (int ai = 0; ai < 2; ++ai)
#pragma unroll
            for (int mp = 0; mp < 2; ++mp) {
                v4u hw[2][2], pw[2][2];
#pragma unroll
                for (int mm = 0; mm < 2; ++mm) { const size_t ro = (size_t)(row0 + ai * 128 + (2 * mp + mm) * 16) * DM;
#pragma unroll
                    for (int bj = 0; bj < 2; ++bj) { const int c = col0 + bj * 128; hw[mm][bj] = *(const v4u*)(hb + ro + c); pw[mm][bj] = *(const v4u*)(pu + ro + c); } }
#pragma unroll
                for (int mm = 0; mm < 2; ++mm) { const int m = 2 * mp + mm; const size_t ro = (size_t)(row0 + ai * 128 + m * 16) * DM;
#pragma unroll
                    for (int bj = 0; bj < 2; ++bj) { const int c = col0 + bj * 128;
                        const f32x4 v0 = acc[ai][bj][m][0] + bv[bj][0], v1 = acc[ai][bj][m][1] + bv[bj][1];
                        const v4u h = hw[mm][bj], q = pw[mm][bj];
                        f32x4 o0, o1;
                        o0[0] = bflo(h.x) + sigmoidf_(v0[0]) * bflo(q.x); o0[1] = bfhi(h.x) + sigmoidf_(v0[1]) * bfhi(q.x);
                        o0[2] = bflo(h.y) + sigmoidf_(v0[2]) * bflo(q.y); o0[3] = bfhi(h.y) + sigmoidf_(v0[3]) * bfhi(q.y);
                        o1[0] = bflo(h.z) + sigmoidf_(v1[0]) * bflo(q.z); o1[1] = bfhi(h.z) + sigmoidf_(v1[1]) * bfhi(q.z);
                        o1[2] = bflo(h.w) + sigmoidf_(v1[2]) * bflo(q.w); o1[3] = bfhi(h.w) + sigmoidf_(v1[3]) * bfhi(q.w);
                        __builtin_nontemporal_store(o0, (f32x4*)(out + ro + c)); __builtin_nontemporal_store(o1, (f32x4*)(out + ro + c + 4)); } }
            }
    }
};

constexpr size_t SLAB = (size_t)MTOK * 512;
__device__ __forceinline__ size_t sb_off(int T, int b, int h) { return (size_t)T * SLAB + (size_t)((b * 8 + h) * SEQ) * 64; }
__device__ __forceinline__ size_t ml_off(int T, int b, int h) { return (size_t)T * SLAB + (size_t)((b * 4 + h) * SEQ) * 128; }
struct EpiProj {
    static constexpr bool PERM = true, AFTER_DRAIN = false;
    bf16* O; float scale0;
    __device__ __forceinline__ void operator()(const pg8::f32x4 (&acc)[2][2][4][2], const pg8::Unit& u, int wr, int wc, int fr, int fq) const {
        const int row0 = u.pm * 256 + wr * 64 + fr, colt = u.pn * 256, T = colt >> 9;
        const float sc = T == 0 ? scale0 : 1.f;
#pragma unroll
        for (int bj = 0; bj < 2; ++bj) {
            const int cin = (colt + bj * 128 + wc * 32 + 8 * fq) & 511;
            const int HDl = T < 4 ? 6 : 7, h = cin >> HDl, cc = cin & ((1 << HDl) - 1), Hn = T < 4 ? 8 : 4;
#pragma unroll
            for (int ai = 0; ai < 2; ++ai)
#pragma unroll
                for (int m = 0; m < 4; ++m) { const int row = row0 + ai * 128 + m * 16, b = row >> 12, t = row & (SEQ - 1);
                    bf16* dst = O + (size_t)T * SLAB + (((size_t)(b * Hn + h) * SEQ + t) << HDl) + cc;
                    const pg8::f32x4 v0 = acc[ai][bj][m][0] * sc, v1 = acc[ai][bj][m][1] * sc;
                    v4u w; w.x = pg8::cvt_pk_bf16(v0[0], v0[1]); w.y = pg8::cvt_pk_bf16(v0[2], v0[3]); w.z = pg8::cvt_pk_bf16(v1[0], v1[1]); w.w = pg8::cvt_pk_bf16(v1[2], v1[3]);
                    __builtin_nontemporal_store(w, (v4u*)dst); }
        }
    }
};

struct ProjOrder : pg8::StaticOrder {
    __host__ __device__ bool next(int i, pg8::Unit& u) const {
        if (!pg8::StaticOrder::next(i, u)) return false;
        const int p = u.pn;
        u.pn = p < 2 ? 8 + p : (p < 6 ? 12 + p : (p < 10 ? 4 + p : p - 10));
        return true;
    }
};

__device__ __forceinline__ int xcd_vblk() { return (gridDim.x & 7) == 0 ? (int)(blockIdx.x & 7) * (int)(gridDim.x >> 3) + (int)(blockIdx.x >> 3) : (int)blockIdx.x; }

struct Args { const float* in[15]; float* out; unsigned char* ws; };
struct Ctx {
    LAS unsigned char* lds; int tid, lane, wave, gw, NGW;
    const float *x, *p, *pre_w, *w_in, *conv_w, *conv_b, *i_bias, *f_bias, *sb_w, *ml_w, *w_out, *post_w, *w_up, *w_gate, *b_gate;
    float* out; bf16 *WT_IN, *WT_OUT, *WT_GATE, *WT_UP, *U, *Y, *HB, *PROJ, *Y2, *PU, *PB, *QKC; float* GATES;
};

#ifdef PROBE_SUB
__device__ unsigned long long g_sub_ts[8];
#define SUBSTAMP(i) do { if (blockIdx.x == 0 && threadIdx.x == 0) g_sub_ts[i] = __builtin_amdgcn_s_memrealtime(); } while (0)
#else
#define SUBSTAMP(i) do { } while (0)
#endif
__device__ __forceinline__ void phase0(Ctx& F) {
    SUBSTAMP(3);
    LAS float* Wg = (LAS float*)F.lds;
    for (int e = F.tid; e < 1024 * 8; e += 512) Wg[e] = F.w_in[(size_t)(e >> 3) * NIN + NPROJ + (e & 7)];
    __syncthreads();
    SUBSTAMP(0);
    if (F.wave < 6) {
        f32x4 wga[16], wgb[16];
#pragma unroll
        for (int j = 0; j < 4; ++j)
#pragma unroll
            for (int e = 0; e < 4; ++e) { const LAS f32x4* wp = (const LAS f32x4*)(Wg + (512 * (j >> 1) + 8 * F.lane + 4 * (j & 1) + e) * 8); wga[4 * j + e] = wp[0]; wgb[4 * j + e] = wp[1]; }
        f32x4 pw[4];
#pragma unroll
        for (int j = 0; j < 4; ++j) pw[j] = *(const f32x4*)(F.pre_w + 512 * (j >> 1) + 8 * F.lane + 4 * (j & 1));
        const f32x4 ib = *(const f32x4*)F.i_bias, fb = *(const f32x4*)F.f_bias;
        f32x4 vn[4];
        const int nrw = (int)gridDim.x * 6, rwi = xcd_vblk() * 6 + F.wave;
        const int mbeg = (int)(((long)rwi * MTOK) / nrw), mend = (int)(((long)(rwi + 1) * MTOK) / nrw);
        { const float* xr = F.x + (size_t)mbeg * DM + 8 * F.lane;
#pragma unroll
          for (int j = 0; j < 4; ++j) vn[j] = __builtin_nontemporal_load((const f32x4*)(xr + 512 * (j >> 1) + 4 * (j & 1))); }
        const bool up32 = (F.lane & 32) != 0, up16 = (F.lane & 16) != 0, up8 = (F.lane & 8) != 0;
        const int gq = F.lane >> 3; const float bsel = gq < 4 ? ib[gq & 3] : fb[gq & 3];
        for (int m = mbeg; m < mend; ++m) {
            f32x4 v[4];
#pragma unroll
            for (int j = 0; j < 4; ++j) v[j] = vn[j];
            { const float* xr = F.x + (size_t)(m + 1 < mend ? m + 1 : m) * DM + 8 * F.lane;
#pragma unroll
                for (int j = 0; j < 4; ++j) vn[j] = __builtin_nontemporal_load((const f32x4*)(xr + 512 * (j >> 1) + 4 * (j & 1))); }
            __builtin_amdgcn_sched_barrier(0);
            float s = 0.f;
#pragma unroll
            for (int j = 0; j < 4; ++j) s += (v[j].x * v[j].x + v[j].y * v[j].y) + (v[j].z * v[j].z + v[j].w * v[j].w);
            f32x4 ga = (f32x4){0.f, 0.f, 0.f, 0.f}, gb = (f32x4){0.f, 0.f, 0.f, 0.f};
#pragma unroll
            for (int j = 0; j < 4; ++j) { const f32x4 xw = v[j] * pw[j];
#pragma unroll
                for (int e = 0; e < 4; ++e) { ga += wga[4 * j + e] * xw[e]; gb += wgb[4 * j + e] * xw[e]; } }
            s = wave_sum(s);
            const float rstd = 1.0f / sqrtf(s * (1.f / DM) + EPS);
            f32x4 g4;
#pragma unroll
            for (int i = 0; i < 4; ++i) { const float keep = up32 ? gb[i] : ga[i], send = up32 ? ga[i] : gb[i]; g4[i] = keep + __shfl_xor(send, 32); }
            const float k0 = up16 ? g4[2] : g4[0], s0 = up16 ? g4[0] : g4[2], k1 = up16 ? g4[3] : g4[1], s1 = up16 ? g4[1] : g4[3];
            const float g2a = k0 + __shfl_xor(s0, 16), g2b = k1 + __shfl_xor(s1, 16);
            const float kk = up8 ? g2b : g2a, sd = up8 ? g2a : g2b; float g1 = kk + __shfl_xor(sd, 8);
            g1 += __shfl_xor(g1, 4); g1 += __shfl_xor(g1, 2); g1 += __shfl_xor(g1, 1);
#pragma unroll
            for (int jj = 0; jj < 2; ++jj) { const f32x4 u0 = v[2 * jj] * rstd * pw[2 * jj], u1 = v[2 * jj + 1] * rstd * pw[2 * jj + 1];
                v4u o; o.x = pk2(u0.x, u0.y); o.y = pk2(u0.z, u0.w); o.z = pk2(u1.x, u1.y); o.w = pk2(u1.z, u1.w);
                *(v4u*)(F.U + (size_t)m * DM + 512 * jj + 8 * F.lane) = o; }
            const float pre = g1 * rstd + bsel;
            const float lsg = fminf(pre, 0.f) - 0.6931471805599453f * __builtin_amdgcn_logf(1.f + __builtin_amdgcn_exp2f(-fabsf(pre) * 1.4426950408889634f));
            if ((F.lane & 7) == 0) F.GATES[(size_t)m * 8 + gq] = gq < 4 ? pre : lsg;
        }
    } else {
        const int ow = (int)blockIdx.x * 2 + (F.wave - 6), now = (int)gridDim.x * 2;
        LAS float* scr = (LAS float*)(F.lds + F.wave * 16384);
        constexpr int I_IN = 16 * 144, I_O = 16 * 32, I_G = 16 * 32, I_U = 4 * 32, NIT = I_IN + I_O + I_G + I_U;
        for (int it = ow; it < NIT; it += now) {
            int r = it;
            if (r < I_IN) { p0_transpose_item(F.w_in, DM, NIN, 144, F.WT_IN, scr, r, F.lane); continue; } r -= I_IN;
            if (r < I_O) { p0_transpose_item(F.w_out, DM, DM, 32, F.WT_OUT, scr, r, F.lane); continue; } r -= I_O;
            if (r < I_G) { p0_transpose_item(F.w_gate, DM, DM, 32, F.WT_GATE, scr, r, F.lane); continue; } r -= I_G;
            p0_transpose_item(F.w_up, PLE, DM, 32, F.WT_UP, scr, r, F.lane);
        }
        const size_t NT8 = (size_t)MTOK * PLE / 8, stride = (size_t)now * 64;
        for (size_t i0 = (size_t)ow * 64 + F.lane; i0 < NT8; i0 += 4 * stride) {
            f32x4 a[4], b[4];
#pragma unroll
            for (int k = 0; k < 4; ++k) { const size_t i = i0 + k * stride; if (i < NT8) { a[k] = __builtin_nontemporal_load((const f32x4*)(F.p + i * 8)); b[k] = __builtin_nontemporal_load((const f32x4*)(F.p + i * 8 + 4)); } }
#pragma unroll
            for (int k = 0; k < 4; ++k) { const size_t i = i0 + k * stride; if (i < NT8) { v4u o; o.x = pk2(a[k].x, a[k].y); o.y = pk2(a[k].z, a[k].w); o.z = pk2(b[k].x, b[k].y); o.w = pk2(b[k].z, b[k].w); *(v4u*)(F.PB + i * 8) = o; } }
        }
    }
    SUBSTAMP(1);
    SUBSTAMP(2);
}

__device__ __forceinline__ void phase_conv(Ctx& F) {
    const size_t NITEM = (size_t)MTOK * 128;
    for (size_t it = (size_t)blockIdx.x * 512 + F.tid; it < NITEM; it += (size_t)gridDim.x * 512) {
        const int row = (int)(it >> 7), c0 = (int)(it & 127) * 8, t = row & (SEQ - 1);
        float acc[8];
#pragma unroll
        for (int e = 0; e < 8; ++e) acc[e] = F.conv_b[c0 + e];
#pragma unroll
        for (int j = 0; j < 4; ++j) {
            if (t - 3 + j < 0) continue;
            const v4u r = *(const v4u*)(F.PROJ + (size_t)(row - 3 + j) * NPROJ + C_MLQ + c0);
            const f32x4 w0 = *(const f32x4*)(F.conv_w + j * 1024 + c0), w1 = *(const f32x4*)(F.conv_w + j * 1024 + c0 + 4);
            acc[0] += w0.x * bflo(r.x); acc[1] += w0.y * bfhi(r.x); acc[2] += w0.z * bflo(r.y); acc[3] += w0.w * bfhi(r.y);
            acc[4] += w1.x * bflo(r.z); acc[5] += w1.y * bfhi(r.z); acc[6] += w1.z * bflo(r.w); acc[7] += w1.w * bfhi(r.w);
        }
        const float sc = c0 >= 512 ? 0.08838834764831845f : 1.0f;
#pragma unroll
        for (int e = 0; e < 8; ++e) acc[e] = siluf_(acc[e]) * sc;
        v4u o; o.x = pk2(acc[0], acc[1]); o.y = pk2(acc[2], acc[3]); o.z = pk2(acc[4], acc[5]); o.w = pk2(acc[6], acc[7]);
        *(v4u*)(F.QKC + (size_t)row * 1024 + c0) = o;
    }
}

__device__ __forceinline__ void phase_norm(Ctx& F) {
    f32x4 pw[4];
#pragma unroll
    for (int j = 0; j < 2; ++j) { pw[2 * j] = *(const f32x4*)(F.post_w + 512 * j + 8 * F.lane); pw[2 * j + 1] = *(const f32x4*)(F.post_w + 512 * j + 8 * F.lane + 4); }
    v4u yn[2]; f32x4 xn[4];
#define NLOAD(m_) do { const v4u* yr_ = (const v4u*)(F.Y2 + (size_t)(m_) * DM) + F.lane; yn[0] = yr_[0]; yn[1] = yr_[64]; \
        const float* xp_ = F.x + (size_t)(m_) * DM + 8 * F.lane; xn[0] = __builtin_nontemporal_load((const f32x4*)xp_); xn[1] = __builtin_nontemporal_load((const f32x4*)(xp_ + 4)); xn[2] = __builtin_nontemporal_load((const f32x4*)(xp_ + 512)); xn[3] = __builtin_nontemporal_load((const f32x4*)(xp_ + 516)); } while (0)
    const int RPW4 = MTOK / F.NGW, m0 = (xcd_vblk() * 8 + F.wave) * RPW4, m1 = m0 + RPW4;
    NLOAD(m0);
    for (int m = m0; m < m1; ++m) {
        v4u yc[2] = {yn[0], yn[1]}; f32x4 xc[4] = {xn[0], xn[1], xn[2], xn[3]};
        NLOAD(m + 1 < m1 ? m + 1 : m);
        __builtin_amdgcn_sched_barrier(0);
        float y[16]; float s = 0.f;
#pragma unroll
        for (int j = 0; j < 2; ++j) { const v4u r = yc[j];
            y[8 * j + 0] = bflo(r.x); y[8 * j + 1] = bfhi(r.x); y[8 * j + 2] = bflo(r.y); y[8 * j + 3] = bfhi(r.y);
            y[8 * j + 4] = bflo(r.z); y[8 * j + 5] = bfhi(r.z); y[8 * j + 6] = bflo(r.w); y[8 * j + 7] = bfhi(r.w); }
#pragma unroll
        for (int e = 0; e < 16; ++e) s += y[e] * y[e];
        const float rstd = 1.0f / sqrtf(wave_sum(s) * (1.f / DM) + EPS);
#pragma unroll
        for (int j = 0; j < 2; ++j) {
            const int c = 512 * j + 8 * F.lane; const size_t o = (size_t)m * DM + c;
            f32x4 h0, h1;
#pragma unroll
            for (int e = 0; e < 4; ++e) { h0[e] = xc[2 * j][e] + y[8 * j + e] * rstd * pw[2 * j][e]; h1[e] = xc[2 * j + 1][e] + y[8 * j + 4 + e] * rstd * pw[2 * j + 1][e]; }
            v4u hb; hb.x = pk2(h0[0], h0[1]); hb.y = pk2(h0[2], h0[3]); hb.z = pk2(h1[0], h1[1]); hb.w = pk2(h1[2], h1[3]);
            *(v4u*)(F.HB + o) = hb;
        }
    }
#undef NLOAD
}
#define XB_TMO      128
#define XB_XCNT(j)  (256  + 64 * (j))
#define XB_XSUB(j)  (1280 + 64 * (j))
#define XB_XGEN(j)  (2304 + 64 * (j))
#define XB_TOP      3328
#define XB_TOPGEN   3392
#define XCD_BAR_WORDS 3456
#define XB_SPIN_CAP (1u << 18)

__device__ __forceinline__ unsigned xb_ld(unsigned* p)              { return __hip_atomic_load(p, __ATOMIC_RELAXED, __HIP_MEMORY_SCOPE_AGENT); }
__device__ __forceinline__ unsigned xb_add(unsigned* p, unsigned v) { return __hip_atomic_fetch_add(p, v, __ATOMIC_RELAXED, __HIP_MEMORY_SCOPE_AGENT); }
__device__ __forceinline__ unsigned xb_xcc_id() { return (unsigned)__builtin_amdgcn_s_getreg((3 << 11) | 20) & 0xFu; }
#define XB_SPIN(cond, bar) do { unsigned _sp = 0; while (cond) { __builtin_amdgcn_s_sleep(1); \
    if ((++_sp & 255u) == 0u) { if (xb_ld(&(bar)[XB_TMO])) break; if (_sp > XB_SPIN_CAP) { atomicAdd(&(bar)[XB_TMO], 1u); break; } } } } while (0)

struct XcdBarrier {
    unsigned* bar; unsigned x;
    volatile LAS unsigned* st;
};

__device__ __forceinline__ XcdBarrier xcd_barrier_post(unsigned* bar, volatile LAS unsigned* st) {
    XcdBarrier b; b.bar = bar; b.x = xb_xcc_id(); b.st = st;
    if (threadIdx.x == 0) (void)xb_add(&bar[XB_XCNT(b.x)], 1u);
    return b;
}
__device__ __forceinline__ void xcd_barrier_complete(unsigned* bar, unsigned x, unsigned& nloc, unsigned& nx) {
    const unsigned G = gridDim.x * gridDim.y * gridDim.z;
    unsigned sum, cnt, mine, sp = 0u;
    for (;;) {
        sum = 0u; cnt = 0u; mine = 0u;
#pragma unroll
        for (unsigned j = 0; j < 16; ++j) { const unsigned c = xb_ld(&bar[XB_XCNT(j)]); sum += c; cnt += (c > 0u) ? 1u : 0u; mine = (j == x) ? c : mine; }
        if (sum == G) break;
        __builtin_amdgcn_s_sleep(1);
        if ((++sp & 255u) == 0u) { if (xb_ld(&bar[XB_TMO])) break; if (sp > XB_SPIN_CAP) { atomicAdd(&bar[XB_TMO], 1u); break; } }
    }
    nloc = mine > 0u ? mine : 1u; nx = cnt > 0u ? cnt : 1u;
}

__device__ __forceinline__ void xcd_barrier(const XcdBarrier& b) {
    asm volatile("s_waitcnt vmcnt(0)" ::: "memory");
    __syncthreads();
    if (threadIdx.x == 0) {
        unsigned* bar = b.bar;
        __builtin_amdgcn_s_waitcnt(0);
        unsigned nloc = b.st[0], nx = b.st[1];
        if (nloc == 0u) { xcd_barrier_complete(bar, b.x, nloc, nx); b.st[0] = nloc; b.st[1] = nx; }
        const unsigned old = xb_add(&bar[XB_XSUB(b.x)], 1u);
        const unsigned gen = old / nloc;
        if (old + 1u == (gen + 1u) * nloc) {
            __builtin_amdgcn_fence(__ATOMIC_RELEASE, "agent");
            asm volatile("s_waitcnt vmcnt(0)" ::: "memory");
            const unsigned og = xb_add(&bar[XB_TOP], 1u);
            const unsigned tg = og / nx;
            if (og + 1u == (tg + 1u) * nx) xb_add(&bar[XB_TOPGEN], 1u);
            else XB_SPIN(xb_ld(&bar[XB_TOPGEN]) == tg, bar);
            __builtin_amdgcn_fence(__ATOMIC_ACQUIRE, "agent");
            xb_add(&bar[XB_XGEN(b.x)], 1u);
            asm volatile("s_waitcnt vmcnt(0)" ::: "memory");
        } else {
            XB_SPIN(xb_ld(&bar[XB_XGEN(b.x)]) == gen, bar);
            __builtin_amdgcn_fence(__ATOMIC_ACQUIRE, "agent");
            asm volatile("s_waitcnt vmcnt(0)" ::: "memory");
        }
    }
    __syncthreads();
}

typedef short v4i16_t __attribute__((ext_vector_type(4)));
typedef float f32x2_t __attribute__((ext_vector_type(2)));
typedef __bf16 bf16x2_t __attribute__((ext_vector_type(2)));
__device__ __forceinline__ unsigned cvtpk(float lo, float hi) { f32x2_t v = {lo, hi}; bf16x2_t b = __builtin_convertvector(v, bf16x2_t); return __builtin_bit_cast(unsigned, b); }
__device__ __forceinline__ s16x4 vtr(const LAS unsigned char* p) { return __builtin_bit_cast(s16x4, __builtin_amdgcn_ds_read_tr16_b64_v4i16((LAS v4i16_t*)p)); }
__device__ __forceinline__ bf16x8 pack8(const f32x16& x, int s) {
    v4u p; p.x = cvtpk(x[8 * s + 0], x[8 * s + 1]); p.y = cvtpk(x[8 * s + 2], x[8 * s + 3]); p.z = cvtpk(x[8 * s + 4], x[8 * s + 5]); p.w = cvtpk(x[8 * s + 6], x[8 * s + 7]);
    return __builtin_bit_cast(bf16x8, p);
}
template <bool MASK> __device__ __forceinline__ void sb_half(f32x16& p, float& R, int kbase, int t, int hi) {
    float lk[16];
#pragma unroll
    for (int i = 0; i < 16; ++i) {
        const float z = p[i];
        float v = -(fmaxf(z, 0.f) + __builtin_amdgcn_logf(1.f + __builtin_amdgcn_exp2f(-fabsf(z))));
        if (MASK) { const int key = kbase + (i & 3) + 8 * (i >> 2); v = key < t ? v : 0.f; }
        lk[i] = v;
    }
#pragma unroll
    for (int g = 0; g < 4; ++g) { lk[4 * g + 2] += lk[4 * g + 3]; lk[4 * g + 1] += lk[4 * g + 2]; lk[4 * g] += lk[4 * g + 1]; }
    float Glo[4], Ghi[4];
#pragma unroll
    for (int g = 0; g < 4; ++g) {
        const unsigned xb = __float_as_uint(lk[4 * g]); const auto rr = __builtin_amdgcn_permlane32_swap(xb, xb, false, false);
        Glo[g] = __uint_as_float(rr[0]); Ghi[g] = __uint_as_float(rr[1]); }
    float acc = R;
#pragma unroll
    for (int g = 3; g >= 0; --g) {
        const float off1 = acc, off0 = acc + Ghi[g]; acc = off0 + Glo[g];
        const float off = hi ? off1 : off0;
#pragma unroll
        for (int e = 0; e < 4; ++e) { const int i = 4 * g + e;
            float a = __builtin_amdgcn_exp2f(p[i] + (lk[i] + off));
            if (MASK) { const int key = kbase + (i & 3) + 8 * (i >> 2); a = key < t ? a : 0.f; }
            p[i] = a; }
    }
    R = acc;
}
__device__ __forceinline__ void attn_fast(Ctx& F, unsigned* ctr) {
    constexpr int VP = 144;
    LAS unsigned char* vt = F.lds + F.wave * 16384;
    int lane_ = F.lane; asm volatile("" : "+v"(lane_));
    const int lane = lane_, r32 = lane & 31, hi = lane >> 5;
    const int i16 = lane & 15, tq = i16 >> 2, tp = i16 & 3, blk = (lane >> 4) & 1;
    const int troff = (4 * hi + tq) * VP + (16 * blk + 4 * tp) * 2;
    const int vblk = (gridDim.x & 7) == 0 ? (int)(blockIdx.x & 7) * (int)(gridDim.x >> 3) + (int)(blockIdx.x >> 3) : (int)blockIdx.x;
    constexpr int NU = NB * 8 * (SEQ / 32);
#define LOAD_KV(KF, VR, KB_, VB_, k0_) do { const bf16* kp_ = (KB_) + (size_t)((k0_) + r32) * 64 + 8 * hi; \
            _Pragma("unroll") for (int hh = 0; hh < 2; ++hh) _Pragma("unroll") for (int d0 = 0; d0 < 4; ++d0) KF[hh][d0] = *(const bf16x8*)(kp_ + hh * 32 * 64 + 16 * d0); \
            const bf16* vp_ = (VB_) + (size_t)(k0_) * 64 + 8 * lane; \
            _Pragma("unroll") for (int i = 0; i < 8; ++i) VR[i] = *(const v4u*)(vp_ + 512 * i); } while (0)
#define LOAD_Q(QB_, t_) do { const bf16* qp_ = (QB_) + (size_t)(t_) * 64 + 8 * hi; _Pragma("unroll") for (int d0 = 0; d0 < 4; ++d0) qr[d0] = *(const bf16x8*)(qp_ + 16 * d0); } while (0)
    bf16x8 qr[4]; bf16x8 kf[2][4]; v4u vr[8];
    int unit = vblk * 8 + F.wave;
    if (unit < NU) {
        const int bh = unit >> 7, qb = unit & 127, b = bh >> 3, h = bh & 7, q0 = 32 * qb;
        LOAD_Q(F.PROJ + sb_off(0, b, h), q0 + r32);
        LOAD_KV(kf, vr, F.PROJ + sb_off(1, b, h), F.PROJ + sb_off(2, b, h), 64 * ((q0 + 31) >> 6));
    }
    while (unit < NU) {
        const int bh = unit >> 7, qb = unit & 127, b = bh >> 3, h = bh & 7, q0 = 32 * qb, t = q0 + r32;
        const bf16* kbase = F.PROJ + sb_off(1, b, h); const bf16* vbase = F.PROJ + sb_off(2, b, h); const bf16* zbase = F.PROJ + sb_off(3, b, h);
        const int kt = (q0 + 31) >> 6;
        f32x16 o[2];
#pragma unroll
        for (int i = 0; i < 16; ++i) { o[0][i] = 0.f; o[1][i] = 0.f; }
        float R = 0.f;
        for (int it = kt; it >= 0; --it) {
            const int k0 = 64 * it;
            asm volatile("" ::: "memory");
#pragma unroll
            for (int i = 0; i < 8; ++i) *(LAS v4u*)(vt + (8 * i + (lane >> 3)) * VP + 16 * (lane & 7)) = vr[i];
            asm volatile("" ::: "memory");
            bf16x8 kc[2][4];
#pragma unroll
            for (int hh = 0; hh < 2; ++hh)
#pragma unroll
                for (int d0 = 0; d0 < 4; ++d0) kc[hh][d0] = kf[hh][d0];
            if (it > 0) LOAD_KV(kf, vr, kbase, vbase, k0 - 64);
            const bool first = (it == kt);
            const bool do_hi = !first || (k0 + 32 <= q0 + 30);
            f32x16 p0, p1;
#pragma unroll
            for (int i = 0; i < 16; ++i) { p0[i] = 0.f; p1[i] = 0.f; }
#pragma unroll
            for (int d0 = 0; d0 < 4; ++d0) p0 = __builtin_amdgcn_mfma_f32_32x32x16_bf16(kc[0][d0], qr[d0], p0, 0, 0, 0);
            if (do_hi) {
#pragma unroll
                for (int d0 = 0; d0 < 4; ++d0) p1 = __builtin_amdgcn_mfma_f32_32x32x16_bf16(kc[1][d0], qr[d0], p1, 0, 0, 0);
                if (first) sb_half<true>(p1, R, k0 + 32 + 4 * hi, t, hi); else sb_half<false>(p1, R, k0 + 32 + 4 * hi, t, hi);
            }
            const bool do_lo = !(do_hi && __all(R < -151.f));
            if (do_lo) { if (first) sb_half<true>(p0, R, k0 + 4 * hi, t, hi); else sb_half<false>(p0, R, k0 + 4 * hi, t, hi); }
#pragma unroll
            for (int hh = 1; hh >= 0; --hh) {
                if (hh == 1 && !do_hi) continue;
                if (hh == 0 && !do_lo) continue;
#pragma unroll
                for (int s = 0; s < 2; ++s) {
                    const bf16x8 pa = pack8(hh ? p1 : p0, s);
#pragma unroll
                    for (int dh = 0; dh < 2; ++dh) {
                        const LAS unsigned char* vb = vt + troff + (32 * hh + 16 * s) * VP + 64 * dh;
                        const s16x4 lo = vtr(vb), hi4 = vtr(vb + 8 * VP);
                        const bf16x8 vf = {lo[0], lo[1], lo[2], lo[3], hi4[0], hi4[1], hi4[2], hi4[3]};
                        o[dh] = __builtin_amdgcn_mfma_f32_32x32x16_bf16(pa, vf, o[dh], 0, 0, 0);
                    }
                }
            }
            if (!do_lo || __all(R < -151.f)) break;
        }
        asm volatile("" ::: "memory");
        LAS float* os = (LAS float*)vt;
#pragma unroll
        for (int dh = 0; dh < 2; ++dh)
#pragma unroll
            for (int i = 0; i < 16; ++i) os[((i & 3) + 8 * (i >> 2) + 4 * hi) * 65 + 32 * dh + r32] = o[dh][i];
        asm volatile("" ::: "memory");
        const int q = lane >> 1, hf = lane & 1;
        v4u zr4[4];
#pragma unroll
        for (int c = 0; c < 4; ++c) zr4[c] = *(const v4u*)(zbase + (size_t)(q0 + q) * 64 + 32 * hf + 8 * c);
        const int nunit = unit + F.NGW;
        if (nunit < NU) {
            const int nbh = nunit >> 7, nqb = nunit & 127, nb = nbh >> 3, nh = nbh & 7, nq0 = 32 * nqb;
            LOAD_Q(F.PROJ + sb_off(0, nb, nh), nq0 + r32);
            LOAD_KV(kf, vr, F.PROJ + sb_off(1, nb, nh), F.PROJ + sb_off(2, nb, nh), 64 * ((nq0 + 31) >> 6));
        }
        float ov[32]; float ss = 0.f;
#pragma unroll
        for (int e = 0; e < 32; ++e) { ov[e] = os[q * 65 + 32 * hf + e]; ss += ov[e] * ov[e]; }
        ss += __shfl_xor(ss, 1);
        const float rstd = 1.0f / sqrtf(ss * (1.f / 64.f) + EPS);
        const size_t row = (size_t)b * SEQ + q0 + q;
        const int c0 = h * 64 + 32 * hf;
#pragma unroll
        for (int c = 0; c < 4; ++c) {
            const v4u zr = zr4[c];
            const f32x4 w0 = *(const f32x4*)(F.sb_w + c0 + 8 * c), w1 = *(const f32x4*)(F.sb_w + c0 + 8 * c + 4);
            v4u w;
            w.x = pk2(ov[8 * c + 0] * rstd * w0.x * siluf_(bflo(zr.x)), ov[8 * c + 1] * rstd * w0.y * siluf_(bfhi(zr.x)));
            w.y = pk2(ov[8 * c + 2] * rstd * w0.z * siluf_(bflo(zr.y)), ov[8 * c + 3] * rstd * w0.w * siluf_(bfhi(zr.y)));
            w.z = pk2(ov[8 * c + 4] * rstd * w1.x * siluf_(bflo(zr.z)), ov[8 * c + 5] * rstd * w1.y * siluf_(bfhi(zr.z)));
            w.w = pk2(ov[8 * c + 6] * rstd * w1.z * siluf_(bflo(zr.w)), ov[8 * c + 7] * rstd * w1.w * siluf_(bfhi(zr.w)));
            *(v4u*)(F.Y + row * DM + c0 + 8 * c) = w;
        }
        asm volatile("" ::: "memory");
        unit = nunit;
    }
#undef LOAD_KV
#undef LOAD_Q
}
__device__ __forceinline__ void attn32k(Ctx& F) {
    constexpr int VP = 144;
    LAS unsigned char* vt = F.lds + F.wave * 16384;
    int lane_ = F.lane; asm volatile("" : "+v"(lane_));
    const int lane = lane_, r32 = lane & 31, hi = lane >> 5;
    const int i16 = lane & 15, tq = i16 >> 2, tp = i16 & 3, blk = (lane >> 4) & 1;
    const int troff = (4 * hi + tq) * VP + (16 * blk + 4 * tp) * 2;
    const int vblk = (gridDim.x & 7) == 0 ? (int)(blockIdx.x & 7) * (int)(gridDim.x >> 3) + (int)(blockIdx.x >> 3) : (int)blockIdx.x;
    constexpr int NU = NB * 8 * (SEQ / 32);
#define A32_LOAD(KF, VR, s_) do { const bf16* kp_ = kbase + (size_t)(32 * (s_)) * 64 + 8 * lane; \
        _Pragma("unroll") for (int i = 0; i < 4; ++i) KF[i] = *(const bf16x8*)(kp_ + 512 * i);     \
        const bf16* vp_ = vbase + (size_t)(32 * (s_)) * 64 + 8 * lane; \
        _Pragma("unroll") for (int i = 0; i < 4; ++i) VR[i] = *(const v4u*)(vp_ + 512 * i); } while (0)
#define A32_STEP(KF, VR, s_, MASKED) do { \
        asm volatile("" ::: "memory"); \
        _Pragma("unroll") for (int i = 0; i < 4; ++i) { *(LAS v4u*)(vt + (8 * i + (lane >> 3)) * VP + 16 * (lane & 7)) = VR[i]; \
            *(LAS bf16x8*)(vt + 4608 + (8 * i + (lane >> 3)) * VP + 16 * (lane & 7)) = KF[i]; } \
        asm volatile("" ::: "memory"); \
        f32x16 p; _Pragma("unroll") for (int i = 0; i < 16; ++i) p[i] = 0.f; \
        _Pragma("unroll") for (int d0 = 0; d0 < 4; ++d0) { const bf16x8 kfr = *(const LAS bf16x8*)(vt + 4608 + r32 * VP + 32 * d0 + 16 * hi); \
            p = __builtin_amdgcn_mfma_f32_32x32x16_bf16(kfr, qr[d0], p, 0, 0, 0); } \
        asm volatile("" ::: "memory"); \
        A32_LOAD(KF, VR, ((s_) >= 2 ? (s_) - 2 : 0));     \
        if (MASKED) sb_half<true>(p, R, 32 * (s_) + 4 * hi, t, hi); else sb_half<false>(p, R, 32 * (s_) + 4 * hi, t, hi); \
        _Pragma("unroll") for (int ks = 0; ks < 2; ++ks) { const bf16x8 pa = pack8(p, ks); \
            _Pragma("unroll") for (int dh = 0; dh < 2; ++dh) { const LAS unsigned char* vb = vt + troff + (16 * ks) * VP + 64 * dh; \
                const s16x4 lo = vtr(vb), hi4 = vtr(vb + 8 * VP); const bf16x8 vf = {lo[0], lo[1], lo[2], lo[3], hi4[0], hi4[1], hi4[2], hi4[3]}; \
                o[dh] = __builtin_amdgcn_mfma_f32_32x32x16_bf16(pa, vf, o[dh], 0, 0, 0); } } } while (0)
    const bool aligned = gridDim.x == 256;
    const int ubase = aligned ? (vblk >> 5) * 1024 + (vblk & 31) * 8 + F.wave : vblk * 8 + F.wave, ustep = aligned ? 256 : F.NGW, uend = aligned ? (vblk >> 5) * 1024 + 1024 : NU;
    for (int unit = ubase; unit < uend; unit += ustep) {
        const int bh = unit >> 7, qb = unit & 127, b = bh >> 3, h = bh & 7, q0 = 32 * qb, t = q0 + r32;
        const bf16* qbase = F.PROJ + sb_off(0, b, h); const bf16* kbase = F.PROJ + sb_off(1, b, h); const bf16* vbase = F.PROJ + sb_off(2, b, h); const bf16* zbase = F.PROJ + sb_off(3, b, h);
        bf16x8 qr[4], kfA[4], kfB[4]; v4u vrA[4], vrB[4];
        { const bf16* qp = qbase + (size_t)t * 64 + 8 * hi;
#pragma unroll
          for (int d0 = 0; d0 < 4; ++d0) qr[d0] = *(const bf16x8*)(qp + 16 * d0); }
        A32_LOAD(kfA, vrA, qb);
        A32_LOAD(kfB, vrB, (qb >= 1 ? qb - 1 : 0));
        f32x16 o[2];
#pragma unroll
        for (int i = 0; i < 16; ++i) { o[0][i] = 0.f; o[1][i] = 0.f; }
        float R = 0.f;
        A32_STEP(kfA, vrA, qb, true);
        for (int s = qb - 1; s >= 0; s -= 2) {
            if (__all(R < -151.f)) break;
            A32_STEP(kfB, vrB, s, false);
            if (s == 0 || __all(R < -151.f)) break;
            A32_STEP(kfA, vrA, s - 1, false);
        }
        asm volatile("" ::: "memory");
        LAS float* os = (LAS float*)vt;
#pragma unroll
        for (int dh = 0; dh < 2; ++dh)
#pragma unroll
            for (int i = 0; i < 16; ++i) os[((i & 3) + 8 * (i >> 2) + 4 * hi) * 65 + 32 * dh + r32] = o[dh][i];
        asm volatile("" ::: "memory");
        const int q = lane >> 1, hf = lane & 1;
        float ov[32]; float ss = 0.f;
#pragma unroll
        for (int e = 0; e < 32; ++e) { ov[e] = os[q * 65 + 32 * hf + e]; ss += ov[e] * ov[e]; }
        ss += __shfl_xor(ss, 1);
        const float rstd = 1.0f / sqrtf(ss * (1.f / 64.f) + EPS);
        const size_t row = (size_t)b * SEQ + q0 + q;
        const int c0 = h * 64 + 32 * hf;
#pragma unroll
        for (int c = 0; c < 4; ++c) {
            const v4u zr = *(const v4u*)(zbase + (size_t)(q0 + q) * 64 + 32 * hf + 8 * c);
            const f32x4 w0 = *(const f32x4*)(F.sb_w + c0 + 8 * c), w1 = *(const f32x4*)(F.sb_w + c0 + 8 * c + 4);
            v4u w;
            w.x = pk2(ov[8 * c + 0] * rstd * w0.x * siluf_(bflo(zr.x)), ov[8 * c + 1] * rstd * w0.y * siluf_(bfhi(zr.x)));
            w.y = pk2(ov[8 * c + 2] * rstd * w0.z * siluf_(bflo(zr.y)), ov[8 * c + 3] * rstd * w0.w * siluf_(bfhi(zr.y)));
            w.z = pk2(ov[8 * c + 4] * rstd * w1.x * siluf_(bflo(zr.z)), ov[8 * c + 5] * rstd * w1.y * siluf_(bfhi(zr.z)));
            w.w = pk2(ov[8 * c + 6] * rstd * w1.z * siluf_(bflo(zr.w)), ov[8 * c + 7] * rstd * w1.w * siluf_(bfhi(zr.w)));
            *(v4u*)(F.Y + row * DM + c0 + 8 * c) = w;
        }
        asm volatile("" ::: "memory");
    }
#undef A32_LOAD
#undef A32_STEP
}
constexpr int SL_N = 16384, SL_SC = 16512, SL_STRIDE = 16640;
__device__ __forceinline__ v4u scale8(v4u r, float s) {
    v4u o; o.x = cvtpk(bflo(r.x) * s, bfhi(r.x) * s); o.y = cvtpk(bflo(r.y) * s, bfhi(r.y) * s); o.z = cvtpk(bflo(r.z) * s, bfhi(r.z) * s); o.w = cvtpk(bflo(r.w) * s, bfhi(r.w) * s); return o;
}
template <int PASS> __device__ __forceinline__ void mlstm_fast(Ctx& F, float* SLOC) {
    constexpr int PT = 272, SP = 144, HP = 129;
    constexpr int L_Q = 0, L_K = 17408, L_V = 34816, L_VW = 52224, L_S = 69632, L_H = 78848, L_SC = 111872;
    constexpr int L_RAWQ = L_S, L_RAWK = L_S + 17408;
    constexpr int L_HALO = L_SC + 1024, L_CW = L_HALO + 3072;
    static_assert(L_RAWK + 17408 <= L_SC && L_CW + 5120 + 6144 <= 131072, "mLSTM LDS map");
    LAS unsigned char* L = F.lds;
    LAS float* su = (LAS float*)(L + L_SC); LAS float* sM = su + 64; LAS float* sb = su + 128; LAS bf16* swb = (LAS bf16*)(su + 192);
    LAS float* Hs = (LAS float*)(L + L_H);
    const int nunits = PASS == 1 ? NB * 4 * 7 : NB * 4 * 8;
    for (int unit = xcd_vblk(); unit < nunits; unit += gridDim.x) {
        int tid_ = F.tid; asm volatile("" : "+v"(tid_));
        const int tid = tid_, lane = tid & 63, w = __builtin_amdgcn_readfirstlane(tid >> 6), fr = lane & 15, fq = lane >> 4, tq = fr >> 2, tp = fr & 3;
        const int srow = tid >> 3, sc8 = tid & 7, v0 = 16 * w;
        int bh, seg; if (PASS == 1) { bh = unit / 7; seg = unit % 7; } else { bh = unit >> 3; seg = unit & 7; }
        const int b = bh >> 2, h = bh & 3;
        const size_t row0 = (size_t)b * SEQ + (size_t)seg * 512;
        f32x4 X[8], Xn[8];
#pragma unroll
        for (int t = 0; t < 8; ++t) { X[t] = (f32x4){0.f, 0.f, 0.f, 0.f}; Xn[t] = (f32x4){0.f, 0.f, 0.f, 0.f}; }
        float m_prev = PASS == 1 ? -1e30f : 0.f, bsum = 0.f;
        if (PASS == 2) {
            for (int j = 0; j < seg; ++j) {
                const float* S = SLOC + (size_t)(bh * 7 + j) * SL_STRIDE;
                const float mloc = S[SL_SC], Bs = S[SL_SC + 1];
                const float m_new = fmaxf(Bs + m_prev, mloc), fa = __expf(Bs + m_prev - m_new), fg = __expf(mloc - m_new);
#pragma unroll
                for (int t = 0; t < 8; ++t) { const f32x4 cl = *(const f32x4*)(S + (size_t)(t * 512 + tid) * 4); X[t] = X[t] * fa + cl * fg;
                    const f32x4 nl = *(const f32x4*)(S + SL_N + 16 * t + 4 * fq); Xn[t] = Xn[t] * fa + nl * fg; }
                m_prev = m_new;
            }
        }
        LDS_BARRIER();
        { LAS float* gsc = (LAS float*)(L + L_CW + 5120);
          const float* gg = F.GATES + (row0 + tid) * 8; const float ig0 = gg[h]; float bc0 = gg[4 + h];
#pragma unroll
          for (int o = 1; o < 64; o <<= 1) { const float t_ = __shfl_up(bc0, o); if (lane >= o) bc0 += t_; }
          const float u0 = ig0 - bc0; float pm0 = u0;
#pragma unroll
          for (int o = 1; o < 64; o <<= 1) { const float t_ = __shfl_up(pm0, o); if (lane >= o) pm0 = fmaxf(pm0, t_); }
          gsc[tid] = bc0; gsc[512 + tid] = u0; gsc[1024 + tid] = pm0; }
        { int tu = tid; asm volatile("" : "+v"(tu));
          LAS float* cw = (LAS float*)(L + L_CW);
          for (int e = tu; e < 1280; e += 512) { float val;
              if (e < 1024) { const int tn = e >> 9, j = (e >> 7) & 3, cch = e & 127; val = F.conv_w[j * 1024 + tn * 512 + h * 128 + cch]; }
              else { const int tn = (e - 1024) >> 7, cch = e & 127; val = F.conv_b[tn * 512 + h * 128 + cch]; }
              cw[e] = val; }
          if (tu < 96) { const int tn = tu >= 48 ? 1 : 0, r = (tu - 48 * tn) >> 4, c16 = tu & 15; v4u hv = (v4u){0u, 0u, 0u, 0u};
              if (seg > 0) hv = *(const v4u*)(F.PROJ + ml_off(tn ? 5 : 4, b, h) + (size_t)(seg * 512 - 3 + r) * 128 + 8 * c16);
              *(LAS v4u*)(L + L_HALO + (tn * 3 + r) * 256 + 16 * c16) = hv; } }
        v4u pq0, pq1, pk0, pk1, pv0, pv1;
#define MPREF(c_) do { const size_t tl_ = (size_t)(seg * 512 + (c_) * 64 + srow) * 128 + 8 * sc8; \
            if (PASS == 2) { const bf16* q_ = F.PROJ + ml_off(4, b, h) + tl_; pq0 = *(const v4u*)(q_); pq1 = *(const v4u*)(q_ + 64); } \
            { const bf16* k_ = F.PROJ + ml_off(5, b, h) + tl_; const bf16* vv_ = F.PROJ + ml_off(6, b, h) + tl_; \
              pk0 = *(const v4u*)(k_); pk1 = *(const v4u*)(k_ + 64); pv0 = *(const v4u*)(vv_); pv1 = *(const v4u*)(vv_ + 64); } \
            } while (0)
        MPREF(0);
        for (int c = 0; c < 8; ++c) {
            const size_t rowc = row0 + (size_t)c * 64;
            LDS_BARRIER();
            const LAS float* gsc = (const LAS float*)(L + L_CW + 5120);
            const float bc = gsc[c * 64 + lane], u = gsc[512 + c * 64 + lane], pm = gsc[1024 + c * 64 + lane];
            const float Mv = fmaxf(m_prev, pm), M63 = fmaxf(m_prev, gsc[1024 + c * 64 + 63]), blast = gsc[c * 64 + 63];
            const float wgt = __expf(u - M63);
            if (w == 0) { su[lane] = u; sM[lane] = Mv; sb[lane] = bc; swb[lane] = (bf16)(cvtpk(wgt, 0.f) & 0xffffu); }
            const float wrow = __expf(gsc[512 + c * 64 + srow] - M63);
            *(LAS v4u*)(L + L_RAWK + srow * PT + 16 * sc8) = pk0; *(LAS v4u*)(L + L_RAWK + srow * PT + 16 * (sc8 + 8)) = pk1;
            *(LAS v4u*)(L + L_VW + srow * PT + 16 * sc8) = scale8(pv0, wrow); *(LAS v4u*)(L + L_VW + srow * PT + 16 * (sc8 + 8)) = scale8(pv1, wrow);
            if (PASS == 2) {
                *(LAS v4u*)(L + L_RAWQ + srow * PT + 16 * sc8) = pq0; *(LAS v4u*)(L + L_RAWQ + srow * PT + 16 * (sc8 + 8)) = pq1;
                *(LAS v4u*)(L + L_V + srow * PT + 16 * sc8) = pv0; *(LAS v4u*)(L + L_V + srow * PT + 16 * (sc8 + 8)) = pv1;
            }
            LDS_BARRIER();
            { const int cgp = tid & 31, tn = cgp >> 4, c16 = cgp & 15, rg4 = tid >> 5;
              if (PASS == 2 || tn == 1) {
                  const LAS unsigned char* rawb = L + (tn ? L_RAWK : L_RAWQ) + 16 * c16;
                  const LAS unsigned char* halob = L + L_HALO + ((c & 1) * 6 + tn * 3) * 256 + 16 * c16;
#pragma unroll 1
                  for (int hf = 0; hf < 2; ++hf) {
                      v2u rw[7];
#pragma unroll
                      for (int i = 0; i < 7; ++i) { const int rr = 4 * rg4 - 3 + i; rw[i] = *(const LAS v2u*)((rr >= 0 ? rawb + rr * PT : halob + (3 + rr) * 256) + 8 * hf); }
                      const LAS float* cw = (const LAS float*)(L + L_CW) + tn * 512 + 8 * c16 + 4 * hf;
                      const f32x4 b0 = *(const LAS f32x4*)((const LAS float*)(L + L_CW) + 1024 + tn * 128 + 8 * c16 + 4 * hf);
                      f32x4 w0[4];
#pragma unroll
                      for (int j = 0; j < 4; ++j) w0[j] = *(const LAS f32x4*)(cw + j * 128);
                      const float sc = tn ? 0.08838834764831845f : 1.0f;
#pragma unroll
                      for (int o = 0; o < 4; ++o) {
                          f32x4 a0 = b0;
#pragma unroll
                          for (int j = 0; j < 4; ++j) { const v2u r = rw[o + j];
                              a0[0] += w0[j][0] * bflo(r.x); a0[1] += w0[j][1] * bfhi(r.x); a0[2] += w0[j][2] * bflo(r.y); a0[3] += w0[j][3] * bfhi(r.y); }
                          v2u ov; ov.x = cvtpk(siluf_(a0[0]) * sc, siluf_(a0[1]) * sc); ov.y = cvtpk(siluf_(a0[2]) * sc, siluf_(a0[3]) * sc);
                          *(LAS v2u*)(L + (tn ? L_K : L_Q) + (4 * rg4 + o) * PT + 16 * c16 + 8 * hf) = ov;
                      }
                      if (rg4 == 15) {
#pragma unroll
                          for (int r = 0; r < 3; ++r) *(LAS v2u*)(L + L_HALO + (((c + 1) & 1) * 6 + tn * 3 + r) * 256 + 16 * c16 + 8 * hf) = rw[4 + r];
                      }
                  }
              } }
            MPREF(c + 1 < 8 ? c + 1 : 7); __builtin_amdgcn_sched_barrier(0);
            v4u po0, po1, pz0, pz1;
            if (PASS == 2) { const size_t tl = (size_t)(seg * 512 + c * 64 + srow) * 128 + 16 * sc8;
                const bf16* op = F.PROJ + ml_off(7, b, h) + tl; const bf16* zp = F.PROJ + ml_off(8, b, h) + tl;
                po0 = *(const v4u*)(op); po1 = *(const v4u*)(op + 8); pz0 = *(const v4u*)(zp); pz1 = *(const v4u*)(zp + 8); }
            LDS_BARRIER();
            if (PASS == 2) {
                const int lt = w & 3, sp = w >> 2;
#pragma unroll
                for (int si = 0; si < 2; ++si) {
                    const int st = 2 * sp + si;
                    f32x4 acc = (f32x4){0.f, 0.f, 0.f, 0.f};
                    if (st <= lt) {
#pragma unroll
                        for (int ks = 0; ks < 4; ++ks) {
                            const bf16x8 ak = *(const LAS bf16x8*)(L + L_K + (16 * st + fr) * PT + (32 * ks + 8 * fq) * 2);
                            const bf16x8 bq = *(const LAS bf16x8*)(L + L_Q + (16 * lt + fr) * PT + (32 * ks + 8 * fq) * 2);
                            acc = __builtin_amdgcn_mfma_f32_16x16x32_bf16(ak, bq, acc, 0, 0, 0);
                        }
                        const f32x4 us = *(const LAS f32x4*)(su + 16 * st + 4 * fq); const float Ml = sM[16 * lt + fr];
                        const int l = 16 * lt + fr, s0 = 16 * st + 4 * fq;
#pragma unroll
                        for (int j = 0; j < 4; ++j) acc[j] = (s0 + j <= l) ? acc[j] * __expf(us[j] - Ml) : 0.f;
                    }
                    v2u pw; pw.x = cvtpk(acc[0], acc[1]); pw.y = cvtpk(acc[2], acc[3]);
                    *(LAS v2u*)(L + L_S + (16 * lt + fr) * SP + (16 * st + 4 * fq) * 2) = pw;
                }
                LDS_BARRIER();
                f32x4 num[4], den[4];
#pragma unroll
                for (int i = 0; i < 4; ++i) { num[i] = (f32x4){0.f, 0.f, 0.f, 0.f}; den[i] = (f32x4){0.f, 0.f, 0.f, 0.f}; }
#pragma unroll
                for (int kk = 0; kk < 4; ++kk) {
                    v4u bsw, bnw;
                    bsw.x = cvtpk(X[2 * kk][0], X[2 * kk][1]); bsw.y = cvtpk(X[2 * kk][2], X[2 * kk][3]); bsw.z = cvtpk(X[2 * kk + 1][0], X[2 * kk + 1][1]); bsw.w = cvtpk(X[2 * kk + 1][2], X[2 * kk + 1][3]);
                    bnw.x = cvtpk(Xn[2 * kk][0], Xn[2 * kk][1]); bnw.y = cvtpk(Xn[2 * kk][2], Xn[2 * kk][3]); bnw.z = cvtpk(Xn[2 * kk + 1][0], Xn[2 * kk + 1][1]); bnw.w = cvtpk(Xn[2 * kk + 1][2], Xn[2 * kk + 1][3]);
                    const bf16x8 bs = __builtin_bit_cast(bf16x8, bsw), bn = __builtin_bit_cast(bf16x8, bnw);
#pragma unroll
                    for (int i = 0; i < 4; ++i) {
                        const LAS unsigned char* qa = L + L_Q + (16 * i + fr) * PT + (32 * kk + 4 * fq) * 2;
                        const v2u lo = *(const LAS v2u*)qa, hi = *(const LAS v2u*)(qa + 32);
                        const v4u aw = {lo.x, lo.y, hi.x, hi.y}; const bf16x8 aq = __builtin_bit_cast(bf16x8, aw);
                        num[i] = __builtin_amdgcn_mfma_f32_16x16x32_bf16(aq, bs, num[i], 0, 0, 0);
                        den[i] = __builtin_amdgcn_mfma_f32_16x16x32_bf16(aq, bn, den[i], 0, 0, 0);
                    }
                    __builtin_amdgcn_sched_barrier(0);
                }
#pragma unroll
                for (int i = 0; i < 4; ++i) { const f32x4 Ml = *(const LAS f32x4*)(sM + 16 * i + 4 * fq);
#pragma unroll
                    for (int j = 0; j < 4; ++j) { const float cs = __expf(m_prev - Ml[j]); num[i][j] *= cs; den[i][j] *= cs; } }
                const v4u onesw = {0x3f803f80u, 0x3f803f80u, 0x3f803f80u, 0x3f803f80u}; const bf16x8 ones = __builtin_bit_cast(bf16x8, onesw);
#pragma unroll
                for (int ks = 0; ks < 2; ++ks) {
                    const LAS unsigned char* vb = L + L_V + (32 * ks + 8 * fq + tq) * PT + (v0 + 4 * tp) * 2;
                    const s16x4 lo = vtr(vb), hi4 = vtr(vb + 4 * PT);
                    const bf16x8 bv = {lo[0], lo[1], lo[2], lo[3], hi4[0], hi4[1], hi4[2], hi4[3]};
#pragma unroll
                    for (int i = 0; i < 4; ++i) {
                        if (32 * ks > 16 * i + 15) continue;
                        const bf16x8 as = *(const LAS bf16x8*)(L + L_S + (16 * i + fr) * SP + (32 * ks + 8 * fq) * 2);
                        num[i] = __builtin_amdgcn_mfma_f32_16x16x32_bf16(as, bv, num[i], 0, 0, 0);
                        den[i] = __builtin_amdgcn_mfma_f32_16x16x32_bf16(as, ones, den[i], 0, 0, 0);
                    }
                }
#pragma unroll
                for (int i = 0; i < 4; ++i) { const f32x4 Ml = *(const LAS f32x4*)(sM + 16 * i + 4 * fq), bl = *(const LAS f32x4*)(sb + 16 * i + 4 * fq);
#pragma unroll
                    for (int j = 0; j < 4; ++j) Hs[(16 * i + 4 * fq + j) * HP + v0 + fr] = num[i][j] * __builtin_amdgcn_rcpf(fmaxf(fabsf(den[i][j]), __expf(-(bl[j] + Ml[j])))); }
            }
            {
                const float a = __expf(m_prev - M63);
#pragma unroll
                for (int t = 0; t < 8; ++t) { X[t] *= a; Xn[t] *= a; }
#pragma unroll
                for (int ks = 0; ks < 2; ++ks) {
                    const LAS unsigned char* vb = L + L_VW + (32 * ks + 8 * fq + tq) * PT + (v0 + 4 * tp) * 2;
                    const s16x4 lo = vtr(vb), hi4 = vtr(vb + 4 * PT);
                    const bf16x8 bv = {lo[0], lo[1], lo[2], lo[3], hi4[0], hi4[1], hi4[2], hi4[3]};
                    const bf16x8 bw = *(const LAS bf16x8*)(swb + 32 * ks + 8 * fq);
#pragma unroll
                    for (int t = 0; t < 8; ++t) {
                        const LAS unsigned char* kb = L + L_K + (32 * ks + 8 * fq + tq) * PT + (16 * t + 4 * tp) * 2;
                        const s16x4 klo = vtr(kb), khi = vtr(kb + 4 * PT);
                        const bf16x8 ak = {klo[0], klo[1], klo[2], klo[3], khi[0], khi[1], khi[2], khi[3]};
                        X[t] = __builtin_amdgcn_mfma_f32_16x16x32_bf16(ak, bv, X[t], 0, 0, 0);
                        Xn[t] = __builtin_amdgcn_mfma_f32_16x16x32_bf16(ak, bw, Xn[t], 0, 0, 0);
                        if (t & 1) __builtin_amdgcn_sched_barrier(0);
                    }
                }
                m_prev = blast + M63; bsum += blast;
            }
            if (PASS == 2) {
                LDS_BARRIER();
                const unsigned ow[8] = {po0.x, po0.y, po0.z, po0.w, po1.x, po1.y, po1.z, po1.w}, zw[8] = {pz0.x, pz0.y, pz0.z, pz0.w, pz1.x, pz1.y, pz1.z, pz1.w};
                float yv[16]; float ss = 0.f;
#pragma unroll
                for (int e = 0; e < 8; ++e) { const float h0 = Hs[srow * HP + 16 * sc8 + 2 * e], h1 = Hs[srow * HP + 16 * sc8 + 2 * e + 1];
                    yv[2 * e] = sigmoidf_(bflo(ow[e])) * h0; yv[2 * e + 1] = sigmoidf_(bfhi(ow[e])) * h1; ss += yv[2 * e] * yv[2 * e] + yv[2 * e + 1] * yv[2 * e + 1]; }
                ss += __shfl_xor(ss, 1); ss += __shfl_xor(ss, 2); ss += __shfl_xor(ss, 4);
                const float rstd = 1.0f / sqrtf(ss * (1.f / 128.f) + EPS);
                const float* nw = F.ml_w + h * 128 + 16 * sc8;
                unsigned outw[8];
#pragma unroll
                for (int e = 0; e < 8; ++e) outw[e] = pk2(yv[2 * e] * rstd * nw[2 * e] * siluf_(bflo(zw[e])), yv[2 * e + 1] * rstd * nw[2 * e + 1] * siluf_(bfhi(zw[e])));
                bf16* yp = F.Y + (rowc + srow) * DM + 512 + h * 128 + 16 * sc8;
                *(v4u*)yp = (v4u){outw[0], outw[1], outw[2], outw[3]}; *(v4u*)(yp + 8) = (v4u){outw[4], outw[5], outw[6], outw[7]};
            }
        }
#undef MPREF
        if (PASS == 1) {
            float* S = SLOC + (size_t)(bh * 7 + seg) * SL_STRIDE;
#pragma unroll
            for (int t = 0; t < 8; ++t) { *(f32x4*)(S + (size_t)(t * 512 + tid) * 4) = X[t]; if (w == 0 && fr == 0) *(f32x4*)(S + SL_N + 16 * t + 4 * fq) = Xn[t]; }
            if (tid == 0) { S[SL_SC] = m_prev; S[SL_SC + 1] = bsum; }
        }
        LDS_BARRIER();
    }
}
__device__ __forceinline__ void mlstm_pass1(Ctx& F, float* SLOC) {
    constexpr int PT = 272;
    constexpr int L_KB = 0, L_VB = 2 * 17408, L_W = 4 * 17408, L_WB = L_W + 2048, L_RED = L_WB + 1024;
    LAS unsigned char* L = F.lds;
    LAS float* sw = (LAS float*)(L + L_W); LAS bf16* swb = (LAS bf16*)(L + L_WB); LAS float* red = (LAS float*)(L + L_RED);
    for (int vu = xcd_vblk(); vu < NB * 32; vu += gridDim.x) {
        if ((vu & 31) >= 28) continue;
        const int unit = (vu >> 5) * 28 + (vu & 31);
        int tid_ = F.tid; asm volatile("" : "+v"(tid_));
        const int tid = tid_, lane = tid & 63, w = __builtin_amdgcn_readfirstlane(tid >> 6), fr = lane & 15, fq = lane >> 4, tq = fr >> 2, tp = fr & 3;
        const int srow = tid >> 3, sc8 = tid & 7, v0 = 16 * w, c16 = tid & 15, rg2 = tid >> 4;
        const int bh = unit / 7, seg = unit % 7, b = bh >> 2, h = bh & 3;
        const size_t row0 = (size_t)b * SEQ + (size_t)seg * 512;
        LDS_BARRIER();
        float bc, u;
        { const float* gg = F.GATES + (row0 + tid) * 8; const float ig = gg[h]; bc = gg[4 + h];
#pragma unroll
          for (int o = 1; o < 64; o <<= 1) { const float t_ = __shfl_up(bc, o); if (lane >= o) bc += t_; }
          if (lane == 63) red[w] = bc;
          LDS_BARRIER();
          float off = 0.f;
#pragma unroll
          for (int i = 0; i < 8; ++i) off += (i < w) ? red[i] : 0.f;
          bc += off; u = ig - bc;
          float mx = u;
#pragma unroll
          for (int o = 1; o < 64; o <<= 1) mx = fmaxf(mx, __shfl_xor(mx, o));
          if (lane == 0) red[8 + w] = mx;
          if (tid == 511) red[16] = bc;
          LDS_BARRIER();
          float umax = red[8];
#pragma unroll
          for (int i = 1; i < 8; ++i) umax = fmaxf(umax, red[8 + i]);
          const float wgt = __expf(u - umax);
          sw[tid] = wgt; swb[tid] = (bf16)(cvtpk(wgt, 0.f) & 0xffffu);
          if (tid == 0) { float* S = SLOC + (size_t)(bh * 7 + seg) * SL_STRIDE; S[SL_SC] = red[16] + umax; S[SL_SC + 1] = red[16]; }
        }
        f32x4 cwa[4], cwb[4], cba, cbb;
        { const float* cw = F.conv_w + 512 + h * 128 + 8 * c16;
#pragma unroll
          for (int j = 0; j < 4; ++j) { cwa[j] = *(const f32x4*)(cw + j * 1024); cwb[j] = *(const f32x4*)(cw + j * 1024 + 4); }
          cba = *(const f32x4*)(F.conv_b + 512 + h * 128 + 8 * c16); cbb = *(const f32x4*)(F.conv_b + 512 + h * 128 + 8 * c16 + 4); }
        f32x4 X[8], Xn[8];
#pragma unroll
        for (int t = 0; t < 8; ++t) { X[t] = (f32x4){0.f, 0.f, 0.f, 0.f}; Xn[t] = (f32x4){0.f, 0.f, 0.f, 0.f}; }
        v4u rk[5], pv0, pv1;
#define P1PREF(c_) do { const long tb_ = (long)(seg * 512 + (c_) * 64 + 2 * rg2 - 3); \
            _Pragma("unroll") for (int i = 0; i < 5; ++i) { const long tr_ = tb_ + i; const v4u ld_ = *(const v4u*)(F.PROJ + ml_off(5, b, h) + (size_t)(tr_ < 0 ? 0 : tr_) * 128 + 8 * c16); \
                rk[i].x = tr_ < 0 ? 0u : ld_.x; rk[i].y = tr_ < 0 ? 0u : ld_.y; rk[i].z = tr_ < 0 ? 0u : ld_.z; rk[i].w = tr_ < 0 ? 0u : ld_.w; }     \
            const bf16* vv_ = F.PROJ + ml_off(6, b, h) + (size_t)(seg * 512 + (c_) * 64 + srow) * 128 + 8 * sc8; pv0 = *(const v4u*)vv_; pv1 = *(const v4u*)(vv_ + 64); } while (0)
        P1PREF(0);
        LDS_BARRIER();
        for (int c = 0; c < 8; ++c) {
            LAS unsigned char* KB = L + L_KB + (c & 1) * 17408; LAS unsigned char* VB = L + L_VB + (c & 1) * 17408;
#pragma unroll
            for (int o = 0; o < 2; ++o) {
                f32x4 a0 = cba, a1 = cbb;
#pragma unroll
                for (int j = 0; j < 4; ++j) { const v4u r = rk[o + j];
                    a0[0] += cwa[j][0] * bflo(r.x); a0[1] += cwa[j][1] * bfhi(r.x); a0[2] += cwa[j][2] * bflo(r.y); a0[3] += cwa[j][3] * bfhi(r.y);
                    a1[0] += cwb[j][0] * bflo(r.z); a1[1] += cwb[j][1] * bfhi(r.z); a1[2] += cwb[j][2] * bflo(r.w); a1[3] += cwb[j][3] * bfhi(r.w); }
                const float sc = 0.08838834764831845f;
                v4u ov; ov.x = cvtpk(siluf_(a0[0]) * sc, siluf_(a0[1]) * sc); ov.y = cvtpk(siluf_(a0[2]) * sc, siluf_(a0[3]) * sc);
                ov.z = cvtpk(siluf_(a1[0]) * sc, siluf_(a1[1]) * sc); ov.w = cvtpk(siluf_(a1[2]) * sc, siluf_(a1[3]) * sc);
                *(LAS v4u*)(KB + (2 * rg2 + o) * PT + 16 * c16) = ov;
            }
            { const float wrow = sw[c * 64 + srow];
              *(LAS v4u*)(VB + srow * PT + 16 * sc8) = scale8(pv0, wrow); *(LAS v4u*)(VB + srow * PT + 16 * (sc8 + 8)) = scale8(pv1, wrow); }
            P1PREF(c + 1 < 8 ? c + 1 : 7); __builtin_amdgcn_sched_barrier(0);
            LDS_BARRIER();
#pragma unroll
            for (int ks = 0; ks < 2; ++ks) {
                const LAS unsigned char* vb = VB + (32 * ks + 8 * fq + tq) * PT + (v0 + 4 * tp) * 2;
                const s16x4 lo = vtr(vb), hi4 = vtr(vb + 4 * PT);
                const bf16x8 bv = {lo[0], lo[1], lo[2], lo[3], hi4[0], hi4[1], hi4[2], hi4[3]};
                const bf16x8 bw = *(const LAS bf16x8*)(swb + c * 64 + 32 * ks + 8 * fq);
#pragma unroll
                for (int t = 0; t < 8; ++t) {
                    const LAS unsigned char* kb = KB + (32 * ks + 8 * fq + tq) * PT + (16 * t + 4 * tp) * 2;
                    const s16x4 klo = vtr(kb), khi = vtr(kb + 4 * PT);
                    const bf16x8 ak = {klo[0], klo[1], klo[2], klo[3], khi[0], khi[1], khi[2], khi[3]};
                    X[t] = __builtin_amdgcn_mfma_f32_16x16x32_bf16(ak, bv, X[t], 0, 0, 0);
                    Xn[t] = __builtin_amdgcn_mfma_f32_16x16x32_bf16(ak, bw, Xn[t], 0, 0, 0);
                }
            }
        }
#undef P1PREF
        { float* S = SLOC + (size_t)(bh * 7 + seg) * SL_STRIDE;
#pragma unroll
          for (int t = 0; t < 8; ++t) { *(f32x4*)(S + (size_t)(t * 512 + tid) * 4) = X[t]; if (w == 0 && fr == 0) *(f32x4*)(S + SL_N + 16 * t + 4 * fq) = Xn[t]; } }
        LDS_BARRIER();
    }
}
#ifdef PROBE_SUB
#define SUB40(i) do { if (blockIdx.x == 40 && threadIdx.x == 0) g_sub_ts[i] = __builtin_amdgcn_s_memrealtime(); } while (0)
#else
#define SUB40(i) do { } while (0)
#endif
#define MIXERS(F) do { SUB40(4); attn32k(F); SUB40(5); mlstm_pass1(F, (float*)(args.ws + WS_PB)); SUB40(6); GRID_SEAM(); TSTAMP(3); SUB40(7); mlstm_fast<2>(F, (float*)(args.ws + WS_PB)); } while (0)
#ifdef PROBE_PH
#ifndef PROBE_PH_END
#define PROBE_PH_END (PROBE_PH + 1)
#endif
#define TSTAMP(i) do { ts_[i] = __builtin_amdgcn_s_memrealtime(); } while (0)
#define TSPIN() do { if (blockIdx.x == 0 && F.tid == 0) { const unsigned long long dt_ = ts_[PROBE_PH_END] - ts_[PROBE_PH], t0_ = __builtin_amdgcn_s_memrealtime(); \
    while (__builtin_amdgcn_s_memrealtime() - t0_ < dt_) __builtin_amdgcn_s_sleep(8); } } while (0)
#elif defined(PROBE_SUB)
#define TSTAMP(i) do { } while (0)
#define TSPIN() do { if (blockIdx.x == 0 && F.tid == 0) { const unsigned long long dt_ = g_sub_ts[PROBE_SUB_B] - g_sub_ts[PROBE_SUB_A], t0_ = __builtin_amdgcn_s_memrealtime(); \
    while (__builtin_amdgcn_s_memrealtime() - t0_ < dt_) __builtin_amdgcn_s_sleep(8); } } while (0)
#else
#define TSTAMP(i) do { } while (0)
#define TSPIN() do { } while (0)
#endif
#define GRID_SEAM() xcd_barrier(xbar)
#define GRID_SEAM_() xcd_barrier(xbar)
#ifndef REP_SYNC
#define REP_SYNC 0
#endif
#ifndef REP_P0
#define REP_P0 1
#endif
#ifndef REP_P1
#define REP_P1 1
#endif
#ifndef REP_P3
#define REP_P3 1
#endif
__global__ void __launch_bounds__(512, 2) fwd_kernel(Args args) {
    extern __shared__ __attribute__((aligned(16))) unsigned char lds_raw[];
    cg::grid_group grid = cg::this_grid();
    Ctx F;
#ifdef PROBE_PH
    unsigned long long ts_[8];
#endif
    F.lds = (LAS unsigned char*)lds_raw;
    F.tid = threadIdx.x; F.lane = F.tid & 63; F.wave = __builtin_amdgcn_readfirstlane(F.tid >> 6);
    F.gw = blockIdx.x * 8 + F.wave; F.NGW = gridDim.x * 8;
    F.x = args.in[0]; F.p = args.in[1]; F.pre_w = args.in[2]; F.w_in = args.in[3]; F.conv_w = args.in[4]; F.conv_b = args.in[5]; F.i_bias = args.in[6]; F.f_bias = args.in[7];
    F.sb_w = args.in[8]; F.ml_w = args.in[9]; F.w_out = args.in[10]; F.post_w = args.in[11]; F.w_up = args.in[12]; F.w_gate = args.in[13]; F.b_gate = args.in[14];
    F.out = args.out; unsigned char* ws = args.ws;
    F.WT_IN = (bf16*)(ws + WS_WIN); F.WT_OUT = (bf16*)(ws + WS_WOUT); F.WT_GATE = (bf16*)(ws + WS_WGATE); F.WT_UP = (bf16*)(ws + WS_WUP); F.GATES = (float*)(ws + WS_GATES);
    F.U = (bf16*)(ws + WS_U); F.Y = F.U; F.HB = F.U; F.PROJ = (bf16*)(ws + WS_PROJ); F.Y2 = F.PROJ; F.PU = (bf16*)(ws + WS_PU); F.PB = (bf16*)(ws + WS_PB); F.QKC = (bf16*)(ws + WS_QKC);

    volatile LAS unsigned* bar_st = (volatile LAS unsigned*)(F.lds + 131072 + 512);
    if (F.tid < 2) bar_st[F.tid] = 0u;
    __syncthreads();
    unsigned* bar_words = (unsigned*)args.ws;
    if (args.ws == nullptr) grid.sync();
    const XcdBarrier xbar = xcd_barrier_post(bar_words, bar_st);
    TSTAMP(0);
    for (int rep_ = 0; rep_ < REP_P0; ++rep_) phase0(F);
    GRID_SEAM_();
    TSTAMP(1);

    for (int rep_ = 0; rep_ < REP_SYNC; ++rep_) GRID_SEAM();
    for (int rep_ = 0; rep_ < REP_P1; ++rep_) {
        pg8::Gemm g{F.U, F.WT_IN, MTOK, NPROJ, DM}; ProjOrder S; S.init(MTOK, NPROJ, gridDim.x, blockIdx.x);
        EpiProj E{F.PROJ, 0.125f * 1.4426950408889634f};
        pg8::gemm_phase<EpiProj, ProjOrder, true, true>(F.lds, g, S, E);
        pg8::Gemm g2{F.PB, F.WT_UP, MTOK, DM, PLE}; pg8::StaticOrder S2; S2.init(MTOK, DM, gridDim.x, blockIdx.x);
        pg8::EpiBf16<0> E2{F.PU, DM, nullptr, 0, 0, 1.f, 1};
        pg8::gemm_phase<pg8::EpiBf16<0>, pg8::StaticOrder, true, true>(F.lds, g2, S2, E2);
    }
    GRID_SEAM();
    TSTAMP(2);
    MIXERS(F);
    GRID_SEAM();
    TSTAMP(4);
    for (int rep_ = 0; rep_ < REP_P3; ++rep_) {
        pg8::Gemm g{F.Y, F.WT_OUT, MTOK, DM, DM}; pg8::StaticOrder S; S.init(MTOK, DM, gridDim.x, blockIdx.x);
        pg8::EpiBf16<0> E{F.Y2, DM, nullptr, 0, 0, 1.f};
        pg8::gemm_phase<pg8::EpiBf16<0>, pg8::StaticOrder, true, true>(F.lds, g, S, E);
    }
    GRID_SEAM();
    TSTAMP(5);
    for (int rep_ = 0; rep_ < REP_P0; ++rep_) phase_norm(F);
    GRID_SEAM();
    TSTAMP(6);
    {
        pg8::Gemm g{F.HB, F.WT_GATE, MTOK, DM, DM}; pg8::StaticOrder S; S.init(MTOK, DM, gridDim.x, blockIdx.x);
        EpiGate E{F.out, F.PU, F.b_gate, F.HB};
        pg8::gemm_phase<EpiGate, pg8::StaticOrder, true, true>(F.lds, g, S, E);
    }
    TSTAMP(7);
    TSPIN();
}

extern "C" void kernel_launch(void* const* d_in, const int* in_sizes, int n_in, void* d_out, int out_size, void* d_ws, size_t ws_size, hipStream_t stream) {
    static int grid = 0;
    if (grid == 0) {
        if (n_in != 15 || out_size != MTOK * DM || ws_size < WS_END) { fprintf(stderr, "kernel_launch: unexpected shapes (n_in %d out %d ws %zu)\n", n_in, out_size, ws_size); grid = -1; return; }
        int dev = 0, cus = 0, per_cu = 0;
        (void)hipGetDevice(&dev); (void)hipDeviceGetAttribute(&cus, hipDeviceAttributeMultiprocessorCount, dev);
        if (hipFuncSetAttribute((const void*)fwd_kernel, hipFuncAttributeMaxDynamicSharedMemorySize, LDS_BYTES) != hipSuccess) { fprintf(stderr, "kernel_launch: hipFuncSetAttribute failed\n"); grid = -1; return; }
        if (hipOccupancyMaxActiveBlocksPerMultiprocessor(&per_cu, (const void*)fwd_kernel, 512, LDS_BYTES) != hipSuccess || per_cu < 1) { fprintf(stderr, "kernel_launch: occupancy query says %d\n", per_cu); per_cu = 1; }
        (void)hipGetLastError();
        grid = cus * 1;
        if (grid <= 0) grid = 256;
    }
    if (grid < 0) return;
    Args a{};
    for (int i = 0; i < 15; ++i) a.in[i] = (const float*)d_in[i];
    a.out = (float*)d_out; a.ws = (unsigned char*)d_ws;
    if (hipMemsetAsync(d_ws, 0, 32768, stream) != hipSuccess) { fprintf(stderr, "kernel_launch: memset of the control words failed\n"); return; }
    void* kargs[] = {&a};
    hipError_t e = hipLaunchCooperativeKernel((const void*)fwd_kernel, dim3(grid), dim3(512), kargs, LDS_BYTES, stream);
    if (e != hipSuccess) fprintf(stderr, "kernel_launch: cooperative launch failed: %s (grid %d)\n", hipGetErrorString(e), grid);
}
```

```cpp
#include <hip/hip_runtime.h>
#include <hip/hip_cooperative_groups.h>
#include <cstdio>
#include <cstdint>
namespace cg = cooperative_groups;

namespace pg8 {
#define PG8_LAS __attribute__((address_space(3)))
typedef unsigned short bf16_t;
typedef short bf16x8 __attribute__((ext_vector_type(8)));
typedef float f32x4 __attribute__((ext_vector_type(4)));
typedef unsigned u32x4 __attribute__((ext_vector_type(4)));
constexpr int BM = 256, BK = 64, HALF = 128, HTB = HALF * BK * 2  , STAGE_BYTES = 8 * HTB, NXCD = 8, WGM = 8;

__host__ __device__ __forceinline__ int lds_byte(int r, int c) { const int st = (r >> 4) * 2 + (c >> 5), rr = r & 15, cc = c & 31, ob = rr * 64 + cc * 2; return st * 1024 + (ob ^ (((ob >> 9) & 1) << 5)); }
__host__ __device__ __forceinline__ void stage_rc(int b, int& R, int& C) { const int st = b / 1024, sb = b % 1024, swz = sb ^ (((sb >> 9) & 1) << 5); R = (st >> 1) * 16 + swz / 64; C = (st & 1) * 32 + (swz % 64) / 2; }
__host__ __device__ __forceinline__ int perm32(int rho) { const int n = rho >> 4, i = rho & 15; return 8 * (i >> 2) + 4 * n + (i & 3); }

struct Unit { int pm, pn; };
struct Gemm { const bf16_t* A; const bf16_t* Bt; int M, N, K; };

struct StaticOrder {
    int nM, nN, nwg, G, c;
    __host__ __device__ void init(int M, int N, int G_, int c_) { nM = M / BM; nN = N / BM; nwg = nM * nN; G = G_; c = c_; }
    __host__ __device__ bool next(int i, Unit& u) const {
        const long L = (long)i * G + c; if (L >= nwg) return false;
        int wgid = (int)L; { const int q = nwg / NXCD, r = nwg % NXCD, xcd = wgid % NXCD, off = wgid / NXCD; wgid = (xcd < r ? xcd * (q + 1) : r * (q + 1) + (xcd - r) * q) + off; }
        const int nig = WGM * nN, gid = wgid / nig, fm = gid * WGM, gsz = (nM - fm) < WGM ? (nM - fm) : WGM;
        u.pm = fm + ((wgid % nig) % gsz); u.pn = (wgid % nig) / gsz; return true;
    }
    __device__ __forceinline__ void a_ready(const Unit&) const {}
    __device__ __forceinline__ void done(const Unit&) const {}
};

__device__ __forceinline__ unsigned cvt_pk_bf16(float lo, float hi) { unsigned r; asm volatile("v_cvt_pk_bf16_f32 %0, %1, %2" : "=v"(r) : "v"(lo), "v"(hi)); return r; }
typedef float f32x2 __attribute__((ext_vector_type(2)));
__device__ __forceinline__ f32x2 gelu_pk(f32x2 v) {
    const f32x2 av = __builtin_elementwise_abs(v), d = av * 0.2316418882f + 1.0f;
    f32x2 t; t.x = __builtin_amdgcn_rcpf(d.x); t.y = __builtin_amdgcn_rcpf(d.y);
    f32x2 q = t * 0.5307027145f + (-0.7265760135f); q = q * t + 0.7107068705f; q = q * t + (-0.142248368f); q = q * t + 0.127414796f; q = q * t;
    const f32x2 s = (v * v) * (-0.72134752044f);
    f32x2 e; e.x = __builtin_amdgcn_exp2f(s.x); e.y = __builtin_amdgcn_exp2f(s.y);
    const f32x2 m = v * (q * e), r = v - m;
    f32x2 o; o.x = v.x < 0.f ? m.x : r.x; o.y = v.y < 0.f ? m.y : r.y; return o;
}

template <int ACT  > struct EpiBf16 {
    static constexpr bool PERM = true, AFTER_DRAIN = false; static_assert(ACT == 0 || ACT == 1, "EpiBf16: ACT is 0 (none) or 1 (gelu_pk)");
    bf16_t* O; int ldc; const float* bias; int split_cols; size_t split_stride; float scale0; int nt;
    __device__ __forceinline__ void operator()(const f32x4 (&acc)[2][2][4][2], const Unit& u, int wr, int wc, int fr, int fq) const {
        const int row0 = u.pm * BM + wr * 64 + fr; int colt = u.pn * BM; bf16_t* base = O;
        float sc = 1.f; if (split_cols) { const int t = colt / split_cols; base += (size_t)t * split_stride; colt -= t * split_cols; if (t == 0) sc = scale0; }
        const int col0 = colt + wc * 32 + 8 * fq, bcol0 = u.pn * BM + wc * 32 + 8 * fq;
        f32x4 bv[2][2];
#pragma unroll
        for (int bj = 0; bj < 2; ++bj)
#pragma unroll
            for (int n = 0; n < 2; ++n) bv[bj][n] = bias ? *(const f32x4*)(bias + bcol0 + bj * HALF + 4 * n) : (f32x4){0.f, 0.f, 0.f, 0.f};
#pragma unroll
        for (int ai = 0; ai < 2; ++ai)
#pragma unroll
            for (int m = 0; m < 4; ++m) { bf16_t* rowp = base + (size_t)(row0 + ai * HALF + m * 16) * ldc + col0;
#pragma unroll
                for (int bj = 0; bj < 2; ++bj) { f32x4 v0 = acc[ai][bj][m][0] + bv[bj][0], v1 = acc[ai][bj][m][1] + bv[bj][1];
                    if (ACT == 1) { f32x2 a = gelu_pk((f32x2){v0[0], v0[1]}), b = gelu_pk((f32x2){v0[2], v0[3]}), c = gelu_pk((f32x2){v1[0], v1[1]}), d = gelu_pk((f32x2){v1[2], v1[3]});
                        v0 = (f32x4){a.x, a.y, b.x, b.y}; v1 = (f32x4){c.x, c.y, d.x, d.y}; }
                    v0 = v0 * sc; v1 = v1 * sc; u32x4 w; w.x = cvt_pk_bf16(v0[0], v0[1]); w.y = cvt_pk_bf16(v0[2], v0[3]); w.z = cvt_pk_bf16(v1[0], v1[1]); w.w = cvt_pk_bf16(v1[2], v1[3]);
                    if (nt) __builtin_nontemporal_store(w, (u32x4*)(rowp + bj * HALF)); else *(u32x4*)(rowp + bj * HALF) = w; } }
    }
};

template <class Epi, class Sched, bool ALIGN_EPI = false, bool SP2 = false>
__device__ __forceinline__ void gemm_phase(PG8_LAS unsigned char* lds, const Gemm g, const Sched& S, const Epi& E) {
    int tid_ = threadIdx.x; asm volatile("" : "+v"(tid_));
    const int tid = tid_, wid = __builtin_amdgcn_readfirstlane(tid >> 6), lane = tid & 63, wr = wid >> 2, wc = wid & 3, fr = lane & 15, fq = lane >> 4;
    const int K = g.K, nt = K / BK;
    unsigned voffA[2], voffB[2];
#pragma unroll
    for (int i = 0; i < 2; ++i) { int R, C; stage_rc(tid * 16 + i * 8192, R, C); const int Rb = Epi::PERM ? ((R & ~31) + perm32(R & 31)) : R;
        voffA[i] = (unsigned)(R * K + C) * 2u; voffB[i] = (unsigned)(Rb * K + C) * 2u; }
    const size_t kstep = (size_t)(BK * 2);
    const size_t hstep = (size_t)HALF * K * 2;
    const size_t tstep = 2 * hstep;
    const unsigned ldsw = (unsigned)wid * 1024u;
    const int aoff = lds_byte(wr * 64 + fr, fq * 8), boff = lds_byte(wc * 32 + fr, fq * 8);
#define PG8_SA(b, h) (((b) * 2 + (h)) * HTB)
#define PG8_SB(b, h) ((4 + (b) * 2 + (h)) * HTB)
#define PG8_STAGE(bufoff, gbase, voff) do { _Pragma("unroll") for (int _i = 0; _i < 2; ++_i) \
        __builtin_amdgcn_global_load_lds((const unsigned*)((const char*)(gbase) + (voff)[_i]), (PG8_LAS unsigned*)(lds + (bufoff) + ldsw + _i * 8192), 16, 0, 0); } while (0)
#define PG8_LDA(dst, b, h) do { _Pragma("unroll") for (int m = 0; m < 4; ++m) _Pragma("unroll") for (int k = 0; k < 2; ++k) dst[m][k] = *(const PG8_LAS bf16x8*)(lds + PG8_SA(b, h) + aoff + m * 2048 + k * 1024); } while (0)
#define PG8_LDB(dst, b, h) do { _Pragma("unroll") for (int n = 0; n < 2; ++n) _Pragma("unroll") for (int k = 0; k < 2; ++k) dst[n][k] = *(const PG8_LAS bf16x8*)(lds + PG8_SB(b, h) + boff + n * 2048 + k * 1024); } while (0)
#define PG8_MMA(ai, bj, At, Bt) do { __builtin_amdgcn_s_setprio(1); _Pragma("unroll") for (int m = 0; m < 4; ++m) _Pragma("unroll") for (int n = 0; n < 2; ++n) _Pragma("unroll") for (int k = 0; k < 2; ++k) \
        acc[ai][bj][m][n] = __builtin_amdgcn_mfma_f32_16x16x32_bf16(Bt[n][k], At[m][k], acc[ai][bj][m][n], 0, 0, 0); __builtin_amdgcn_s_setprio(0); } while (0)
#define PG8_WAIT_V(n) asm volatile("s_waitcnt vmcnt(" #n ")" ::: "memory")
#define PG8_WAIT_L(n) asm volatile("s_waitcnt lgkmcnt(" #n ")" ::: "memory")
#define PG8_BAR __builtin_amdgcn_s_barrier()
#define PG8_SCHED __builtin_amdgcn_sched_barrier(0)
    Unit cur, nxt; int ui = 0;
    if (!S.next(0, cur)) return;
    f32x4 acc[2][2][4][2];
#pragma unroll
    for (int a = 0; a < 2; ++a)
#pragma unroll
        for (int b = 0; b < 2; ++b)
#pragma unroll
            for (int m = 0; m < 4; ++m)
#pragma unroll
                for (int n = 0; n < 2; ++n) acc[a][b][m][n] = (f32x4){0.f, 0.f, 0.f, 0.f};
    bf16x8 At[4][2], B0[2][2], B1[2][2];
    const char* cA = (const char*)g.A + (size_t)cur.pm * tstep; const char* cB = (const char*)g.Bt + (size_t)cur.pn * tstep;
    S.a_ready(cur);
    if constexpr (SP2) {
        PG8_STAGE(PG8_SB(0, 0), cB, voffB); PG8_STAGE(PG8_SB(0, 1), cB + hstep, voffB); PG8_STAGE(PG8_SA(0, 0), cA, voffA); PG8_STAGE(PG8_SA(0, 1), cA + hstep, voffA);
        if (wr == 1) PG8_BAR;
        PG8_WAIT_V(2); PG8_BAR;
        PG8_STAGE(PG8_SB(1, 0), cB + kstep, voffB); PG8_STAGE(PG8_SA(1, 0), cA + kstep, voffA); PG8_STAGE(PG8_SB(1, 1), cB + hstep + kstep, voffB);
        PG8_WAIT_V(6); PG8_BAR;
    } else {
        PG8_STAGE(PG8_SB(0, 0), cB, voffB); PG8_STAGE(PG8_SA(0, 0), cA, voffA); PG8_STAGE(PG8_SB(0, 1), cB + hstep, voffB); PG8_STAGE(PG8_SA(0, 1), cA + hstep, voffA);
        if (wr == 1) PG8_BAR;
        PG8_WAIT_V(4); PG8_BAR;
        PG8_STAGE(PG8_SB(1, 0), cB + kstep, voffB); PG8_STAGE(PG8_SA(1, 0), cA + kstep, voffA); PG8_STAGE(PG8_SB(1, 1), cB + hstep + kstep, voffB);
        PG8_WAIT_V(6); PG8_BAR;
    }
    for (;;) {
        const bool has_next = S.next(ui + 1, nxt);
        const char* nA = has_next ? (const char*)g.A + (size_t)nxt.pm * tstep : cA; const char* nB = has_next ? (const char*)g.Bt + (size_t)nxt.pn * tstep : cB;
        for (int t = 0; t < nt; t += 2) {
            const bool last = (t == nt - 2);
            const char* a1 = cA + (size_t)(t + 1) * kstep;
            const char* a2 = last ? nA : cA + (size_t)(t + 2) * kstep; const char* b2 = last ? nB : cB + (size_t)(t + 2) * kstep;
            const char* a3 = a2 + kstep; const char* b3 = b2 + kstep;
            if (last && has_next) S.a_ready(nxt);
            if constexpr (SP2) {
            PG8_LDB(B0, 0, 0); PG8_LDB(B1, 0, 1); PG8_SCHED; PG8_LDA(At, 0, 0); PG8_STAGE(PG8_SA(1, 1), a1 + hstep, voffA);
            PG8_WAIT_V(8); PG8_WAIT_L(0); PG8_BAR; PG8_MMA(0, 0, At, B0); PG8_MMA(0, 1, At, B1); PG8_BAR; PG8_SCHED;
            PG8_LDA(At, 0, 1); PG8_STAGE(PG8_SB(0, 0), b2, voffB); PG8_STAGE(PG8_SB(0, 1), b2 + hstep, voffB); PG8_STAGE(PG8_SA(0, 0), a2, voffA);
            PG8_WAIT_V(8); PG8_WAIT_L(0); PG8_BAR; PG8_MMA(1, 0, At, B0); PG8_MMA(1, 1, At, B1); PG8_BAR; PG8_SCHED;
            PG8_LDB(B0, 1, 0); PG8_LDB(B1, 1, 1); PG8_SCHED; PG8_LDA(At, 1, 0); PG8_STAGE(PG8_SA(0, 1), a2 + hstep, voffA);
            PG8_WAIT_V(8); PG8_WAIT_L(0); PG8_BAR; PG8_MMA(0, 0, At, B0); PG8_MMA(0, 1, At, B1); PG8_BAR; PG8_SCHED;
            PG8_LDA(At, 1, 1); PG8_STAGE(PG8_SB(1, 0), b3, voffB); PG8_STAGE(PG8_SB(1, 1), b3 + hstep, voffB); PG8_STAGE(PG8_SA(1, 0), a3, voffA);
            PG8_WAIT_V(8); PG8_WAIT_L(0); PG8_BAR; PG8_MMA(1, 0, At, B0); PG8_MMA(1, 1, At, B1); PG8_BAR; PG8_SCHED;
            } else {
            PG8_LDB(B0, 0, 0); PG8_SCHED; PG8_LDA(At, 0, 0); PG8_STAGE(PG8_SA(1, 1), a1 + hstep, voffA);
            PG8_WAIT_L(8); PG8_BAR; PG8_WAIT_L(0); PG8_MMA(0, 0, At, B0); PG8_BAR; PG8_SCHED;
            PG8_LDB(B1, 0, 1); PG8_STAGE(PG8_SB(0, 0), b2, voffB);
            PG8_BAR; PG8_WAIT_L(0); PG8_MMA(0, 1, At, B1); PG8_BAR;
            PG8_LDA(At, 0, 1); PG8_STAGE(PG8_SA(0, 0), a2, voffA);
            PG8_BAR; PG8_WAIT_L(0); PG8_MMA(1, 0, At, B0); PG8_BAR; PG8_SCHED;
            PG8_STAGE(PG8_SB(0, 1), b2 + hstep, voffB);
            PG8_WAIT_V(6); PG8_BAR; PG8_MMA(1, 1, At, B1); PG8_BAR;
            PG8_LDB(B0, 1, 0); PG8_SCHED; PG8_LDA(At, 1, 0); PG8_STAGE(PG8_SA(0, 1), a2 + hstep, voffA);
            PG8_WAIT_L(8); PG8_BAR; PG8_WAIT_L(0); PG8_MMA(0, 0, At, B0); PG8_BAR; PG8_SCHED;
            PG8_LDB(B1, 1, 1); PG8_STAGE(PG8_SB(1, 0), b3, voffB);
            PG8_BAR; PG8_WAIT_L(0); PG8_MMA(0, 1, At, B1); PG8_BAR;
            PG8_LDA(At, 1, 1); PG8_STAGE(PG8_SA(1, 0), a3, voffA);
            PG8_BAR; PG8_WAIT_L(0); PG8_MMA(1, 0, At, B0); PG8_BAR; PG8_SCHED;
            PG8_STAGE(PG8_SB(1, 1), b3 + hstep, voffB);
            PG8_WAIT_V(6); PG8_BAR; PG8_MMA(1, 1, At, B1); PG8_BAR;
            }
        }
        if constexpr (ALIGN_EPI) { if (wr == 0) PG8_BAR; }
        if constexpr (!Epi::AFTER_DRAIN) { E(acc, cur, wr, wc, fr, fq); S.done(cur); }
        if (!has_next) break;
#pragma unroll
        for (int a = 0; a < 2; ++a)
#pragma unroll
            for (int b = 0; b < 2; ++b)
#pragma unroll
                for (int m = 0; m < 4; ++m)
#pragma unroll
                    for (int n = 0; n < 2; ++n) acc[a][b][m][n] = (f32x4){0.f, 0.f, 0.f, 0.f};
        cur = nxt; cA = nA; cB = nB; ++ui;
        if constexpr (ALIGN_EPI) { if (wr == 1) PG8_BAR; }
    }
    PG8_WAIT_V(0);
    if constexpr (!ALIGN_EPI) { if (wr == 0) PG8_BAR; }
    PG8_BAR;
    if constexpr (Epi::AFTER_DRAIN) { E.fused(acc, cur, wr, wc, fr, fq, lds, wid, lane); S.done(cur); }
#undef PG8_SA
#undef PG8_SB
#undef PG8_STAGE
#undef PG8_LDA
#undef PG8_LDB
#undef PG8_MMA
#undef PG8_WAIT_V
#undef PG8_WAIT_L
#undef PG8_BAR
#undef PG8_SCHED
}
}
#define LAS __attribute__((address_space(3)))
typedef unsigned short bf16;
typedef unsigned v4u __attribute__((ext_vector_type(4)));
typedef unsigned v2u __attribute__((ext_vector_type(2)));
typedef float f32x4 __attribute__((ext_vector_type(4)));
typedef short bf16x8 __attribute__((ext_vector_type(8)));
typedef short s16x4 __attribute__((ext_vector_type(4)));
typedef float f32x16 __attribute__((ext_vector_type(16)));
constexpr int DM = 1024, NB = 8, SEQ = 4096, MTOK = NB * SEQ, NIN = 4616, NPROJ = 4608, PLE = 256;
constexpr int C_SBQ = 0, C_SBK = 512, C_SBV = 1024, C_SBZ = 1536, C_MLQ = 2048, C_MLK = 2560, C_MLV = 3072, C_MLO = 3584, C_MLZ = 4096;
constexpr float EPS = 1e-6f;
constexpr size_t MiB = 1u << 20;
constexpr size_t WS_WIN = 1 * MiB, WS_WOUT = 10 * MiB, WS_WGATE = 12 * MiB, WS_WUP = 14 * MiB, WS_GATES = 15 * MiB;
constexpr size_t WS_U = 16 * MiB;
constexpr size_t WS_PROJ = 80 * MiB;
constexpr size_t WS_PU = 368 * MiB, WS_PB = 432 * MiB, WS_QKC = 448 * MiB, WS_END = 512 * MiB;
constexpr int LDS_BYTES = 147456;

__device__ __forceinline__ unsigned f2bf(float f) { unsigned u = __builtin_bit_cast(unsigned, f); return (u + 0x7fffu + ((u >> 16) & 1u)) >> 16; }
__device__ __forceinline__ unsigned pk2(float lo, float hi) { return f2bf(lo) | (f2bf(hi) << 16); }
__device__ __forceinline__ float bflo(unsigned w) { return __builtin_bit_cast(float, w << 16); }
__device__ __forceinline__ float bfhi(unsigned w) { return __builtin_bit_cast(float, w & 0xffff0000u); }
__device__ __forceinline__ float bf1(bf16 v) { return __builtin_bit_cast(float, ((unsigned)v) << 16); }
__device__ __forceinline__ float wave_sum(float v) {
#pragma unroll
    for (int o = 1; o < 64; o <<= 1) v += __shfl_xor(v, o);
    return v;
}
__device__ __forceinline__ float sigmoidf_(float x) { return __builtin_amdgcn_rcpf(1.f + __expf(-x)); }
__device__ __forceinline__ float siluf_(float x) { return x * __builtin_amdgcn_rcpf(1.f + __expf(-x)); }
#define LDS_WAIT() asm volatile("s_waitcnt lgkmcnt(0)" ::: "memory")
#define LDS_BARRIER() do { asm volatile("s_waitcnt lgkmcnt(0)" ::: "memory"); __builtin_amdgcn_s_barrier(); asm volatile("" ::: "memory"); } while (0)

__device__ __forceinline__ void p0_transpose_item(const float* W, int K, int pitch, int nblk, bf16* WT, LAS float* scr, int item, int lane) {
    const int kb = item / nblk, nb = item % nblk, k0 = 64 * kb, n0 = 32 * nb;
    float tv[32];
#pragma unroll
    for (int i = 0; i < 32; ++i) tv[i] = __builtin_nontemporal_load(W + (size_t)(k0 + 2 * i + (lane >> 5)) * pitch + n0 + (lane & 31));
#pragma unroll
    for (int i = 0; i < 32; ++i) scr[(2 * i + (lane >> 5)) * 33 + (lane & 31)] = tv[i];
    LDS_WAIT(); asm volatile("" ::: "memory");
    const int c = lane & 7;
#pragma unroll
    for (int j = 0; j < 4; ++j) { const int n = (lane >> 3) + 8 * j; const LAS float* s = scr + (8 * c) * 33 + n;
        v4u o; o.x = pk2(s[0 * 33], s[1 * 33]); o.y = pk2(s[2 * 33], s[3 * 33]); o.z = pk2(s[4 * 33], s[5 * 33]); o.w = pk2(s[6 * 33], s[7 * 33]);
        *(v4u*)(WT + (size_t)(n0 + n) * K + k0 + 8 * c) = o; }
    LDS_WAIT(); asm volatile("" ::: "memory");
}

struct EpiGate {
    static constexpr bool PERM = true, AFTER_DRAIN = false;
    float* out; const bf16* pu; const float* bias; const bf16* hb;
    __device__ __forceinline__ void operator()(const pg8::f32x4 (&acc)[2][2][4][2], const pg8::Unit& u, int wr, int wc, int fr, int fq) const {
        const int row0 = u.pm * 256 + wr * 64 + fr, col0 = u.pn * 256 + wc * 32 + 8 * fq;
        f32x4 bv[2][2];
#pragma unroll
        for (int bj = 0; bj < 2; ++bj) { bv[bj][0] = *(const f32x4*)(bias + col0 + bj * 128); bv[bj][1] = *(const f32x4*)(bias + col0 + bj * 128 + 4); }
#pragma unroll
        for (int ai = 0; ai < 2; ++ai)
#pragma unroll
            for (int mp = 0; mp < 2; ++mp) {
                v4u hw[2][2], pw[2][2];
#pragma unroll
                for (int mm = 0; mm < 2; ++mm) { const size_t ro = (size_t)(row0 + ai * 128 + (2 * mp + mm) * 16) * DM;
#pragma unroll
                    for (int bj = 0; bj < 2; ++bj) { const int c = col0 + bj * 128; hw[mm][bj] = *(const v4u*)(hb + ro + c); pw[mm][bj] = *(const v4u*)(pu + ro + c); } }
#pragma unroll
                for (int mm = 0; mm < 2; ++mm) { const int m = 2 * mp + mm; const size_t ro = (size_t)(row0 + ai * 128 + m * 16) * DM;
#pragma unroll
                    for (int bj = 0; bj < 2; ++bj) { const int c = col0 + bj * 128;
                        const f32x4 v0 = acc[ai][bj][m][0] + bv[bj][0], v1 = acc[ai][bj][m][1] + bv[bj][1];
                        const v4u h = hw[mm][bj], q = pw[mm][bj];
                        f32x4 o0, o1;
                        o0[0] = bflo(h.x) + sigmoidf_(v0[0]) * bflo(q.x); o0[1] = bfhi(h.x) + sigmoidf_(v0[1]) * bfhi(q.x);
                        o0[2] = bflo(h.y) + sigmoidf_(v0[2]) * bflo(q.y); o0[3] = bfhi(h.y) + sigmoidf_(v0[3]) * bfhi(q.y);
                        o1[0] = bflo(h.z) + sigmoidf_(v1[0]) * bflo(q.z); o1[1] = bfhi(h.z) + sigmoidf_(v1[1]) * bfhi(q.z);
                        o1[2] = bflo(h.w) + sigmoidf_(v1[2]) * bflo(q.w); o1[3] = bfhi(h.w) + sigmoidf_(v1[3]) * bfhi(q.w);
                        __builtin_nontemporal_store(o0, (f32x4*)(out + ro + c)); __builtin_nontemporal_store(o1, (f32x4*)(out + ro + c + 4)); } }
            }
    }
};

constexpr size_t SLAB = (size_t)MTOK * 512;
__device__ __forceinline__ size_t sb_off(int T, int b, int h) { return (size_t)T * SLAB + (size_t)((b * 8 + h) * SEQ) * 64; }
__device__ __forceinline__ size_t ml_off(int T, int b, int h) { return (size_t)T * SLAB + (size_t)((b * 4 + h) * SEQ) * 128; }
struct EpiProj {
    static constexpr bool PERM = true, AFTER_DRAIN = false;
    bf16* O; float scale0;
    __device__ __forceinline__ void operator()(const pg8::f32x4 (&acc)[2][2][4][2], const pg8::Unit& u, int wr, int wc, int fr, int fq) const {
        const int row0 = u.pm * 256 + wr * 64 + fr, colt = u.pn * 256, T = colt >> 9;
        const float sc = T == 0 ? scale0 : 1.f;
#pragma unroll
        for (int bj = 0; bj < 2; ++bj) {
            const int cin = (colt + bj * 128 + wc * 32 + 8 * fq) & 511;
            const int HDl = T < 4 ? 6 : 7, h = cin >> HDl, cc = cin & ((1 << HDl) - 1), Hn = T < 4 ? 8 : 4;
#pragma unroll
            for (int ai = 0; ai < 2; ++ai)
#pragma unroll
                for (int m = 0; m < 4; ++m) { const int row = row0 + ai * 128 + m * 16, b = row >> 12, t = row & (SEQ - 1);
                    bf16* dst = O + (size_t)T * SLAB + (((size_t)(b * Hn + h) * SEQ + t) << HDl) + cc;
                    const pg8::f32x4 v0 = acc[ai][bj][m][0] * sc, v1 = acc[ai][bj][m][1] * sc;
                    v4u w; w.x = pg8::cvt_pk_bf16(v0[0], v0[1]); w.y = pg8::cvt_pk_bf16(v0[2], v0[3]); w.z = pg8::cvt_pk_bf16(v1[0], v1[1]); w.w = pg8::cvt_pk_bf16(v1[2], v1[3]);
                    __builtin_nontemporal_store(w, (v4u*)dst); }
        }
    }
};

struct ProjOrder : pg8::StaticOrder {
    __host__ __device__ bool next(int i, pg8::Unit& u) const {
        if (!pg8::StaticOrder::next(i, u)) return false;
        const int p = u.pn;
        u.pn = p < 2 ? 8 + p : (p < 6 ? 12 + p : (p < 10 ? 4 + p : p - 10));
        return true;
    }
};

__device__ __forceinline__ int xcd_vblk() { return (gridDim.x & 7) == 0 ? (int)(blockIdx.x & 7) * (int)(gridDim.x >> 3) + (int)(blockIdx.x >> 3) : (int)blockIdx.x; }

struct Args { const float* in[15]; float* out; unsigned char* ws; };
struct Ctx {
    LAS unsigned char* lds; int tid, lane, wave, gw, NGW;
    const float *x, *p, *pre_w, *w_in, *conv_w, *conv_b, *i_bias, *f_bias, *sb_w, *ml_w, *w_out, *post_w, *w_up, *w_gate, *b_gate;
    float* out; bf16 *WT_IN, *WT_OUT, *WT_GATE, *WT_UP, *U, *Y, *HB, *PROJ, *Y2, *PU, *PB, *QKC; float* GATES;
};

#ifdef PROBE_SUB
__device__ unsigned long long g_sub_ts[8];
#define SUBSTAMP(i) do { if (blockIdx.x == 0 && threadIdx.x == 0) g_sub_ts[i] = __builtin_amdgcn_s_memrealtime(); } while (0)
#else
#define SUBSTAMP(i) do { } while (0)
#endif
__device__ __forceinline__ void phase0(Ctx& F) {
    SUBSTAMP(3);
    LAS float* Wg = (LAS float*)F.lds;
    for (int e = F.tid; e < 1024 * 8; e += 512) Wg[e] = F.w_in[(size_t)(e >> 3) * NIN + NPROJ + (e & 7)];
    __syncthreads();
    SUBSTAMP(0);
    if (F.wave < 6) {
        f32x4 wga[16], wgb[16];
#pragma unroll
        for (int j = 0; j < 4; ++j)
#pragma unroll
            for (int e = 0; e < 4; ++e) { const LAS f32x4* wp = (const LAS f32x4*)(Wg + (512 * (j >> 1) + 8 * F.lane + 4 * (j & 1) + e) * 8); wga[4 * j + e] = wp[0]; wgb[4 * j + e] = wp[1]; }
        f32x4 pw[4];
#pragma unroll
        for (int j = 0; j < 4; ++j) pw[j] = *(const f32x4*)(F.pre_w + 512 * (j >> 1) + 8 * F.lane + 4 * (j & 1));
        const f32x4 ib = *(const f32x4*)F.i_bias, fb = *(const f32x4*)F.f_bias;
        f32x4 vn[4];
        const int nrw = (int)gridDim.x * 6, rwi = xcd_vblk() * 6 + F.wave;
        const int mbeg = (int)(((long)rwi * MTOK) / nrw), mend = (int)(((long)(rwi + 1) * MTOK) / nrw);
        { const float* xr = F.x + (size_t)mbeg * DM + 8 * F.lane;
#pragma unroll
          for (int j = 0; j < 4; ++j) vn[j] = __builtin_nontemporal_load((const f32x4*)(xr + 512 * (j >> 1) + 4 * (j & 1))); }
        const bool up32 = (F.lane & 32) != 0, up16 = (F.lane & 16) != 0, up8 = (F.lane & 8) != 0;
        const int gq = F.lane >> 3; const float bsel = gq < 4 ? ib[gq & 3] : fb[gq & 3];
        for (int m = mbeg; m < mend; ++m) {
            f32x4 v[4];
#pragma unroll
            for (int j = 0; j < 4; ++j) v[j] = vn[j];
            { const float* xr = F.x + (size_t)(m + 1 < mend ? m + 1 : m) * DM + 8 * F.lane;
#pragma unroll
                for (int j = 0; j < 4; ++j) vn[j] = __builtin_nontemporal_load((const f32x4*)(xr + 512 * (j >> 1) + 4 * (j & 1))); }
            __builtin_amdgcn_sched_barrier(0);
            float s = 0.f;
#pragma unroll
            for (int j = 0; j < 4; ++j) s += (v[j].x * v[j].x + v[j].y * v[j].y) + (v[j].z * v[j].z + v[j].w * v[j].w);
            f32x4 ga = (f32x4){0.f, 0.f, 0.f, 0.f}, gb = (f32x4){0.f, 0.f, 0.f, 0.f};
#pragma unroll
            for (int j = 0; j < 4; ++j) { const f32x4 xw = v[j] * pw[j];
#pragma unroll
                for (int e = 0; e < 4; ++e) { ga += wga[4 * j + e] * xw[e]; gb += wgb[4 * j + e] * xw[e]; } }
            s = wave_sum(s);
            const float rstd = 1.0f / sqrtf(s * (1.f / DM) + EPS);
            f32x4 g4;
#pragma unroll
            for (int i = 0; i < 4; ++i) { const float keep = up32 ? gb[i] : ga[i], send = up32 ? ga[i] : gb[i]; g4[i] = keep + __shfl_xor(send, 32); }
            const float k0 = up16 ? g4[2] : g4[0], s0 = up16 ? g4[0] : g4[2], k1 = up16 ? g4[3] : g4[1], s1 = up16 ? g4[1] : g4[3];
            const float g2a = k0 + __shfl_xor(s0, 16), g2b = k1 + __shfl_xor(s1, 16);
            const float kk = up8 ? g2b : g2a, sd = up8 ? g2a : g2b; float g1 = kk + __shfl_xor(sd, 8);
            g1 += __shfl_xor(g1, 4); g1 += __shfl_xor(g1, 2); g1 += __shfl_xor(g1, 1);
#pragma unroll
            for (int jj = 0; jj < 2; ++jj) { const f32x4 u0 = v[2 * jj] * rstd * pw[2 * jj], u1 = v[2 * jj + 1] * rstd * pw[2 * jj + 1];
                v4u o; o.x = pk2(u0.x, u0.y); o.y = pk2(u0.z, u0.w); o.z = pk2(u1.x, u1.y); o.w = pk2(u1.z, u1.w);
                *(v4u*)(F.U + (size_t)m * DM + 512 * jj + 8 * F.lane) = o; }
            const float pre = g1 * rstd + bsel;
            const float lsg = fminf(pre, 0.f) - 0.6931471805599453f * __builtin_amdgcn_logf(1.f + __builtin_amdgcn_exp2f(-fabsf(pre) * 1.4426950408889634f));
            if ((F.lane & 7) == 0) F.GATES[(size_t)m * 8 + gq] = gq < 4 ? pre : lsg;
        }
    } else {
        const int ow = (int)blockIdx.x * 2 + (F.wave - 6), now = (int)gridDim.x * 2;
        LAS float* scr = (LAS float*)(F.lds + F.wave * 16384);
        constexpr int I_IN = 16 * 144, I_O = 16 * 32, I_G = 16 * 32, I_U = 4 * 32, NIT = I_IN + I_O + I_G + I_U;
        for (int it = ow; it < NIT; it += now) {
            int r = it;
            if (r < I_IN) { p0_transpose_item(F.w_in, DM, NIN, 144, F.WT_IN, scr, r, F.lane); continue; } r -= I_IN;
            if (r < I_O) { p0_transpose_item(F.w_out, DM, DM, 32, F.WT_OUT, scr, r, F.lane); continue; } r -= I_O;
            if (r < I_G) { p0_transpose_item(F.w_gate, DM, DM, 32, F.WT_GATE, scr, r, F.lane); continue; } r -= I_G;
            p0_transpose_item(F.w_up, PLE, DM, 32, F.WT_UP, scr, r, F.lane);
        }
        const size_t NT8 = (size_t)MTOK * PLE / 8, stride = (size_t)now * 64;
        for (size_t i0 = (size_t)ow * 64 + F.lane; i0 < NT8; i0 += 4 * stride) {
            f32x4 a[4], b[4];
#pragma unroll
            for (int k = 0; k < 4; ++k) { const size_t i = i0 + k * stride; if (i < NT8) { a[k] = __builtin_nontemporal_load((const f32x4*)(F.p + i * 8)); b[k] = __builtin_nontemporal_load((const f32x4*)(F.p + i * 8 + 4)); } }
#pragma unroll
            for (int k = 0; k < 4; ++k) { const size_t i = i0 + k * stride; if (i < NT8) { v4u o; o.x = pk2(a[k].x, a[k].y); o.y = pk2(a[k].z, a[k].w); o.z = pk2(b[k].x, b[k].y); o.w = pk2(b[k].z, b[k].w); *(v4u*)(F.PB + i * 8) = o; } }
        }
    }
    SUBSTAMP(1);
    SUBSTAMP(2);
}

__device__ __forceinline__ void phase_conv(Ctx& F) {
    const size_t NITEM = (size_t)MTOK * 128;
    for (size_t it = (size_t)blockIdx.x * 512 + F.tid; it < NITEM; it += (size_t)gridDim.x * 512) {
        const int row = (int)(it >> 7), c0 = (int)(it & 127) * 8, t = row & (SEQ - 1);
        float acc[8];
#pragma unroll
        for (int e = 0; e < 8; ++e) acc[e] = F.conv_b[c0 + e];
#pragma unroll
        for (int j = 0; j < 4; ++j) {
            if (t - 3 + j < 0) continue;
            const v4u r = *(const v4u*)(F.PROJ + (size_t)(row - 3 + j) * NPROJ + C_MLQ + c0);
            const f32x4 w0 = *(const f32x4*)(F.conv_w + j * 1024 + c0), w1 = *(const f32x4*)(F.conv_w + j * 1024 + c0 + 4);
            acc[0] += w0.x * bflo(r.x); acc[1] += w0.y * bfhi(r.x); acc[2] += w0.z * bflo(r.y); acc[3] += w0.w * bfhi(r.y);
            acc[4] += w1.x * bflo(r.z); acc[5] += w1.y * bfhi(r.z); acc[6] += w1.z * bflo(r.w); acc[7] += w1.w * bfhi(r.w);
        }
        const float sc = c0 >= 512 ? 0.08838834764831845f : 1.0f;
#pragma unroll
        for (int e = 0; e < 8; ++e) acc[e] = siluf_(acc[e]) * sc;
        v4u o; o.x = pk2(acc[0], acc[1]); o.y = pk2(acc[2], acc[3]); o.z = pk2(acc[4], acc[5]); o.w = pk2(acc[6], acc[7]);
        *(v4u*)(F.QKC + (size_t)row * 1024 + c0) = o;
    }
}

__device__ __forceinline__ void phase_norm(Ctx& F) {
    f32x4 pw[4];
#pragma unroll
    for (int j = 0; j < 2; ++j) { pw[2 * j] = *(const f32x4*)(F.post_w + 512 * j + 8 * F.lane); pw[2 * j + 1] = *(const f32x4*)(F.post_w + 512 * j + 8 * F.lane + 4); }
    v4u yn[2]; f32x4 xn[4];
#define NLOAD(m_) do { const v4u* yr_ = (const v4u*)(F.Y2 + (size_t)(m_) * DM) + F.lane; yn[0] = yr_[0]; yn[1] = yr_[64]; \
        const float* xp_ = F.x + (size_t)(m_) * DM + 8 * F.lane; xn[0] = __builtin_nontemporal_load((const f32x4*)xp_); xn[1] = __builtin_nontemporal_load((const f32x4*)(xp_ + 4)); xn[2] = __builtin_nontemporal_load((const f32x4*)(xp_ + 512)); xn[3] = __builtin_nontemporal_load((const f32x4*)(xp_ + 516)); } while (0)
    const int RPW4 = MTOK / F.NGW, m0 = (xcd_vblk() * 8 + F.wave) * RPW4, m1 = m0 + RPW4;
    NLOAD(m0);
    for (int m = m0; m < m1; ++m) {
        v4u yc[2] = {yn[0], yn[1]}; f32x4 xc[4] = {xn[0], xn[1], xn[2], xn[3]};
        NLOAD(m + 1 < m1 ? m + 1 : m);
        __builtin_amdgcn_sched_barrier(0);
        float y[16]; float s = 0.f;
#pragma unroll
        for (int j = 0; j < 2; ++j) { const v4u r = yc[j];
            y[8 * j + 0] = bflo(r.x); y[8 * j + 1] = bfhi(r.x); y[8 * j + 2] = bflo(r.y); y[8 * j + 3] = bfhi(r.y);
            y[8 * j + 4] = bflo(r.z); y[8 * j + 5] = bfhi(r.z); y[8 * j + 6] = bflo(r.w); y[8 * j + 7] = bfhi(r.w); }
#pragma unroll
        for (int e = 0; e < 16; ++e) s += y[e] * y[e];
        const float rstd = 1.0f / sqrtf(wave_sum(s) * (1.f / DM) + EPS);
#pragma unroll
        for (int j = 0; j < 2; ++j) {
            const int c = 512 * j + 8 * F.lane; const size_t o = (size_t)m * DM + c;
            f32x4 h0, h1;
#pragma unroll
            for (int e = 0; e < 4; ++e) { h0[e] = xc[2 * j][e] + y[8 * j + e] * rstd * pw[2 * j][e]; h1[e] = xc[2 * j + 1][e] + y[8 * j + 4 + e] * rstd * pw[2 * j + 1][e]; }
            v4u hb; hb.x = pk2(h0[0], h0[1]); hb.y = pk2(h0[2], h0[3]); hb.z = pk2(h1[0], h1[1]); hb.w = pk2(h1[2], h1[3]);
            *(v4u*)(F.HB + o) = hb;
        }
    }
#undef NLOAD
}
#define XB_TMO      128
#define XB_XCNT(j)  (256  + 64 * (j))
#define XB_XSUB(j)  (1280 + 64 * (j))
#define XB_XGEN(j)  (2304 + 64 * (j))
#define XB_TOP      3328
#define XB_TOPGEN   3392
#define XCD_BAR_WORDS 3456
#define XB_SPIN_CAP (1u << 18)

__device__ __forceinline__ unsigned xb_ld(unsigned* p)              { return __hip_atomic_load(p, __ATOMIC_RELAXED, __HIP_MEMORY_SCOPE_AGENT); }
__device__ __forceinline__ unsigned xb_add(unsigned* p, unsigned v) { return __hip_atomic_fetch_add(p, v, __ATOMIC_RELAXED, __HIP_MEMORY_SCOPE_AGENT); }
__device__ __forceinline__ unsigned xb_xcc_id() { return (unsigned)__builtin_amdgcn_s_getreg((3 << 11) | 20) & 0xFu; }
#define XB_SPIN(cond, bar) do { unsigned _sp = 0; while (cond) { __builtin_amdgcn_s_sleep(1); \
    if ((++_sp & 255u) == 0u) { if (xb_ld(&(bar)[XB_TMO])) break; if (_sp > XB_SPIN_CAP) { atomicAdd(&(bar)[XB_TMO], 1u); break; } } } } while (0)

struct XcdBarrier {
    unsigned* bar; unsigned x;
    volatile LAS unsigned* st;
};

__device__ __forceinline__ XcdBarrier xcd_barrier_post(unsigned* bar, volatile LAS unsigned* st) {
    XcdBarrier b; b.bar = bar; b.x = xb_xcc_id(); b.st = st;
    if (threadIdx.x == 0) (void)xb_add(&bar[XB_XCNT(b.x)], 1u);
    return b;
}
__device__ __forceinline__ void xcd_barrier_complete(unsigned* bar, unsigned x, unsigned& nloc, unsigned& nx) {
    const unsigned G = gridDim.x * gridDim.y * gridDim.z;
    unsigned sum, cnt, mine, sp = 0u;
    for (;;) {
        sum = 0u; cnt = 0u; mine = 0u;
#pragma unroll
        for (unsigned j = 0; j < 16; ++j) { const unsigned c = xb_ld(&bar[XB_XCNT(j)]); sum += c; cnt += (c > 0u) ? 1u : 0u; mine = (j == x) ? c : mine; }
        if (sum == G) break;
        __builtin_amdgcn_s_sleep(1);
        if ((++sp & 255u) == 0u) { if (xb_ld(&bar[XB_TMO])) break; if (sp > XB_SPIN_CAP) { atomicAdd(&bar[XB_TMO], 1u); break; } }
    }
    nloc = mine > 0u ? mine : 1u; nx = cnt > 0u ? cnt : 1u;
}

__device__ __forceinline__ void xcd_barrier(const XcdBarrier& b) {
    asm volatile("s_waitcnt vmcnt(0)" ::: "memory");
    __syncthreads();
    if (threadIdx.x == 0) {
        unsigned* bar = b.bar;
        __builtin_amdgcn_s_waitcnt(0);
        unsigned nloc = b.st[0], nx = b.st[1];
        if (nloc == 0u) { xcd_barrier_complete(bar, b.x, nloc, nx); b.st[0] = nloc; b.st[1] = nx; }
        const unsigned old = xb_add(&bar[XB_XSUB(b.x)], 1u);
        const unsigned gen = old / nloc;
        if (old + 1u == (gen + 1u) * nloc) {
            __builtin_amdgcn_fence(__ATOMIC_RELEASE, "agent");
            asm volatile("s_waitcnt vmcnt(0)" ::: "memory");
            const unsigned og = xb_add(&bar[XB_TOP], 1u);
            const unsigned tg = og / nx;
            if (og + 1u == (tg + 1u) * nx) xb_add(&bar[XB_TOPGEN], 1u);
            else XB_SPIN(xb_ld(&bar[XB_TOPGEN]) == tg, bar);
            __builtin_amdgcn_fence(__ATOMIC_ACQUIRE, "agent");
            xb_add(&bar[XB_XGEN(b.x)], 1u);
            asm volatile("s_waitcnt vmcnt(0)" ::: "memory");
        } else {
            XB_SPIN(xb_ld(&bar[XB_XGEN(b.x)]) == gen, bar);
            __builtin_amdgcn_fence(__ATOMIC_ACQUIRE, "agent");
            asm volatile("s_waitcnt vmcnt(0)" ::: "memory");
        }
    }
    __syncthreads();
}

typedef short v4i16_t __attribute__((ext_vector_type(4)));
typedef float f32x2_t __attribute__((ext_vector_type(2)));
typedef __bf16 bf16x2_t __attribute__((ext_vector_type(2)));
__device__ __forceinline__ unsigned cvtpk(float lo, float hi) { f32x2_t v = {lo, hi}; bf16x2_t b = __builtin_convertvector(v, bf16x2_t); return __builtin_bit_cast(unsigned, b); }
__device__ __forceinline__ s16x4 vtr(const LAS unsigned char* p) { return __builtin_bit_cast(s16x4, __builtin_amdgcn_ds_read_tr16_b64_v4i16((LAS v4i16_t*)p)); }
__device__ __forceinline__ bf16x8 pack8(const f32x16& x, int s) {
    v4u p; p.x = cvtpk(x[8 * s + 0], x[8 * s + 1]); p.y = cvtpk(x[8 * s + 2], x[8 * s + 3]); p.z = cvtpk(x[8 * s + 4], x[8 * s + 5]); p.w = cvtpk(x[8 * s + 6], x[8 * s + 7]);
    return __builtin_bit_cast(bf16x8, p);
}
template <bool MASK> __device__ __forceinline__ void sb_half(f32x16& p, float& R, int kbase, int t, int hi) {
    float lk[16];
#pragma unroll
    for (int i = 0; i < 16; ++i) {
        const float z = p[i];
        float v = -(fmaxf(z, 0.f) + __builtin_amdgcn_logf(1.f + __builtin_amdgcn_exp2f(-fabsf(z))));
        if (MASK) { const int key = kbase + (i & 3) + 8 * (i >> 2); v = key < t ? v : 0.f; }
        lk[i] = v;
    }
#pragma unroll
    for (int g = 0; g < 4; ++g) { lk[4 * g + 2] += lk[4 * g + 3]; lk[4 * g + 1] += lk[4 * g + 2]; lk[4 * g] += lk[4 * g + 1]; }
    float Glo[4], Ghi[4];
#pragma unroll
    for (int g = 0; g < 4; ++g) {
        const unsigned xb = __float_as_uint(lk[4 * g]); const auto rr = __builtin_amdgcn_permlane32_swap(xb, xb, false, false);
        Glo[g] = __uint_as_float(rr[0]); Ghi[g] = __uint_as_float(rr[1]); }
    float acc = R;
#pragma unroll
    for (int g = 3; g >= 0; --g) {
        const float off1 = acc, off0 = acc + Ghi[g]; acc = off0 + Glo[g];
        const float off = hi ? off1 : off0;
#pragma unroll
        for (int e = 0; e < 4; ++e) { const int i = 4 * g + e;
            float a = __builtin_amdgcn_exp2f(p[i] + (lk[i] + off));
            if (MASK) { const int key = kbase + (i & 3) + 8 * (i >> 2); a = key < t ? a : 0.f; }
            p[i] = a; }
    }
    R = acc;
}
__device__ __forceinline__ void attn_fast(Ctx& F, unsigned* ctr) {
    constexpr int VP = 144;
    LAS unsigned char* vt = F.lds + F.wave * 16384;
    int lane_ = F.lane; asm volatile("" : "+v"(lane_));
    const int lane = lane_, r32 = lane & 31, hi = lane >> 5;
    const int i16 = lane & 15, tq = i16 >> 2, tp = i16 & 3, blk = (lane >> 4) & 1;
    const int troff = (4 * hi + tq) * VP + (16 * blk + 4 * tp) * 2;
    const int vblk = (gridDim.x & 7) == 0 ? (int)(blockIdx.x & 7) * (int)(gridDim.x >> 3) + (int)(blockIdx.x >> 3) : (int)blockIdx.x;
    constexpr int NU = NB * 8 * (SEQ / 32);
#define LOAD_KV(KF, VR, KB_, VB_, k0_) do { const bf16* kp_ = (KB_) + (size_t)((k0_) + r32) * 64 + 8 * hi; \
            _Pragma("unroll") for (int hh = 0; hh < 2; ++hh) _Pragma("unroll") for (int d0 = 0; d0 < 4; ++d0) KF[hh][d0] = *(const bf16x8*)(kp_ + hh * 32 * 64 + 16 * d0); \
            const bf16* vp_ = (VB_) + (size_t)(k0_) * 64 + 8 * lane; \
            _Pragma("unroll") for (int i = 0; i < 8; ++i) VR[i] = *(const v4u*)(vp_ + 512 * i); } while (0)
#define LOAD_Q(QB_, t_) do { const bf16* qp_ = (QB_) + (size_t)(t_) * 64 + 8 * hi; _Pragma("unroll") for (int d0 = 0; d0 < 4; ++d0) qr[d0] = *(const bf16x8*)(qp_ + 16 * d0); } while (0)
    bf16x8 qr[4]; bf16x8 kf[2][4]; v4u vr[8];
    int unit = vblk * 8 + F.wave;
    if (unit < NU) {
        const int bh = unit >> 7, qb = unit & 127, b = bh >> 3, h = bh & 7, q0 = 32 * qb;
        LOAD_Q(F.PROJ + sb_off(0, b, h), q0 + r32);
        LOAD_KV(kf, vr, F.PROJ + sb_off(1, b, h), F.PROJ + sb_off(2, b, h), 64 * ((q0 + 31) >> 6));
    }
    while (unit < NU) {
        const int bh = unit >> 7, qb = unit & 127, b = bh >> 3, h = bh & 7, q0 = 32 * qb, t = q0 + r32;
        const bf16* kbase = F.PROJ + sb_off(1, b, h); const bf16* vbase = F.PROJ + sb_off(2, b, h); const bf16* zbase = F.PROJ + sb_off(3, b, h);
        const int kt = (q0 + 31) >> 6;
        f32x16 o[2];
#pragma unroll
        for (int i = 0; i < 16; ++i) { o[0][i] = 0.f; o[1][i] = 0.f; }
        float R = 0.f;
        for (int it = kt; it >= 0; --it) {
            const int k0 = 64 * it;
            asm volatile("" ::: "memory");
#pragma unroll
            for (int i = 0; i < 8; ++i) *(LAS v4u*)(vt + (8 * i + (lane >> 3)) * VP + 16 * (lane & 7)) = vr[i];
            asm volatile("" ::: "memory");
            bf16x8 kc[2][4];
#pragma unroll
            for (int hh = 0; hh < 2; ++hh)
#pragma unroll
                for (int d0 = 0; d0 < 4; ++d0) kc[hh][d0] = kf[hh][d0];
            if (it > 0) LOAD_KV(kf, vr, kbase, vbase, k0 - 64);
            const bool first = (it == kt);
            const bool do_hi = !first || (k0 + 32 <= q0 + 30);
            f32x16 p0, p1;
#pragma unroll
            for (int i = 0; i < 16; ++i) { p0[i] = 0.f; p1[i] = 0.f; }
#pragma unroll
            for (int d0 = 0; d0 < 4; ++d0) p0 = __builtin_amdgcn_mfma_f32_32x32x16_bf16(kc[0][d0], qr[d0], p0, 0, 0, 0);
            if (do_hi) {
#pragma unroll
                for (int d0 = 0; d0 < 4; ++d0) p1 = __builtin_amdgcn_mfma_f32_32x32x16_bf16(kc[1][d0], qr[d0], p1, 0, 0, 0);
                if (first) sb_half<true>(p1, R, k0 + 32 + 4 * hi, t, hi); else sb_half<false>(p1, R, k0 + 32 + 4 * hi, t, hi);
            }
            const bool do_lo = !(do_hi && __all(R < -151.f));
            if (do_lo) { if (first) sb_half<true>(p0, R, k0 + 4 * hi, t, hi); else sb_half<false>(p0, R, k0 + 4 * hi, t, hi); }
#pragma unroll
            for (int hh = 1; hh >= 0; --hh) {
                if (hh == 1 && !do_hi) continue;
                if (hh == 0 && !do_lo) continue;
#pragma unroll
                for (int s = 0; s < 2; ++s) {
                    const bf16x8 pa = pack8(hh ? p1 : p0, s);
#pragma unroll
                    for (int dh = 0; dh < 2; ++dh) {
                        const LAS unsigned char* vb = vt + troff + (32 * hh + 16 * s) * VP + 64 * dh;
                        const s16x4 lo = vtr(vb), hi4 = vtr(vb + 8 * VP);
                        const bf16x8 vf = {lo[0], lo[1], lo[2], lo[3], hi4[0], hi4[1], hi4[2], hi4[3]};
                        o[dh] = __builtin_amdgcn_mfma_f32_32x32x16_bf16(pa, vf, o[dh], 0, 0, 0);
                    }
                }
            }
            if (!do_lo || __all(R < -151.f)) break;
        }
        asm volatile("" ::: "memory");
        LAS float* os = (LAS float*)vt;
#pragma unroll
        for (int dh = 0; dh < 2; ++dh)
#pragma unroll
            for (int i = 0; i < 16; ++i) os[((i & 3) + 8 * (i >> 2) + 4 * hi) * 65 + 32 * dh + r32] = o[dh][i];
        asm volatile("" ::: "memory");
        const int q = lane >> 1, hf = lane & 1;
        v4u zr4[4];
#pragma unroll
        for (int c = 0; c < 4; ++c) zr4[c] = *(const v4u*)(zbase + (size_t)(q0 + q) * 64 + 32 * hf + 8 * c);
        const int nunit = unit + F.NGW;
        if (nunit < NU) {
            const int nbh = nunit >> 7, nqb = nunit & 127, nb = nbh >> 3, nh = nbh & 7, nq0 = 32 * nqb;
            LOAD_Q(F.PROJ + sb_off(0, nb, nh), nq0 + r32);
            LOAD_KV(kf, vr, F.PROJ + sb_off(1, nb, nh), F.PROJ + sb_off(2, nb, nh), 64 * ((nq0 + 31) >> 6));
        }
        float ov[32]; float ss = 0.f;
#pragma unroll
        for (int e = 0; e < 32; ++e) { ov[e] = os[q * 65 + 32 * hf + e]; ss += ov[e] * ov[e]; }
        ss += __shfl_xor(ss, 1);
        const float rstd = 1.0f / sqrtf(ss * (1.f / 64.f) + EPS);
        const size_t row = (size_t)b * SEQ + q0 + q;
        const int c0 = h * 64 + 32 * hf;
#pragma unroll
        for (int c = 0; c < 4; ++c) {
            const v4u zr = zr4[c];
            const f32x4 w0 = *(const f32x4*)(F.sb_w + c0 + 8 * c), w1 = *(const f32x4*)(F.sb_w + c0 + 8 * c + 4);
            v4u w;
            w.x = pk2(ov[8 * c + 0] * rstd * w0.x * siluf_(bflo(zr.x)), ov[8 * c + 1] * rstd * w0.y * siluf_(bfhi(zr.x)));
            w.y = pk2(ov[8 * c + 2] * rstd * w0.z * siluf_(bflo(zr.y)), ov[8 * c + 3] * rstd * w0.w * siluf_(bfhi(zr.y)));
            w.z = pk2(ov[8 * c + 4] * rstd * w1.x * siluf_(bflo(zr.z)), ov[8 * c + 5] * rstd * w1.y * siluf_(bfhi(zr.z)));
            w.w = pk2(ov[8 * c + 6] * rstd * w1.z * siluf_(bflo(zr.w)), ov[8 * c + 7] * rstd * w1.w * siluf_(bfhi(zr.w)));
            *(v4u*)(F.Y + row * DM + c0 + 8 * c) = w;
        }
        asm volatile("" ::: "memory");
        unit = nunit;
    }
#undef LOAD_KV
#undef LOAD_Q
}
__device__ __forceinline__ void attn32k(Ctx& F) {
    constexpr int VP = 144;
    LAS unsigned char* vt = F.lds + F.wave * 16384;
    int lane_ = F.lane; asm volatile("" : "+v"(lane_));
    const int lane = lane_, r32 = lane & 31, hi = lane >> 5;
    const int i16 = lane & 15, tq = i16 >> 2, tp = i16 & 3, blk = (lane >> 4) & 1;
    const int troff = (4 * hi + tq) * VP + (16 * blk + 4 * tp) * 2;
    const int vblk = (gridDim.x & 7) == 0 ? (int)(blockIdx.x & 7) * (int)(gridDim.x >> 3) + (int)(blockIdx.x >> 3) : (int)blockIdx.x;
    constexpr int NU = NB * 8 * (SEQ / 32);
#define A32_LOAD(KF, VR, s_) do { const bf16* kp_ = kbase + (size_t)(32 * (s_)) * 64 + 8 * lane; \
        _Pragma("unroll") for (int i = 0; i < 4; ++i) KF[i] = *(const bf16x8*)(kp_ + 512 * i);     \
        const bf16* vp_ = vbase + (size_t)(32 * (s_)) * 64 + 8 * lane; \
        _Pragma("unroll") for (int i = 0; i < 4; ++i) VR[i] = *(const v4u*)(vp_ + 512 * i); } while (0)
#define A32_STEP(KF, VR, s_, MASKED) do { \
        asm volatile("" ::: "memory"); \
        _Pragma("unroll") for (int i = 0; i < 4; ++i) { *(LAS v4u*)(vt + (8 * i + (lane >> 3)) * VP + 16 * (lane & 7)) = VR[i]; \
            *(LAS bf16x8*)(vt + 4608 + (8 * i + (lane >> 3)) * VP + 16 * (lane & 7)) = KF[i]; } \
        asm volatile("" ::: "memory"); \
        f32x16 p; _Pragma("unroll") for (int i = 0; i < 16; ++i) p[i] = 0.f; \
        _Pragma("unroll") for (int d0 = 0; d0 < 4; ++d0) { const bf16x8 kfr = *(const LAS bf16x8*)(vt + 4608 + r32 * VP + 32 * d0 + 16 * hi); \
            p = __builtin_amdgcn_mfma_f32_32x32x16_bf16(kfr, qr[d0], p, 0, 0, 0); } \
        asm volatile("" ::: "memory"); \
        A32_LOAD(KF, VR, ((s_) >= 2 ? (s_) - 2 : 0));     \
        if (MASKED) sb_half<true>(p, R, 32 * (s_) + 4 * hi, t, hi); else sb_half<false>(p, R, 32 * (s_) + 4 * hi, t, hi); \
        _Pragma("unroll") for (int ks = 0; ks < 2; ++ks) { const bf16x8 pa = pack8(p, ks); \
            _Pragma("unroll") for (int dh = 0; dh < 2; ++dh) { const LAS unsigned char* vb = vt + troff + (16 * ks) * VP + 64 * dh; \
                const s16x4 lo = vtr(vb), hi4 = vtr(vb + 8 * VP); const bf16x8 vf = {lo[0], lo[1], lo[2], lo[3], hi4[0], hi4[1], hi4[2], hi4[3]}; \
                o[dh] = __builtin_amdgcn_mfma_f32_32x32x16_bf16(pa, vf, o[dh], 0, 0, 0); } } } while (0)
    const bool aligned = gridDim.x == 256;
    const int ubase = aligned ? (vblk >> 5) * 1024 + (vblk & 31) * 8 + F.wave : vblk * 8 + F.wave, ustep = aligned ? 256 : F.NGW, uend = aligned ? (vblk >> 5) * 1024 + 1024 : NU;
    for (int unit = ubase; unit < uend; unit += ustep) {
        const int bh = unit >> 7, qb = unit & 127, b = bh >> 3, h = bh & 7, q0 = 32 * qb, t = q0 + r32;
        const bf16* qbase = F.PROJ + sb_off(0, b, h); const bf16* kbase = F.PROJ + sb_off(1, b, h); const bf16* vbase = F.PROJ + sb_off(2, b, h); const bf16* zbase = F.PROJ + sb_off(3, b, h);
        bf16x8 qr[4], kfA[4], kfB[4]; v4u vrA[4], vrB[4];
        { const bf16* qp = qbase + (size_t)t * 64 + 8 * hi;
#pragma unroll
          for (int d0 = 0; d0 < 4; ++d0) qr[d0] = *(const bf16x8*)(qp + 16 * d0); }
        A32_LOAD(kfA, vrA, qb);
        A32_LOAD(kfB, vrB, (qb >= 1 ? qb - 1 : 0));
        f32x16 o[2];
#pragma unroll
        for (int i = 0; i < 16; ++i) { o[0][i] = 0.f; o[1][i] = 0.f; }
        float R = 0.f;
        A32_STEP(kfA, vrA, qb, true);
        for (int s = qb - 1; s >= 0; s -= 2) {
            if (__all(R < -151.f)) break;
            A32_STEP(kfB, vrB, s, false);
            if (s == 0 || __all(R < -151.f)) break;
            A32_STEP(kfA, vrA, s - 1, false);
        }
        asm volatile("" ::: "memory");
        LAS float* os = (LAS float*)vt;
#pragma unroll
        for (int dh = 0; dh < 2; ++dh)
#pragma unroll
            for (int i = 0; i < 16; ++i) os[((i & 3) + 8 * (i >> 2) + 4 * hi) * 65 + 32 * dh + r32] = o[dh][i];
        asm volatile("" ::: "memory");
        const int q = lane >> 1, hf = lane & 1;
        float ov[32]; float ss = 0.f;
#pragma unroll
        for (int e = 0; e < 32; ++e) { ov[e] = os[q * 65 + 32 * hf + e]; ss += ov[e] * ov[e]; }
        ss += __shfl_xor(ss, 1);
        const float rstd = 1.0f / sqrtf(ss * (1.f / 64.f) + EPS);
        const size_t row = (size_t)b * SEQ + q0 + q;
        const int c0 = h * 64 + 32 * hf;
#pragma unroll
        for (int c = 0; c < 4; ++c) {
            const v4u zr = *(const v4u*)(zbase + (size_t)(q0 + q) * 64 + 32 * hf + 8 * c);
            const f32x4 w0 = *(const f32x4*)(F.sb_w + c0 + 8 * c), w1 = *(const f32x4*)(F.sb_w + c0 + 8 * c + 4);
            v4u w;
            w.x = pk2(ov[8 * c + 0] * rstd * w0.x * siluf_(bflo(zr.x)), ov[8 * c + 1] * rstd * w0.y * siluf_(bfhi(zr.x)));
            w.y = pk2(ov[8 * c + 2] * rstd * w0.z * siluf_(bflo(zr.y)), ov[8 * c + 3] * rstd * w0.w * siluf_(bfhi(zr.y)));
            w.z = pk2(ov[8 * c + 4] * rstd * w1.x * siluf_(bflo(zr.z)), ov[8 * c + 5] * rstd * w1.y * siluf_(bfhi(zr.z)));
            w.w = pk2(ov[8 * c + 6] * rstd * w1.z * siluf_(bflo(zr.w)), ov[8 * c + 7] * rstd * w1.w * siluf_(bfhi(zr.w)));
            *(v4u*)(F.Y + row * DM + c0 + 8 * c) = w;
        }
        asm volatile("" ::: "memory");
    }
#undef A32_LOAD
#undef A32_STEP
}
constexpr int SL_N = 16384, SL_SC = 16512, SL_STRIDE = 16640;
__device__ __forceinline__ v4u scale8(v4u r, float s) {
    v4u o; o.x = cvtpk(bflo(r.x) * s, bfhi(r.x) * s); o.y = cvtpk(bflo(r.y) * s, bfhi(r.y) * s); o.z = cvtpk(bflo(r.z) * s, bfhi(r.z) * s); o.w = cvtpk(bflo(r.w) * s, bfhi(r.w) * s); return o;
}
template <int PASS> __device__ __forceinline__ void mlstm_fast(Ctx& F, float* SLOC) {
    constexpr int PT = 272, PK = 288, SP = 144, HP = 129;
    constexpr int L_Q = 0, L_K = 17408, L_V = L_K + 18432, L_VW = L_V + 18432, L_S = L_VW + 18432, L_H = L_S + 9216, L_SC = L_H + 33024;
    constexpr int L_RAWQ = L_S, L_RAWK = L_S + 17408;
    constexpr int L_HALO = L_SC + 1024, L_CW = L_HALO + 3072;
    static_assert(L_RAWK + 17408 <= L_SC && L_CW + 5120 + 6144 <= 131072, "mLSTM LDS map");
    LAS unsigned char* L = F.lds;
    LAS float* su = (LAS float*)(L + L_SC); LAS float* sM = su + 64; LAS float* sb = su + 128; LAS bf16* swb = (LAS bf16*)(su + 192);
    LAS float* Hs = (LAS float*)(L + L_H);
    const int nunits = PASS == 1 ? NB * 4 * 7 : NB * 4 * 8;
    for (int unit = xcd_vblk(); unit < nunits; unit += gridDim.x) {
        int tid_ = F.tid; asm volatile("" : "+v"(tid_));
        const int tid = tid_, lane = tid & 63, w = __builtin_amdgcn_readfirstlane(tid >> 6), fr = lane & 15, fq = lane >> 4, tq = fr >> 2, tp = fr & 3;
        const int srow = tid >> 3, sc8 = tid & 7, v0 = 16 * w;
        int bh, seg; if (PASS == 1) { bh = unit / 7; seg = unit % 7; } else { bh = unit >> 3; seg = unit & 7; }
        const int b = bh >> 2, h = bh & 3;
        const size_t row0 = (size_t)b * SEQ + (size_t)seg * 512;
        f32x4 X[8], Xn[8];
#pragma unroll
        for (int t = 0; t < 8; ++t) { X[t] = (f32x4){0.f, 0.f, 0.f, 0.f}; Xn[t] = (f32x4){0.f, 0.f, 0.f, 0.f}; }
        float m_prev = PASS == 1 ? -1e30f : 0.f, bsum = 0.f;
        if (PASS == 2) {
            for (int j = 0; j < seg; ++j) {
                const float* S = SLOC + (size_t)(bh * 7 + j) * SL_STRIDE;
                const float mloc = S[SL_SC], Bs = S[SL_SC + 1];
                const float m_new = fmaxf(Bs + m_prev, mloc), fa = __expf(Bs + m_prev - m_new), fg = __expf(mloc - m_new);
#pragma unroll
                for (int t = 0; t < 8; ++t) { const f32x4 cl = *(const f32x4*)(S + (size_t)(t * 512 + tid) * 4); X[t] = X[t] * fa + cl * fg;
                    const f32x4 nl = *(const f32x4*)(S + SL_N + 16 * t + 4 * fq); Xn[t] = Xn[t] * fa + nl * fg; }
                m_prev = m_new;
            }
        }
        LDS_BARRIER();
        { LAS float* gsc = (LAS float*)(L + L_CW + 5120);
          const float* gg = F.GATES + (row0 + tid) * 8; const float ig0 = gg[h]; float bc0 = gg[4 + h];
#pragma unroll
          for (int o = 1; o < 64; o <<= 1) { const float t_ = __shfl_up(bc0, o); if (lane >= o) bc0 += t_; }
          const float u0 = ig0 - bc0; float pm0 = u0;
#pragma unroll
          for (int o = 1; o < 64; o <<= 1) { const float t_ = __shfl_up(pm0, o); if (lane >= o) pm0 = fmaxf(pm0, t_); }
          gsc[tid] = bc0; gsc[512 + tid] = u0; gsc[1024 + tid] = pm0; }
        { int tu = tid; asm volatile("" : "+v"(tu));
          LAS float* cw = (LAS float*)(L + L_CW);
          for (int e = tu; e < 1280; e += 512) { float val;
              if (e < 1024) { const int tn = e >> 9, j = (e >> 7) & 3, cch = e & 127; val = F.conv_w[j * 1024 + tn * 512 + h * 128 + cch]; }
              else { const int tn = (e - 1024) >> 7, cch = e & 127; val = F.conv_b[tn * 512 + h * 128 + cch]; }
              cw[e] = val; }
          if (tu < 96) { const int tn = tu >= 48 ? 1 : 0, r = (tu - 48 * tn) >> 4, c16 = tu & 15; v4u hv = (v4u){0u, 0u, 0u, 0u};
              if (seg > 0) hv = *(const v4u*)(F.PROJ + ml_off(tn ? 5 : 4, b, h) + (size_t)(seg * 512 - 3 + r) * 128 + 8 * c16);
              *(LAS v4u*)(L + L_HALO + (tn * 3 + r) * 256 + 16 * c16) = hv; } }
        v4u pq0, pq1, pk0, pk1, pv0, pv1;
#define MPREF(c_) do { const size_t tl_ = (size_t)(seg * 512 + (c_) * 64 + srow) * 128 + 8 * sc8; \
            if (PASS == 2) { const bf16* q_ = F.PROJ + ml_off(4, b, h) + tl_; pq0 = *(const v4u*)(q_); pq1 = *(const v4u*)(q_ + 64); } \
            { const bf16* k_ = F.PROJ + ml_off(5, b, h) + tl_; const bf16* vv_ = F.PROJ + ml_off(6, b, h) + tl_; \
              pk0 = *(const v4u*)(k_); pk1 = *(const v4u*)(k_ + 64); pv0 = *(const v4u*)(vv_); pv1 = *(const v4u*)(vv_ + 64); } \
            } while (0)
        MPREF(0);
        for (int c = 0; c < 8; ++c) {
            const size_t rowc = row0 + (size_t)c * 64;
            LDS_BARRIER();
            const LAS float* gsc = (const LAS float*)(L + L_CW + 5120);
            const float bc = gsc[c * 64 + lane], u = gsc[512 + c * 64 + lane], pm = gsc[1024 + c * 64 + lane];
            const float Mv = fmaxf(m_prev, pm), M63 = __shfl(Mv, 63), blast = __shfl(bc, 63);
            const float wgt = __expf(u - M63);
            if (w == 0) { su[lane] = u; sM[lane] = Mv; sb[lane] = bc; swb[lane] = (bf16)(cvtpk(wgt, 0.f) & 0xffffu); }
            const float wrow = __shfl(wgt, srow);
            *(LAS v4u*)(L + L_RAWK + srow * PT + 16 * sc8) = pk0; *(LAS v4u*)(L + L_RAWK + srow * PT + 16 * (sc8 + 8)) = pk1;
            *(LAS v4u*)(L + L_VW + srow * PK + 16 * sc8) = scale8(pv0, wrow); *(LAS v4u*)(L + L_VW + srow * PK + 16 * (sc8 + 8)) = scale8(pv1, wrow);
            if (PASS == 2) {
                *(LAS v4u*)(L + L_RAWQ + srow * PT + 16 * sc8) = pq0; *(LAS v4u*)(L + L_RAWQ + srow * PT + 16 * (sc8 + 8)) = pq1;
                *(LAS v4u*)(L + L_V + srow * PK + 16 * sc8) = pv0; *(LAS v4u*)(L + L_V + srow * PK + 16 * (sc8 + 8)) = pv1;
            }
            LDS_BARRIER();
            { const int cgp = tid & 31, tn = cgp >> 4, c16 = cgp & 15, rg4 = tid >> 5;
              if (PASS == 2 || tn == 1) {
                  const LAS unsigned char* rawb = L + (tn ? L_RAWK : L_RAWQ) + 16 * c16;
                  const LAS unsigned char* halob = L + L_HALO + ((c & 1) * 6 + tn * 3) * 256 + 16 * c16;
#pragma unroll 1
                  for (int hf = 0; hf < 2; ++hf) {
                      v2u rw[7];
#pragma unroll
                      for (int i = 0; i < 7; ++i) { const int rr = 4 * rg4 - 3 + i; rw[i] = *(const LAS v2u*)((rr >= 0 ? rawb + rr * PT : halob + (3 + rr) * 256) + 8 * hf); }
                      const LAS float* cw = (const LAS float*)(L + L_CW) + tn * 512 + 8 * c16 + 4 * hf;
                      const f32x4 b0 = *(const LAS f32x4*)((const LAS float*)(L + L_CW) + 1024 + tn * 128 + 8 * c16 + 4 * hf);
                      f32x4 w0[4];
#pragma unroll
                      for (int j = 0; j < 4; ++j) w0[j] = *(const LAS f32x4*)(cw + j * 128);
                      const float sc = tn ? 0.08838834764831845f : 1.0f;
#pragma unroll
                      for (int o = 0; o < 4; ++o) {
                          f32x4 a0 = b0;
#pragma unroll
                          for (int j = 0; j < 4; ++j) { const v2u r = rw[o + j];
                              a0[0] += w0[j][0] * bflo(r.x); a0[1] += w0[j][1] * bfhi(r.x); a0[2] += w0[j][2] * bflo(r.y); a0[3] += w0[j][3] * bfhi(r.y); }
                          v2u ov; ov.x = cvtpk(siluf_(a0[0]) * sc, siluf_(a0[1]) * sc); ov.y = cvtpk(siluf_(a0[2]) * sc, siluf_(a0[3]) * sc);
                          *(LAS v2u*)(L + (tn ? L_K + (4 * rg4 + o) * PK : L_Q + (4 * rg4 + o) * PT) + 16 * c16 + 8 * hf) = ov;
                      }
                      if (rg4 == 15) {
#pragma unroll
                          for (int r = 0; r < 3; ++r) *(LAS v2u*)(L + L_HALO + (((c + 1) & 1) * 6 + tn * 3 + r) * 256 + 16 * c16 + 8 * hf) = rw[4 + r];
                      }
                  }
              } }
            MPREF(c + 1 < 8 ? c + 1 : 7); __builtin_amdgcn_sched_barrier(0);
            v4u po0, po1, pz0, pz1;
            if (PASS == 2) { const size_t tl = (size_t)(seg * 512 + c * 64 + srow) * 128 + 16 * sc8;
                const bf16* op = F.PROJ + ml_off(7, b, h) + tl; const bf16* zp = F.PROJ + ml_off(8, b, h) + tl;
                po0 = *(const v4u*)(op); po1 = *(const v4u*)(op + 8); pz0 = *(const v4u*)(zp); pz1 = *(const v4u*)(zp + 8); }
            LDS_BARRIER();
            if (PASS == 2) {
                const int lt = w & 3, sp = w >> 2;
#pragma unroll
                for (int si = 0; si < 2; ++si) {
                    const int st = 2 * sp + si;
                    f32x4 acc = (f32x4){0.f, 0.f, 0.f, 0.f};
                    if (st <= lt) {
#pragma unroll
                        for (int ks = 0; ks < 4; ++ks) {
                            const bf16x8 ak = *(const LAS bf16x8*)(L + L_K + (16 * st + fr) * PK + (32 * ks + 8 * fq) * 2);
                            const bf16x8 bq = *(const LAS bf16x8*)(L + L_Q + (16 * lt + fr) * PT + (32 * ks + 8 * fq) * 2);
                            acc = __builtin_amdgcn_mfma_f32_16x16x32_bf16(ak, bq, acc, 0, 0, 0);
                        }
                        const f32x4 us = *(const LAS f32x4*)(su + 16 * st + 4 * fq); const float Ml = sM[16 * lt + fr];
                        const int l = 16 * lt + fr, s0 = 16 * st + 4 * fq;
#pragma unroll
                        for (int j = 0; j < 4; ++j) acc[j] = (s0 + j <= l) ? acc[j] * __expf(us[j] - Ml) : 0.f;
                    }
                    v2u pw; pw.x = cvtpk(acc[0], acc[1]); pw.y = cvtpk(acc[2], acc[3]);
                    *(LAS v2u*)(L + L_S + (16 * lt + fr) * SP + (16 * st + 4 * fq) * 2) = pw;
                }
                LDS_BARRIER();
                f32x4 num[4], den[4];
#pragma unroll
                for (int i = 0; i < 4; ++i) { num[i] = (f32x4){0.f, 0.f, 0.f, 0.f}; den[i] = (f32x4){0.f, 0.f, 0.f, 0.f}; }
#pragma unroll
                for (int kk = 0; kk < 4; ++kk) {
                    v4u bsw, bnw;
                    bsw.x = cvtpk(X[2 * kk][0], X[2 * kk][1]); bsw.y = cvtpk(X[2 * kk][2], X[2 * kk][3]); bsw.z = cvtpk(X[2 * kk + 1][0], X[2 * kk + 1][1]); bsw.w = cvtpk(X[2 * kk + 1][2], X[2 * kk + 1][3]);
                    bnw.x = cvtpk(Xn[2 * kk][0], Xn[2 * kk][1]); bnw.y = cvtpk(Xn[2 * kk][2], Xn[2 * kk][3]); bnw.z = cvtpk(Xn[2 * kk + 1][0], Xn[2 * kk + 1][1]); bnw.w = cvtpk(Xn[2 * kk + 1][2], Xn[2 * kk + 1][3]);
                    const bf16x8 bs = __builtin_bit_cast(bf16x8, bsw), bn = __builtin_bit_cast(bf16x8, bnw);
#pragma unroll
                    for (int i = 0; i < 4; ++i) {
                        const LAS unsigned char* qa = L + L_Q + (16 * i + fr) * PT + (32 * kk + 4 * fq) * 2;
                        const v2u lo = *(const LAS v2u*)qa, hi = *(const LAS v2u*)(qa + 32);
                        const v4u aw = {lo.x, lo.y, hi.x, hi.y}; const bf16x8 aq = __builtin_bit_cast(bf16x8, aw);
                        num[i] = __builtin_amdgcn_mfma_f32_16x16x32_bf16(aq, bs, num[i], 0, 0, 0);
                        den[i] = __builtin_amdgcn_mfma_f32_16x16x32_bf16(aq, bn, den[i], 0, 0, 0);
                    }
                    __builtin_amdgcn_sched_barrier(0);
                }
#pragma unroll
                for (int i = 0; i < 4; ++i) { const f32x4 Ml = *(const LAS f32x4*)(sM + 16 * i + 4 * fq);
#pragma unroll
                    for (int j = 0; j < 4; ++j) { const float cs = __expf(m_prev - Ml[j]); num[i][j] *= cs; den[i][j] *= cs; } }
                const v4u onesw = {0x3f803f80u, 0x3f803f80u, 0x3f803f80u, 0x3f803f80u}; const bf16x8 ones = __builtin_bit_cast(bf16x8, onesw);
#pragma unroll
                for (int ks = 0; ks < 2; ++ks) {
                    const LAS unsigned char* vb = L + L_V + (32 * ks + 8 * fq + tq) * PK + (v0 + 4 * tp) * 2;
                    const s16x4 lo = vtr(vb), hi4 = vtr(vb + 4 * PK);
                    const bf16x8 bv = {lo[0], lo[1], lo[2], lo[3], hi4[0], hi4[1], hi4[2], hi4[3]};
#pragma unroll
                    for (int i = 0; i < 4; ++i) {
                        if (32 * ks > 16 * i + 15) continue;
                        const bf16x8 as = *(const LAS bf16x8*)(L + L_S + (16 * i + fr) * SP + (32 * ks + 8 * fq) * 2);
                        num[i] = __builtin_amdgcn_mfma_f32_16x16x32_bf16(as, bv, num[i], 0, 0, 0);
                        den[i] = __builtin_amdgcn_mfma_f32_16x16x32_bf16(as, ones, den[i], 0, 0, 0);
                    }
                }
#pragma unroll
                for (int i = 0; i < 4; ++i) { const f32x4 Ml = *(const LAS f32x4*)(sM + 16 * i + 4 * fq), bl = *(const LAS f32x4*)(sb + 16 * i + 4 * fq);
#pragma unroll
                    for (int j = 0; j < 4; ++j) Hs[(16 * i + 4 * fq + j) * HP + v0 + fr] = num[i][j] * __builtin_amdgcn_rcpf(fmaxf(fabsf(den[i][j]), __expf(-(bl[j] + Ml[j])))); }
            }
            {
                const float a = __expf(m_prev - M63);
#pragma unroll
                for (int t = 0; t < 8; ++t) { X[t] *= a; Xn[t] *= a; }
#pragma unroll
                for (int ks = 0; ks < 2; ++ks) {
                    const LAS unsigned char* vb = L + L_VW + (32 * ks + 8 * fq + tq) * PK + (v0 + 4 * tp) * 2;
                    const s16x4 lo = vtr(vb), hi4 = vtr(vb + 4 * PK);
                    const bf16x8 bv = {lo[0], lo[1], lo[2], lo[3], hi4[0], hi4[1], hi4[2], hi4[3]};
                    const bf16x8 bw = *(const LAS bf16x8*)(swb + 32 * ks + 8 * fq);
#pragma unroll
                    for (int t = 0; t < 8; ++t) {
                        const LAS unsigned char* kb = L + L_K + (32 * ks + 8 * fq + tq) * PK + (16 * t + 4 * tp) * 2;
                        const s16x4 klo = vtr(kb), khi = vtr(kb + 4 * PK);
                        const bf16x8 ak = {klo[0], klo[1], klo[2], klo[3], khi[0], khi[1], khi[2], khi[3]};
                        X[t] = __builtin_amdgcn_mfma_f32_16x16x32_bf16(ak, bv, X[t], 0, 0, 0);
                        Xn[t] = __builtin_amdgcn_mfma_f32_16x16x32_bf16(ak, bw, Xn[t], 0, 0, 0);
                        if (t & 1) __builtin_amdgcn_sched_barrier(0);
                    }
                }
                m_prev = blast + M63; bsum += blast;
            }
            if (PASS == 2) {
                LDS_BARRIER();
                const unsigned ow[8] = {po0.x, po0.y, po0.z, po0.w, po1.x, po1.y, po1.z, po1.w}, zw[8] = {pz0.x, pz0.y, pz0.z, pz0.w, pz1.x, pz1.y, pz1.z, pz1.w};
                float yv[16]; float ss = 0.f;
#pragma unroll
                for (int e = 0; e < 8; ++e) { const float h0 = Hs[srow * HP + 16 * sc8 + 2 * e], h1 = Hs[srow * HP + 16 * sc8 + 2 * e + 1];
                    yv[2 * e] = sigmoidf_(bflo(ow[e])) * h0; yv[2 * e + 1] = sigmoidf_(bfhi(ow[e])) * h1; ss += yv[2 * e] * yv[2 * e] + yv[2 * e + 1] * yv[2 * e + 1]; }
                ss += __shfl_xor(ss, 1); ss += __shfl_xor(ss, 2); ss += __shfl_xor(ss, 4);
                const float rstd = 1.0f / sqrtf(ss * (1.f / 128.f) + EPS);
                const float* nw = F.ml_w + h * 128 + 16 * sc8;
                unsigned outw[8];
#pragma unroll
                for (int e = 0; e < 8; ++e) outw[e] = pk2(yv[2 * e] * rstd * nw[2 * e] * siluf_(bflo(zw[e])), yv[2 * e + 1] * rstd * nw[2 * e + 1] * siluf_(bfhi(zw[e])));
                bf16* yp = F.Y + (rowc + srow) * DM + 512 + h * 128 + 16 * sc8;
                *(v4u*)yp = (v4u){outw[0], outw[1], outw[2], outw[3]}; *(v4u*)(yp + 8) = (v4u){outw[4], outw[5], outw[6], outw[7]};
            }
        }
#undef MPREF
        if (PASS == 1) {
            float* S = SLOC + (size_t)(bh * 7 + seg) * SL_STRIDE;
#pragma unroll
            for (int t = 0; t < 8; ++t) { *(f32x4*)(S + (size_t)(t * 512 + tid) * 4) = X[t]; if (w == 0 && fr == 0) *(f32x4*)(S + SL_N + 16 * t + 4 * fq) = Xn[t]; }
            if (tid == 0) { S[SL_SC] = m_prev; S[SL_SC + 1] = bsum; }
        }
        LDS_BARRIER();
    }
}
__device__ __forceinline__ void mlstm_pass1(Ctx& F, float* SLOC) {
    constexpr int PT = 288;
    constexpr int L_KB = 0, L_VB = 2 * 18432, L_W = 4 * 18432, L_WB = L_W + 2048, L_RED = L_WB + 1024;
    LAS unsigned char* L = F.lds;
    LAS float* sw = (LAS float*)(L + L_W); LAS bf16* swb = (LAS bf16*)(L + L_WB); LAS float* red = (LAS float*)(L + L_RED);
    for (int vu = xcd_vblk(); vu < NB * 32; vu += gridDim.x) {
        if ((vu & 31) >= 28) continue;
        const int unit = (vu >> 5) * 28 + (vu & 31);
        int tid_ = F.tid; asm volatile("" : "+v"(tid_));
        const int tid = tid_, lane = tid & 63, w = __builtin_amdgcn_readfirstlane(tid >> 6), fr = lane & 15, fq = lane >> 4, tq = fr >> 2, tp = fr & 3;
        const int srow = tid >> 3, sc8 = tid & 7, v0 = 16 * w, c16 = tid & 15, rg2 = tid >> 4;
        const int bh = unit / 7, seg = unit % 7, b = bh >> 2, h = bh & 3;
        const size_t row0 = (size_t)b * SEQ + (size_t)seg * 512;
        LDS_BARRIER();
        float bc, u;
        { const float* gg = F.GATES + (row0 + tid) * 8; const float ig = gg[h]; bc = gg[4 + h];
#pragma unroll
          for (int o = 1; o < 64; o <<= 1) { const float t_ = __shfl_up(bc, o); if (lane >= o) bc += t_; }
          if (lane == 63) red[w] = bc;
          LDS_BARRIER();
          float off = 0.f;
#pragma unroll
          for (int i = 0; i < 8; ++i) off += (i < w) ? red[i] : 0.f;
          bc += off; u = ig - bc;
          float mx = u;
#pragma unroll
          for (int o = 1; o < 64; o <<= 1) mx = fmaxf(mx, __shfl_xor(mx, o));
          if (lane == 0) red[8 + w] = mx;
          if (tid == 511) red[16] = bc;
          LDS_BARRIER();
          float umax = red[8];
#pragma unroll
          for (int i = 1; i < 8; ++i) umax = fmaxf(umax, red[8 + i]);
          const float wgt = __expf(u - umax);
          sw[tid] = wgt; swb[tid] = (bf16)(cvtpk(wgt, 0.f) & 0xffffu);
          if (tid == 0) { float* S = SLOC + (size_t)(bh * 7 + seg) * SL_STRIDE; S[SL_SC] = red[16] + umax; S[SL_SC + 1] = red[16]; }
        }
        f32x4 cwa[4], cwb[4], cba, cbb;
        { const float* cw = F.conv_w + 512 + h * 128 + 8 * c16;
#pragma unroll
          for (int j = 0; j < 4; ++j) { cwa[j] = *(const f32x4*)(cw + j * 1024); cwb[j] = *(const f32x4*)(cw + j * 1024 + 4); }
          cba = *(const f32x4*)(F.conv_b + 512 + h * 128 + 8 * c16); cbb = *(const f32x4*)(F.conv_b + 512 + h * 128 + 8 * c16 + 4); }
        f32x4 X[8], Xn[8];
#pragma unroll
        for (int t = 0; t < 8; ++t) { X[t] = (f32x4){0.f, 0.f, 0.f, 0.f}; Xn[t] = (f32x4){0.f, 0.f, 0.f, 0.f}; }
        v4u rk[5], pv0, pv1;
#define P1PREF(c_) do { const long tb_ = (long)(seg * 512 + (c_) * 64 + 2 * rg2 - 3); \
            _Pragma("unroll") for (int i = 0; i < 5; ++i) { const long tr_ = tb_ + i; const v4u ld_ = *(const v4u*)(F.PROJ + ml_off(5, b, h) + (size_t)(tr_ < 0 ? 0 : tr_) * 128 + 8 * c16); \
                rk[i].x = tr_ < 0 ? 0u : ld_.x; rk[i].y = tr_ < 0 ? 0u : ld_.y; rk[i].z = tr_ < 0 ? 0u : ld_.z; rk[i].w = tr_ < 0 ? 0u : ld_.w; }     \
            const bf16* vv_ = F.PROJ + ml_off(6, b, h) + (size_t)(seg * 512 + (c_) * 64 + srow) * 128 + 8 * sc8; pv0 = *(const v4u*)vv_; pv1 = *(const v4u*)(vv_ + 64); } while (0)
        P1PREF(0);
        LDS_BARRIER();
        for (int c = 0; c < 8; ++c) {
            LAS unsigned char* KB = L + L_KB + (c & 1) * 18432; LAS unsigned char* VB = L + L_VB + (c & 1) * 18432;
#pragma unroll
            for (int o = 0; o < 2; ++o) {
                f32x4 a0 = cba, a1 = cbb;
#pragma unroll
                for (int j = 0; j < 4; ++j) { const v4u r = rk[o + j];
                    a0[0] += cwa[j][0] * bflo(r.x); a0[1] += cwa[j][1] * bfhi(r.x); a0[2] += cwa[j][2] * bflo(r.y); a0[3] += cwa[j][3] * bfhi(r.y);
                    a1[0] += cwb[j][0] * bflo(r.z); a1[1] += cwb[j][1] * bfhi(r.z); a1[2] += cwb[j][2] * bflo(r.w); a1[3] += cwb[j][3] * bfhi(r.w); }
                const float sc = 0.08838834764831845f;
                v4u ov; ov.x = cvtpk(siluf_(a0[0]) * sc, siluf_(a0[1]) * sc); ov.y = cvtpk(siluf_(a0[2]) * sc, siluf_(a0[3]) * sc);
                ov.z = cvtpk(siluf_(a1[0]) * sc, siluf_(a1[1]) * sc); ov.w = cvtpk(siluf_(a1[2]) * sc, siluf_(a1[3]) * sc);
                *(LAS v4u*)(KB + (2 * rg2 + o) * PT + 16 * c16) = ov;
            }
            { const float wrow = sw[c * 64 + srow];
              *(LAS v4u*)(VB + srow * PT + 16 * sc8) = scale8(pv0, wrow); *(LAS v4u*)(VB + srow * PT + 16 * (sc8 + 8)) = scale8(pv1, wrow); }
            P1PREF(c + 1 < 8 ? c + 1 : 7); __builtin_amdgcn_sched_barrier(0);
            LDS_BARRIER();
#pragma unroll
            for (int ks = 0; ks < 2; ++ks) {
                const LAS unsigned char* vb = VB + (32 * ks + 8 * fq + tq) * PT + (v0 + 4 * tp) * 2;
                const s16x4 lo = vtr(vb), hi4 = vtr(vb + 4 * PT);
                const bf16x8 bv = {lo[0], lo[1], lo[2], lo[3], hi4[0], hi4[1], hi4[2], hi4[3]};
                const bf16x8 bw = *(const LAS bf16x8*)(swb + c * 64 + 32 * ks + 8 * fq);
#pragma unroll
                for (int t = 0; t < 8; ++t) {
                    const LAS unsigned char* kb = KB + (32 * ks + 8 * fq + tq) * PT + (16 * t + 4 * tp) * 2;
                    const s16x4 klo = vtr(kb), khi = vtr(kb + 4 * PT);
                    const bf16x8 ak = {klo[0], klo[1], klo[2], klo[3], khi[0], khi[1], khi[2], khi[3]};
                    X[t] = __builtin_amdgcn_mfma_f32_16x16x32_bf16(ak, bv, X[t], 0, 0, 0);
                    Xn[t] = __builtin_amdgcn_mfma_f32_16x16x32_bf16(ak, bw, Xn[t], 0, 0, 0);
                }
            }
        }
#undef P1PREF
        { float* S = SLOC + (size_t)(bh * 7 + seg) * SL_STRIDE;
#pragma unroll
          for (int t = 0; t < 8; ++t) { *(f32x4*)(S + (size_t)(t * 512 + tid) * 4) = X[t]; if (w == 0 && fr == 0) *(f32x4*)(S + SL_N + 16 * t + 4 * fq) = Xn[t]; } }
        LDS_BARRIER();
    }
}
#ifdef PROBE_SUB
#define SUB40(i) do { if (blockIdx.x == 40 && threadIdx.x == 0) g_sub_ts[i] = __builtin_amdgcn_s_memrealtime(); } while (0)
#else
#define SUB40(i) do { } while (0)
#endif
#define MIXERS(F) do { SUB40(4); attn32k(F); SUB40(5); mlstm_pass1(F, (float*)(args.ws + WS_PB)); SUB40(6); GRID_SEAM(); TSTAMP(3); SUB40(7); mlstm_fast<2>(F, (float*)(args.ws + WS_PB)); } while (0)
#ifdef PROBE_PH
#ifndef PROBE_PH_END
#define PROBE_PH_END (PROBE_PH + 1)
#endif
#define TSTAMP(i) do { ts_[i] = __builtin_amdgcn_s_memrealtime(); } while (0)
#define TSPIN() do { if (blockIdx.x == 0 && F.tid == 0) { const unsigned long long dt_ = ts_[PROBE_PH_END] - ts_[PROBE_PH], t0_ = __builtin_amdgcn_s_memrealtime(); \
    while (__builtin_amdgcn_s_memrealtime() - t0_ < dt_) __builtin_amdgcn_s_sleep(8); } } while (0)
#elif defined(PROBE_SUB)
#define TSTAMP(i) do { } while (0)
#define TSPIN() do { if (blockIdx.x == 0 && F.tid == 0) { const unsigned long long dt_ = g_sub_ts[PROBE_SUB_B] - g_sub_ts[PROBE_SUB_A], t0_ = __builtin_amdgcn_s_memrealtime(); \
    while (__builtin_amdgcn_s_memrealtime() - t0_ < dt_) __builtin_amdgcn_s_sleep(8); } } while (0)
#else
#define TSTAMP(i) do { } while (0)
#define TSPIN() do { } while (0)
#endif
#define GRID_SEAM() xcd_barrier(xbar)
#define GRID_SEAM_() xcd_barrier(xbar)
#ifndef REP_SYNC
#define REP_SYNC 0
#endif
#ifndef REP_P0
#define REP_P0 1
#endif
#ifndef REP_P1
#define REP_P1 1
#endif
#ifndef REP_P3
#define REP_P3 1
#endif
__global__ void __launch_bounds__(512, 2) fwd_kernel(Args args) {
    extern __shared__ __attribute__((aligned(16))) unsigned char lds_raw[];
    cg::grid_group grid = cg::this_grid();
    Ctx F;
#ifdef PROBE_PH
    unsigned long long ts_[8];
#endif
    F.lds = (LAS unsigned char*)lds_raw;
    F.tid = threadIdx.x; F.lane = F.tid & 63; F.wave = __builtin_amdgcn_readfirstlane(F.tid >> 6);
    F.gw = blockIdx.x * 8 + F.wave; F.NGW = gridDim.x * 8;
    F.x = args.in[0]; F.p = args.in[1]; F.pre_w = args.in[2]; F.w_in = args.in[3]; F.conv_w = args.in[4]; F.conv_b = args.in[5]; F.i_bias = args.in[6]; F.f_bias = args.in[7];
    F.sb_w = args.in[8]; F.ml_w = args.in[9]; F.w_out = args.in[10]; F.post_w = args.in[11]; F.w_up = args.in[12]; F.w_gate = args.in[13]; F.b_gate = args.in[14];
    F.out = args.out; unsigned char* ws = args.ws;
    F.WT_IN = (bf16*)(ws + WS_WIN); F.WT_OUT = (bf16*)(ws + WS_WOUT); F.WT_GATE = (bf16*)(ws + WS_WGATE); F.WT_UP = (bf16*)(ws + WS_WUP); F.GATES = (float*)(ws + WS_GATES);
    F.U = (bf16*)(ws + WS_U); F.Y = F.U; F.HB = F.U; F.PROJ = (bf16*)(ws + WS_PROJ); F.Y2 = F.PROJ; F.PU = (bf16*)(ws + WS_PU); F.PB = (bf16*)(ws + WS_PB); F.QKC = (bf16*)(ws + WS_QKC);

    volatile LAS unsigned* bar_st = (volatile LAS unsigned*)(F.lds + 131072 + 512);
    if (F.tid < 2) bar_st[F.tid] = 0u;
    __syncthreads();
    unsigned* bar_words = (unsigned*)args.ws;
    if (args.ws == nullptr) grid.sync();
    const XcdBarrier xbar = xcd_barrier_post(bar_words, bar_st);
    TSTAMP(0);
    for (int rep_ = 0; rep_ < REP_P0; ++rep_) phase0(F);
    GRID_SEAM_();
    TSTAMP(1);

    for (int rep_ = 0; rep_ < REP_SYNC; ++rep_) GRID_SEAM();
    for (int rep_ = 0; rep_ < REP_P1; ++rep_) {
        pg8::Gemm g{F.U, F.WT_IN, MTOK, NPROJ, DM}; ProjOrder S; S.init(MTOK, NPROJ, gridDim.x, blockIdx.x);
        EpiProj E{F.PROJ, 0.125f * 1.4426950408889634f};
        pg8::gemm_phase<EpiProj, ProjOrder, true, true>(F.lds, g, S, E);
        pg8::Gemm g2{F.PB, F.WT_UP, MTOK, DM, PLE}; pg8::StaticOrder S2; S2.init(MTOK, DM, gridDim.x, blockIdx.x);
        pg8::EpiBf16<0> E2{F.PU, DM, nullptr, 0, 0, 1.f, 1};
        pg8::gemm_phase<pg8::EpiBf16<0>, pg8::StaticOrder, true, true>(F.lds, g2, S2, E2);
    }
    GRID_SEAM();
    TSTAMP(2);
    MIXERS(F);
    GRID_SEAM();
    TSTAMP(4);
    for (int rep_ = 0; rep_ < REP_P3; ++rep_) {
        pg8::Gemm g{F.Y, F.WT_OUT, MTOK, DM, DM}; pg8::StaticOrder S; S.init(MTOK, DM, gridDim.x, blockIdx.x);
        pg8::EpiBf16<0> E{F.Y2, DM, nullptr, 0, 0, 1.f};
        pg8::gemm_phase<pg8::EpiBf16<0>, pg8::StaticOrder, true, true>(F.lds, g, S, E);
    }
    GRID_SEAM();
    TSTAMP(5);
    for (int rep_ = 0; rep_ < REP_P0; ++rep_) phase_norm(F);
    GRID_SEAM();
    TSTAMP(6);
    {
        pg8::Gemm g{F.HB, F.WT_GATE, MTOK, DM, DM}; pg8::StaticOrder S; S.init(MTOK, DM, gridDim.x, blockIdx.x);
        EpiGate E{F.out, F.PU, F.b_gate, F.HB};
        pg8::gemm_phase<EpiGate, pg8::StaticOrder, true, true>(F.lds, g, S, E);
    }
    TSTAMP(7);
    TSPIN();
}

extern "C" void kernel_launch(void* const* d_in, const int* in_sizes, int n_in, void* d_out, int out_size, void* d_ws, size_t ws_size, hipStream_t stream) {
    static int grid = 0;
    if (grid == 0) {
        if (n_in != 15 || out_size != MTOK * DM || ws_size < WS_END) { fprintf(stderr, "kernel_launch: unexpected shapes (n_in %d out %d ws %zu)\n", n_in, out_size, ws_size); grid = -1; return; }
        int dev = 0, cus = 0, per_cu = 0;
        (void)hipGetDevice(&dev); (void)hipDeviceGetAttribute(&cus, hipDeviceAttributeMultiprocessorCount, dev);
        if (hipFuncSetAttribute((const void*)fwd_kernel, hipFuncAttributeMaxDynamicSharedMemorySize, LDS_BYTES) != hipSuccess) { fprintf(stderr, "kernel_launch: hipFuncSetAttribute failed\n"); grid = -1; return; }
        if (hipOccupancyMaxActiveBlocksPerMultiprocessor(&per_cu, (const void*)fwd_kernel, 512, LDS_BYTES) != hipSuccess || per_cu < 1) { fprintf(stderr, "kernel_launch: occupancy query says %d\n", per_cu); per_cu = 1; }
        (void)hipGetLastError();
        grid = cus * 1;
        if (grid <= 0) grid = 256;
    }
    if (grid < 0) return;
    Args a{};
    for (int i = 0; i < 15; ++i) a.in[i] = (const float*)d_in[i];
    a.out = (float*)d_out; a.ws = (unsigned char*)d_ws;
    if (hipMemsetAsync(d_ws, 0, 32768, stream) != hipSuccess) { fprintf(stderr, "kernel_launch: memset of the control words failed\n"); return; }
    void* kargs[] = {&a};
    hipError_t e = hipLaunchCooperativeKernel((const void*)fwd_kernel, dim3(grid), dim3(512), kargs, LDS_BYTES, stream);
    if (e != hipSuccess) fprintf(stderr, "kernel_launch: cooperative launch failed: %s (grid %d)\n", hipGetErrorString(e), grid);
}
```
